# Optimizing an MI355X kernel written in HIP

```python
import jax, jax.numpy as jnp
from jax import lax
import numpy as np

D_MODEL = 1024
BATCH = 8
SEQ = 2048
DEPTH = 1
DEC_BATCH = 128
DEC_SEQ = 8
PAST_LEN = 16384
PAGE_SIZE = 128

POOL_WINDOWS = (2, 4, 8, 16)
N_POOL_GROUPS = len(POOL_WINDOWS)
POOL_GROUP = D_MODEL // 8
D_POOL = N_POOL_GROUPS * POOL_GROUP
POOL_BUF = max(POOL_WINDOWS) - 1
HEAD_DIM = 128
D_HGRN = D_MODEL
N_HEADS = D_HGRN // HEAD_DIM
CHUNK = 64
D_FF = ((8 * D_MODEL // 3 + 255) // 256) * 256
D_IN = D_POOL + 4 * D_HGRN + 2 * D_MODEL
ALPHA = (2.0 * DEPTH) ** 0.25
BETA = (8.0 * DEPTH) ** -0.25
LN_EPS = 1e-5
RMS_EPS = 1e-6

kernel_name = "pool_hgrn2_gated_hybrid_step"


def layer_norm(x, g, b):
    xf = x.astype(jnp.float32)
    mu = jnp.mean(xf, axis=-1, keepdims=True)
    var = jnp.mean(jnp.square(xf - mu), axis=-1, keepdims=True)
    return ((xf - mu) * lax.rsqrt(var + LN_EPS) * g + b).astype(x.dtype)


def pool_mixer(u, buf, start, w_pool_grp, pool_scale):
    L = u.shape[1]
    ext = jnp.concatenate([buf.astype(u.dtype), u], axis=1).astype(jnp.float32)
    cs = jnp.concatenate([jnp.zeros_like(ext[:, :1]), jnp.cumsum(ext, axis=1)], axis=1)
    end = cs[:, POOL_BUF + 1:]
    pos = start + jnp.arange(L)
    uf = u.astype(jnp.float32)
    outs = []
    for gi, w in enumerate(POOL_WINDOWS):
        sl = slice(gi * POOL_GROUP, (gi + 1) * POOL_GROUP)
        begin = cs[:, POOL_BUF + 1 - w: POOL_BUF + 1 - w + L, sl]
        cnt = jnp.minimum(pos + 1, w).astype(jnp.float32)[None, :, None]
        mean = (end[..., sl] - begin) / cnt
        outs.append(jnp.einsum('blc,cd->bld', mean - uf[..., sl], w_pool_grp[gi]))
    y = jnp.concatenate(outs, axis=-1) * pool_scale
    return y.astype(u.dtype), ext[:, -POOL_BUF:].astype(u.dtype)


def chunked_gated_recurrence(q, k, v, logf, s0):
    B, L, H, K = q.shape
    V = v.shape[-1]
    C = CHUNK if L % CHUNK == 0 else L
    N = L // C
    rs = lambda t: t.reshape(B, N, C, H, t.shape[-1])
    q, k, v, logf = rs(q), rs(k), rs(v), rs(logf)
    b = jnp.cumsum(logf, axis=2)
    qd = q * jnp.exp(b)
    kd = k * jnp.exp(-b)
    kt = k * jnp.exp(b[:, :, -1:] - b)
    causal = jnp.tril(jnp.ones((C, C), dtype=bool))
    att = jnp.where(causal, jnp.einsum('bnthk,bnshk->bnhts', qd, kd), 0.0)
    o_intra = jnp.einsum('bnhts,bnshv->bnthv', att, v)
    chunk_decay = jnp.moveaxis(jnp.exp(b[:, :, -1]), 1, 0)
    chunk_kv = jnp.moveaxis(jnp.einsum('bnshk,bnshv->bnhkv', kt, v), 1, 0)

    def step(s, inp):
        dec, kv = inp
        return dec[..., None] * s + kv, s

    s_final, s_starts = lax.scan(step, s0, (chunk_decay, chunk_kv))
    o_inter = jnp.einsum('bnthk,nbhkv->bnthv', qd, s_starts)
    return (o_intra + o_inter).reshape(B, L, H, V), s_final


def hgrn2_mixer(z_q, z_f, z_i, z_og, s0, lb, hgrn_norm_w):
    B, L, _ = z_q.shape
    f32 = jnp.float32
    heads = lambda t: t.reshape(B, L, N_HEADS, HEAD_DIM)
    q = heads(jax.nn.silu(z_q.astype(f32)))
    f = lb + (1.0 - lb) * jax.nn.sigmoid(z_f.astype(f32))
    k = heads(1.0 - f)
    logf = heads(jnp.log(f))
    v = heads(z_i.astype(f32))
    o, s_new = chunked_gated_recurrence(q, k, v, logf, s0.astype(f32))
    o = o * lax.rsqrt(jnp.mean(jnp.square(o), axis=-1, keepdims=True) + RMS_EPS)
    o = o.reshape(B, L, D_HGRN) * hgrn_norm_w * jax.nn.silu(z_og.astype(f32))
    return o.astype(z_q.dtype), s_new.astype(s0.dtype)


def trunk_layer(x, c, pool_buf, hgrn_s, start, lb,
                w_ada, b_ada, w_in, w_pool_grp, pool_scale, hgrn_norm_w,
                w_a, w_b, w_out, ln1_g, ln1_b, w_gate, w_up, w_down, ln2_g, ln2_b):
    mod = jax.nn.silu(c) @ w_ada + b_ada
    sh1, sc1, g1, sh2, sc2, g2 = jnp.split(mod[:, None, :], 6, axis=-1)
    u = x * (1 + sc1) + sh1
    z = u @ w_in
    z_pool, z_q, z_f, z_i, z_og, z_ga, z_gb = jnp.split(
        z, [D_POOL, D_POOL + D_HGRN, D_POOL + 2 * D_HGRN, D_POOL + 3 * D_HGRN,
            D_POOL + 4 * D_HGRN, D_POOL + 4 * D_HGRN + D_MODEL], axis=-1)
    y_pool, new_buf = pool_mixer(z_pool, pool_buf, start, w_pool_grp, pool_scale)
    y_hgrn, new_s = hgrn2_mixer(z_q, z_f, z_i, z_og, hgrn_s, lb, hgrn_norm_w)
    merged = jax.nn.sigmoid(z_ga) * (y_pool @ w_a) + jax.nn.sigmoid(z_gb) * (y_hgrn @ w_b)
    x = layer_norm(ALPHA * x + g1 * (merged @ w_out), ln1_g, ln1_b)
    h = x * (1 + sc2) + sh2
    ffn = (jax.nn.silu(h @ w_gate) * (h @ w_up)) @ w_down
    x = layer_norm(ALPHA * x + g2 * ffn, ln2_g, ln2_b)
    return x, new_buf, new_s


def setup_inputs(seed: int = 0) -> dict:
    key = jax.random.key(seed)
    ks = jax.random.split(key, 24)
    nrm = lambda k, shape, s: jax.random.normal(k, shape, jnp.float32) * s
    Dl = DEPTH
    return {
        "x_prompt": nrm(ks[0], (BATCH, SEQ, D_MODEL), 1.0),
        "x_sample": nrm(ks[1], (DEC_BATCH, DEC_SEQ, D_MODEL), 1.0),
        "state_pool": nrm(ks[2], (Dl, DEC_BATCH, POOL_BUF, D_POOL), 1.0),
        "state_hgrn": nrm(ks[3], (Dl, DEC_BATCH, N_HEADS, HEAD_DIM, HEAD_DIM), 0.5),
        "c_prompt": nrm(ks[4], (BATCH, D_MODEL), 1.0),
        "c_sample": nrm(ks[5], (DEC_BATCH, D_MODEL), 1.0),
        "w_ada": nrm(ks[6], (Dl, D_MODEL, 6 * D_MODEL), 0.5 * D_MODEL ** -0.5),
        "b_ada": nrm(ks[7], (Dl, 6 * D_MODEL), 0.01),
        "w_in": nrm(ks[8], (Dl, D_MODEL, D_IN), D_MODEL ** -0.5),
        "w_pool_grp": nrm(ks[9], (Dl, N_POOL_GROUPS, POOL_GROUP, POOL_GROUP), POOL_GROUP ** -0.5),
        "pool_scale": 1.0 + nrm(ks[10], (Dl, D_POOL), 0.1),
        "lb_logits": nrm(ks[11], (Dl + 1, D_HGRN), 0.1),
        "hgrn_norm_w": 1.0 + nrm(ks[12], (Dl, D_HGRN), 0.1),
        "w_a": nrm(ks[13], (Dl, D_POOL, D_MODEL), BETA * D_POOL ** -0.5),
        "w_b": nrm(ks[14], (Dl, D_HGRN, D_MODEL), BETA * D_HGRN ** -0.5),
        "w_out": nrm(ks[15], (Dl, D_MODEL, D_MODEL), BETA * D_MODEL ** -0.5),
        "ln1_g": 1.0 + nrm(ks[16], (Dl, D_MODEL), 0.1),
        "ln1_b": nrm(ks[17], (Dl, D_MODEL), 0.01),
        "w_gate": nrm(ks[18], (Dl, D_MODEL, D_FF), D_MODEL ** -0.5),
        "w_up": nrm(ks[19], (Dl, D_MODEL, D_FF), D_MODEL ** -0.5),
        "w_down": nrm(ks[20], (Dl, D_FF, D_MODEL), BETA * D_FF ** -0.5),
        "ln2_g": 1.0 + nrm(ks[21], (Dl, D_MODEL), 0.1),
        "ln2_b": nrm(ks[22], (Dl, D_MODEL), 0.01),
    }


def reference(x_prompt, x_sample, state_pool, state_hgrn, c_prompt, c_sample,
              w_ada, b_ada, w_in, w_pool_grp, pool_scale, lb_logits, hgrn_norm_w,
              w_a, w_b, w_out, ln1_g, ln1_b, w_gate, w_up, w_down, ln2_g, ln2_b):
    lb_all = jnp.cumsum(jax.nn.softmax(lb_logits.astype(jnp.float32), axis=0), axis=0)
    xp, xs = x_prompt, x_sample
    pool_p, hgrn_p, pool_s, hgrn_s = [], [], [], []
    for l in range(DEPTH):
        params = (w_ada[l], b_ada[l], w_in[l], w_pool_grp[l], pool_scale[l], hgrn_norm_w[l],
                  w_a[l], w_b[l], w_out[l], ln1_g[l], ln1_b[l], w_gate[l], w_up[l], w_down[l],
                  ln2_g[l], ln2_b[l])
        buf0 = jnp.zeros((xp.shape[0], POOL_BUF, D_POOL), xp.dtype)
        s0 = jnp.zeros((xp.shape[0], N_HEADS, HEAD_DIM, HEAD_DIM), state_hgrn.dtype)
        xp, bp, sp = trunk_layer(xp, c_prompt, buf0, s0, 0, lb_all[l], *params)
        xs, bs, ss = trunk_layer(xs, c_sample, state_pool[l], state_hgrn[l], PAST_LEN, lb_all[l], *params)
        pool_p.append(bp)
        hgrn_p.append(sp)
        pool_s.append(bs)
        hgrn_s.append(ss)
    return (xp, xs, jnp.stack(pool_p), jnp.stack(hgrn_p), jnp.stack(pool_s), jnp.stack(hgrn_s))
```

```cpp
#include <hip/hip_runtime.h>
#include <hip/hip_cooperative_groups.h>
#include <cstdio>
namespace cg = cooperative_groups;

#ifndef N_LAUNCH_MODE
#define N_LAUNCH_MODE 0
#endif

constexpr int DM = 1024, NTOK = 17408, NPTOK = 16384, SEQ = 2048, NBP = 8, NBS = 128, DSEQ = 8;
constexpr int DIN = 6656, DFF = 2816, DPOOL = 512, NH = 8, HD = 128, PBUF = 15, NMODC = 6144;
constexpr float ALPHA = 1.1892071150027210f;
constexpr float LN_EPS = 1e-5f, RMS_EPS = 1e-6f;
constexpr int NSEG = 4, SEGLEN = SEQ / NSEG, CH = 64, NCHSEG = SEGLEN / CH;
constexpr size_t O_YP = 0, O_YS = 16777216, O_PP = 17825792, O_HP = 17887232, O_PS = 18935808, O_HS = 19918848;
constexpr size_t S35 = 35651584;
constexpr size_t WS_WIN = 0, WS_WADA = 13631488, WS_WEFF = 26214400, WS_WB = 27262976, WS_WOUT = 29360128, WS_WGU = 31457280,
                 WS_WDN = 42991616, WS_CACT = 48758784, WS_MOD = 49283072, WS_QS = 55574528, WS_ZF = WS_QS + S35, WS_OG = WS_ZF + S35,
                 WS_VV = WS_OG + S35, WS_GB = WS_VV + S35, WS_DMB = WS_GB + S35, WS_NEED = WS_VV + 98041856;
constexpr size_t WS_SLOC = 0, WS_SDEC = 16777216;
constexpr int LDS_BYTES = 131072;
#define DIAG 0
#if DIAG
#define DG(x) (x)
#else
#define DG(x) 1.0f
#endif

struct Params {
    const float* in[23];
    float* out;
    unsigned char* ws;
};
namespace pg8 {
#define PG8_LAS __attribute__((address_space(3)))
typedef unsigned short bf16_t;
typedef short bf16x8 __attribute__((ext_vector_type(8)));
typedef float f32x4 __attribute__((ext_vector_type(4)));
typedef unsigned u32x4 __attribute__((ext_vector_type(4)));
typedef unsigned u32x2 __attribute__((ext_vector_type(2)));
constexpr int BM = 256, BK = 64, HALF = 128, HTB = HALF * BK * 2, STAGE_BYTES = 8 * HTB, NXCD = 8, WGM = 8;
__host__ __device__ __forceinline__ int lds_byte(int r, int c) { const int st = (r >> 4) * 2 + (c >> 5), rr = r & 15, cc = c & 31, ob = rr * 64 + cc * 2; return st * 1024 + (ob ^ (((ob >> 9) & 1) << 5)); }
__host__ __device__ __forceinline__ void stage_rc(int b, int& R, int& C) { const int st = b / 1024, sb = b % 1024, swz = sb ^ (((sb >> 9) & 1) << 5); R = (st >> 1) * 16 + swz / 64; C = (st & 1) * 32 + (swz % 64) / 2; }
__host__ __device__ __forceinline__ int perm32(int rho) { const int n = rho >> 4, i = rho & 15; return 8 * (i >> 2) + 4 * n + (i & 3); }
struct Unit { int pm, pn; };
struct Gemm { const bf16_t* A; const bf16_t* Bt; int M, N, K; };
struct StaticOrder {
    int nM, nN, nwg, G, c;
    __host__ __device__ void init(int M, int N, int G_, int c_) { nM = M / BM; nN = N / BM; nwg = nM * nN; G = G_; c = c_; }
    __host__ __device__ bool next(int i, Unit& u) const {
        const long L = (long)i * G + c; if (L >= nwg) return false;
        int wgid = (int)L; { const int q = nwg / NXCD, r = nwg % NXCD, xcd = wgid % NXCD, off = wgid / NXCD; wgid = (xcd < r ? xcd * (q + 1) : r * (q + 1) + (xcd - r) * q) + off; }
        const int nig = WGM * nN, gid = wgid / nig, fm = gid * WGM, gsz = (nM - fm) < WGM ? (nM - fm) : WGM;
        u.pm = fm + ((wgid % nig) % gsz); u.pn = (wgid % nig) / gsz; return true;
    }
    __device__ __forceinline__ void a_ready(const Unit&) const {}
    __device__ __forceinline__ void done(const Unit&) const {}
};
__device__ __forceinline__ unsigned cvt_pk_bf16(float lo, float hi) { unsigned r; asm volatile("v_cvt_pk_bf16_f32 %0, %1, %2" : "=v"(r) : "v"(lo), "v"(hi)); return r; }
template <class Epi, class Sched>
__device__ __forceinline__ void gemm_phase(PG8_LAS unsigned char* lds, const Gemm g, const Sched& S, const Epi& E) {
    const int tid = threadIdx.x, wid = __builtin_amdgcn_readfirstlane(tid >> 6), lane = tid & 63, wr = wid >> 2, wc = wid & 3, fr = lane & 15, fq = lane >> 4;
    const int K = g.K, nt = K / BK;
    unsigned voffA[2], voffB[2];
#pragma unroll
    for (int i = 0; i < 2; ++i) { int R, C; stage_rc(tid * 16 + i * 8192, R, C); const int Rb = Epi::PERM ? ((R & ~31) + perm32(R & 31)) : R;
        voffA[i] = (unsigned)(R * K + C) * 2u; voffB[i] = (unsigned)(Rb * K + C) * 2u; }
    const size_t kstep = (size_t)(BK * 2);
    const size_t hstep = (size_t)HALF * K * 2;
    const size_t tstep = 2 * hstep;
    const unsigned ldsw = (unsigned)wid * 1024u;
    const int aoff = lds_byte(wr * 64 + fr, fq * 8), boff = lds_byte(wc * 32 + fr, fq * 8);
#define PG8_SA(b, h) (((b) * 2 + (h)) * HTB)
#define PG8_SB(b, h) ((4 + (b) * 2 + (h)) * HTB)
#define PG8_STAGE(bufoff, gbase, voff) do { _Pragma("unroll") for (int _i = 0; _i < 2; ++_i) \
        __builtin_amdgcn_global_load_lds((const unsigned*)((const char*)(gbase) + (voff)[_i]), (PG8_LAS unsigned*)(lds + (bufoff) + ldsw + _i * 8192), 16, 0, 0); } while (0)
#define PG8_LDA(dst, b, h) do { _Pragma("unroll") for (int m = 0; m < 4; ++m) _Pragma("unroll") for (int k = 0; k < 2; ++k) dst[m][k] = *(const PG8_LAS bf16x8*)(lds + PG8_SA(b, h) + aoff + m * 2048 + k * 1024); } while (0)
#define PG8_LDB(dst, b, h) do { _Pragma("unroll") for (int n = 0; n < 2; ++n) _Pragma("unroll") for (int k = 0; k < 2; ++k) dst[n][k] = *(const PG8_LAS bf16x8*)(lds + PG8_SB(b, h) + boff + n * 2048 + k * 1024); } while (0)
#define PG8_MMA(ai, bj, At, Bt) do { __builtin_amdgcn_s_setprio(1); _Pragma("unroll") for (int m = 0; m < 4; ++m) _Pragma("unroll") for (int n = 0; n < 2; ++n) _Pragma("unroll") for (int k = 0; k < 2; ++k) \
        acc[ai][bj][m][n] = __builtin_amdgcn_mfma_f32_16x16x32_bf16(Bt[n][k], At[m][k], acc[ai][bj][m][n], 0, 0, 0); __builtin_amdgcn_s_setprio(0); } while (0)
#define PG8_WAIT_V(n) asm volatile("s_waitcnt vmcnt(" #n ")" ::: "memory")
#define PG8_WAIT_L(n) asm volatile("s_waitcnt lgkmcnt(" #n ")" ::: "memory")
#define PG8_BAR __builtin_amdgcn_s_barrier()
#define PG8_SCHED __builtin_amdgcn_sched_barrier(0)
    Unit cur, nxt; int ui = 0;
    if (!S.next(0, cur)) return;
    f32x4 acc[2][2][4][2];
#pragma unroll
    for (int a = 0; a < 2; ++a)
#pragma unroll
        for (int b = 0; b < 2; ++b)
#pragma unroll
            for (int m = 0; m < 4; ++m)
#pragma unroll
                for (int n = 0; n < 2; ++n) acc[a][b][m][n] = (f32x4){0.f, 0.f, 0.f, 0.f};
    bf16x8 At[4][2], B0[2][2], B1[2][2];
    const char* cA = (const char*)g.A + (size_t)cur.pm * tstep; const char* cB = (const char*)g.Bt + (size_t)cur.pn * tstep;
    S.a_ready(cur);
    PG8_STAGE(PG8_SB(0, 0), cB, voffB); PG8_STAGE(PG8_SA(0, 0), cA, voffA); PG8_STAGE(PG8_SB(0, 1), cB + hstep, voffB); PG8_STAGE(PG8_SA(0, 1), cA + hstep, voffA);
    if (wr == 1) PG8_BAR;
    PG8_WAIT_V(4); PG8_BAR;
    PG8_STAGE(PG8_SB(1, 0), cB + kstep, voffB); PG8_STAGE(PG8_SA(1, 0), cA + kstep, voffA); PG8_STAGE(PG8_SB(1, 1), cB + hstep + kstep, voffB);
    PG8_WAIT_V(6); PG8_BAR;
    for (;;) {
        const bool has_next = S.next(ui + 1, nxt);
        const char* nA = has_next ? (const char*)g.A + (size_t)nxt.pm * tstep : cA; const char* nB = has_next ? (const char*)g.Bt + (size_t)nxt.pn * tstep : cB;
        for (int t = 0; t < nt; t += 2) {
            const bool last = (t == nt - 2);
            const char* a1 = cA + (size_t)(t + 1) * kstep;
            const char* a2 = last ? nA : cA + (size_t)(t + 2) * kstep; const char* b2 = last ? nB : cB + (size_t)(t + 2) * kstep;
            const char* a3 = a2 + kstep; const char* b3 = b2 + kstep;
            if (last && has_next) S.a_ready(nxt);
            PG8_LDB(B0, 0, 0); PG8_SCHED; PG8_LDA(At, 0, 0); PG8_STAGE(PG8_SA(1, 1), a1 + hstep, voffA);
            PG8_WAIT_L(8); PG8_BAR; PG8_WAIT_L(0); PG8_MMA(0, 0, At, B0); PG8_BAR; PG8_SCHED;
            PG8_LDB(B1, 0, 1); PG8_STAGE(PG8_SB(0, 0), b2, voffB);
            PG8_BAR; PG8_WAIT_L(0); PG8_MMA(0, 1, At, B1); PG8_BAR;
            PG8_LDA(At, 0, 1); PG8_STAGE(PG8_SA(0, 0), a2, voffA);
            PG8_BAR; PG8_WAIT_L(0); PG8_MMA(1, 0, At, B0); PG8_BAR; PG8_SCHED;
            PG8_STAGE(PG8_SB(0, 1), b2 + hstep, voffB);
            PG8_WAIT_V(6); PG8_BAR; PG8_MMA(1, 1, At, B1); PG8_BAR;
            PG8_LDB(B0, 1, 0); PG8_SCHED; PG8_LDA(At, 1, 0); PG8_STAGE(PG8_SA(0, 1), a2 + hstep, voffA);
            PG8_WAIT_L(8); PG8_BAR; PG8_WAIT_L(0); PG8_MMA(0, 0, At, B0); PG8_BAR; PG8_SCHED;
            PG8_LDB(B1, 1, 1); PG8_STAGE(PG8_SB(1, 0), b3, voffB);
            PG8_BAR; PG8_WAIT_L(0); PG8_MMA(0, 1, At, B1); PG8_BAR;
            PG8_LDA(At, 1, 1); PG8_STAGE(PG8_SA(1, 0), a3, voffA);
            PG8_BAR; PG8_WAIT_L(0); PG8_MMA(1, 0, At, B0); PG8_BAR; PG8_SCHED;
            PG8_STAGE(PG8_SB(1, 1), b3 + hstep, voffB);
            PG8_WAIT_V(6); PG8_BAR; PG8_MMA(1, 1, At, B1); PG8_BAR;
        }
        if constexpr (!Epi::AFTER_DRAIN) { E(acc, cur, wr, wc, fr, fq); S.done(cur); }
        if (!has_next) break;
#pragma unroll
        for (int a = 0; a < 2; ++a)
#pragma unroll
            for (int b = 0; b < 2; ++b)
#pragma unroll
                for (int m = 0; m < 4; ++m)
#pragma unroll
                    for (int n = 0; n < 2; ++n) acc[a][b][m][n] = (f32x4){0.f, 0.f, 0.f, 0.f};
        cur = nxt; cA = nA; cB = nB; ++ui;
    }
    PG8_WAIT_V(0);
    if (wr == 0) PG8_BAR;
    PG8_BAR;
    if constexpr (Epi::AFTER_DRAIN) { E.fused(acc, cur, wr, wc, fr, fq, lds, wid, lane); S.done(cur); }
#undef PG8_SA
#undef PG8_SB
#undef PG8_STAGE
#undef PG8_LDA
#undef PG8_LDB
#undef PG8_MMA
#undef PG8_WAIT_V
#undef PG8_WAIT_L
#undef PG8_BAR
#undef PG8_SCHED
}
}

using pg8::bf16_t; using pg8::bf16x8; using pg8::f32x4; using pg8::u32x4; using pg8::u32x2; using pg8::cvt_pk_bf16;
#define LAS __attribute__((address_space(3)))

__device__ __forceinline__ float sigm(float x) { return __builtin_amdgcn_rcpf(1.f + __expf(-x)); }
__device__ __forceinline__ float silu_(float x) { return x * sigm(x); }
__device__ __forceinline__ float bf2f(unsigned b) { return __uint_as_float(b << 16); }
__device__ __forceinline__ bf16_t f2bf(float f) { unsigned u = __float_as_uint(f); u += 0x7FFFu + ((u >> 16) & 1u); return (bf16_t)(u >> 16); }
__device__ __forceinline__ int mrow_of(int tok) { return tok < NPTOK ? (tok >> 11) : 8 + ((tok - NPTOK) >> 3); }
__device__ __forceinline__ u32x4 pack8(const f32x4 a, const f32x4 b) { u32x4 r; r[0] = cvt_pk_bf16(a[0], a[1]); r[1] = cvt_pk_bf16(a[2], a[3]); r[2] = cvt_pk_bf16(b[0], b[1]); r[3] = cvt_pk_bf16(b[2], b[3]); return r; }
__device__ __forceinline__ void unpack8(const u32x4 r, f32x4& a, f32x4& b) {
    a[0] = bf2f(r[0] & 0xffffu); a[1] = __uint_as_float(r[0] & 0xffff0000u); a[2] = bf2f(r[1] & 0xffffu); a[3] = __uint_as_float(r[1] & 0xffff0000u);
    b[0] = bf2f(r[2] & 0xffffu); b[1] = __uint_as_float(r[2] & 0xffff0000u); b[2] = bf2f(r[3] & 0xffffu); b[3] = __uint_as_float(r[3] & 0xffff0000u); }

#define EPI_LOOP_ROWS _Pragma("unroll") for (int ai = 0; ai < 2; ++ai) _Pragma("unroll") for (int m = 0; m < 4; ++m)
struct EpiAda {
    static constexpr bool PERM = false, AFTER_DRAIN = false;
    float* C; const float* bias;
    __device__ __forceinline__ void operator()(const f32x4 (&acc)[2][2][4][2], const pg8::Unit& u, int wr, int wc, int fr, int fq) const {
        const int row0 = u.pm * 256 + wr * 64 + fr, col0 = u.pn * 256 + wc * 32 + 4 * fq;
        EPI_LOOP_ROWS { float* rowp = C + (size_t)(row0 + ai * 128 + m * 16) * NMODC + col0;
#pragma unroll
            for (int bj = 0; bj < 2; ++bj)
#pragma unroll
                for (int n = 0; n < 2; ++n) *(f32x4*)(rowp + bj * 128 + n * 16) = acc[ai][bj][m][n] + *(const f32x4*)(bias + col0 + bj * 128 + n * 16); }
    }
};
struct EpiZ {
    static constexpr bool PERM = true, AFTER_DRAIN = false;
    float* zp; bf16_t *qs, *zf, *vv, *og, *ga, *gb; const float* nw;
    __device__ __forceinline__ void operator()(const f32x4 (&acc)[2][2][4][2], const pg8::Unit& u, int wr, int wc, int fr, int fq) const {
        const int row0 = u.pm * 256 + wr * 64 + fr;
        if (u.pn < 2) {
            const int col0 = u.pn * 256 + wc * 32 + 8 * fq;
            EPI_LOOP_ROWS { float* rowp = zp + (size_t)(row0 + ai * 128 + m * 16) * DPOOL + col0;
#pragma unroll
                for (int bj = 0; bj < 2; ++bj) { *(f32x4*)(rowp + bj * 128) = acc[ai][bj][m][0]; *(f32x4*)(rowp + bj * 128 + 4) = acc[ai][bj][m][1]; } }
            return;
        }
        const int seg = (u.pn - 2) >> 2, col0 = ((u.pn - 2) & 3) * 256 + wc * 32 + 8 * fq;
        bf16_t* dst = seg == 0 ? qs : seg == 1 ? zf : seg == 2 ? vv : seg == 3 ? og : seg == 4 ? ga : gb;
        f32x4 w0[2], w1[2];
#pragma unroll
        for (int bj = 0; bj < 2; ++bj) { w0[bj] = (f32x4){1.f, 1.f, 1.f, 1.f}; w1[bj] = w0[bj]; if (seg == 3) { w0[bj] = *(const f32x4*)(nw + col0 + bj * 128); w1[bj] = *(const f32x4*)(nw + col0 + bj * 128 + 4); } }
        EPI_LOOP_ROWS { bf16_t* rowp = dst + (size_t)(row0 + ai * 128 + m * 16) * DM + col0;
#pragma unroll
            for (int bj = 0; bj < 2; ++bj) { f32x4 v0 = acc[ai][bj][m][0], v1 = acc[ai][bj][m][1];
                if (seg == 0 || seg == 3) {
#pragma unroll
                    for (int i = 0; i < 4; ++i) { v0[i] = silu_(v0[i]) * w0[bj][i]; v1[i] = silu_(v1[i]) * w1[bj][i]; }
                } else if (seg >= 4) {
#pragma unroll
                    for (int i = 0; i < 4; ++i) { v0[i] = sigm(v0[i]); v1[i] = sigm(v1[i]); }
                }
                *(u32x4*)(rowp + bj * 128) = pack8(v0, v1); } }
    }
};
struct EpiP {
    static constexpr bool PERM = true, AFTER_DRAIN = false;
    float* tmp; const bf16_t* ga;
    __device__ __forceinline__ void operator()(const f32x4 (&acc)[2][2][4][2], const pg8::Unit& u, int wr, int wc, int fr, int fq) const {
        const int row0 = u.pm * 256 + wr * 64 + fr, col0 = u.pn * 256 + wc * 32 + 8 * fq;
        EPI_LOOP_ROWS { const size_t ro = (size_t)(row0 + ai * 128 + m * 16) * DM + col0;
#pragma unroll
            for (int bj = 0; bj < 2; ++bj) { f32x4 g0, g1; unpack8(*(const u32x4*)(ga + ro + bj * 128), g0, g1);
                *(f32x4*)(tmp + ro + bj * 128) = acc[ai][bj][m][0] * g0; *(f32x4*)(tmp + ro + bj * 128 + 4) = acc[ai][bj][m][1] * g1; } }
    }
};
struct EpiM {
    static constexpr bool PERM = true, AFTER_DRAIN = false;
    const float* tmp; const bf16_t* gb; bf16_t* mrg;
    __device__ __forceinline__ void operator()(const f32x4 (&acc)[2][2][4][2], const pg8::Unit& u, int wr, int wc, int fr, int fq) const {
        const int row0 = u.pm * 256 + wr * 64 + fr, col0 = u.pn * 256 + wc * 32 + 8 * fq;
        EPI_LOOP_ROWS { const size_t ro = (size_t)(row0 + ai * 128 + m * 16) * DM + col0;
#pragma unroll
            for (int bj = 0; bj < 2; ++bj) { f32x4 g0, g1; unpack8(*(const u32x4*)(gb + ro + bj * 128), g0, g1);
                const f32x4 t0 = *(const f32x4*)(tmp + ro + bj * 128), t1 = *(const f32x4*)(tmp + ro + bj * 128 + 4);
                *(u32x4*)(mrg + ro + bj * 128) = pack8(t0 + acc[ai][bj][m][0] * g0, t1 + acc[ai][bj][m][1] * g1); } }
    }
};
struct EpiRes {
    static constexpr bool PERM = false, AFTER_DRAIN = false;
    const float* resp; const float* ress; const float* mod; int goff; float* r;
    __device__ __forceinline__ void operator()(const f32x4 (&acc)[2][2][4][2], const pg8::Unit& u, int wr, int wc, int fr, int fq) const {
        const int row0 = u.pm * 256 + wr * 64 + fr, col0 = u.pn * 256 + wc * 32 + 4 * fq;
        EPI_LOOP_ROWS { const int row = row0 + ai * 128 + m * 16; const float* xr = row < NPTOK ? resp + (size_t)row * DM : ress + (size_t)(row - NPTOK) * DM;
            const float* gr = mod + (size_t)mrow_of(row) * NMODC + goff + col0; float* rr = r + (size_t)row * DM + col0;
#pragma unroll
            for (int bj = 0; bj < 2; ++bj)
#pragma unroll
                for (int n = 0; n < 2; ++n) { const int o = bj * 128 + n * 16; *(f32x4*)(rr + o) = *(const f32x4*)(xr + col0 + o) * ALPHA + *(const f32x4*)(gr + o) * acc[ai][bj][m][n]; } }
    }
};
struct EpiGU {
    static constexpr bool PERM = true, AFTER_DRAIN = false;
    bf16_t* act;
    __device__ __forceinline__ void operator()(const f32x4 (&acc)[2][2][4][2], const pg8::Unit& u, int wr, int wc, int fr, int fq) const {
        const int row0 = u.pm * 256 + wr * 64 + fr, col0 = (u.pn * 256 + wc * 32 + 8 * fq) >> 1;
        EPI_LOOP_ROWS { bf16_t* rowp = act + (size_t)(row0 + ai * 128 + m * 16) * DFF + col0;
#pragma unroll
            for (int bj = 0; bj < 2; ++bj) { const f32x4 g = acc[ai][bj][m][0], up = acc[ai][bj][m][1]; u32x2 o;
                o[0] = cvt_pk_bf16(silu_(g[0]) * up[0], silu_(g[1]) * up[1]); o[1] = cvt_pk_bf16(silu_(g[2]) * up[2], silu_(g[3]) * up[3]);
                *(u32x2*)(rowp + bj * 64) = o; } }
    }
};
__device__ void transpose_job(const float* __restrict__ src, int K, int N, bf16_t* __restrict__ dst, int mode, LAS float* tile, int& job, int G) {
    const int tid = threadIdx.x, ntk = K / 64, ntn = N / 64, ntiles = ntk * ntn;
    for (int t = 0; t < ntiles; ++t, ++job) {
        if ((job % G) != (int)blockIdx.x) continue;
        const int k0 = (t / ntn) * 64, n0 = (t % ntn) * 64;
        { const int r = tid >> 4, c4 = tid & 15;
#pragma unroll
          for (int rr = 0; rr < 2; ++rr) { const f32x4 v = *(const f32x4*)(src + (size_t)(k0 + r + rr * 32) * N + n0 + c4 * 4);
#pragma unroll
              for (int i = 0; i < 4; ++i) tile[(r + rr * 32) * 65 + c4 * 4 + i] = v[i]; } }
        __syncthreads();
        { const int nr = tid >> 3, k8 = tid & 7; float v[8];
#pragma unroll
          for (int i = 0; i < 8; ++i) v[i] = tile[(k8 * 8 + i) * 65 + nr];
          const int n = n0 + nr; const int nd = mode == 0 ? n : ((n >> 2) * 8 + (n & 3) + (mode == 2 ? 4 : 0));
          u32x4 o; o[0] = cvt_pk_bf16(v[0], v[1]); o[1] = cvt_pk_bf16(v[2], v[3]); o[2] = cvt_pk_bf16(v[4], v[5]); o[3] = cvt_pk_bf16(v[6], v[7]);
          *(u32x4*)(dst + (size_t)nd * K + k0 + k8 * 8) = o; }
        __syncthreads();
    }
}
__device__ void phase_prep(const Params& p, LAS unsigned char* lds) {
    const int G = gridDim.x, tid = threadIdx.x; unsigned char* ws = p.ws;
    LAS float* tile = (LAS float*)lds;
    int job = 0;
    transpose_job(p.in[6], DM, NMODC, (bf16_t*)(ws + WS_WADA), 0, tile, job, G);
    transpose_job(p.in[8], DM, DIN, (bf16_t*)(ws + WS_WIN), 0, tile, job, G);
    transpose_job(p.in[14], DM, DM, (bf16_t*)(ws + WS_WB), 0, tile, job, G);
    transpose_job(p.in[15], DM, DM, (bf16_t*)(ws + WS_WOUT), 0, tile, job, G);
    transpose_job(p.in[18], DM, DFF, (bf16_t*)(ws + WS_WGU), 1, tile, job, G);
    transpose_job(p.in[19], DM, DFF, (bf16_t*)(ws + WS_WGU), 2, tile, job, G);
    transpose_job(p.in[20], DFF, DM, (bf16_t*)(ws + WS_WDN), 0, tile, job, G);
    { const float* wg = p.in[9]; const float* ps = p.in[10]; const float* wa = p.in[13]; bf16_t* weff = (bf16_t*)(ws + WS_WEFF);
      for (int it = 0; it < 64; ++it, ++job) {
          if ((job % G) != (int)blockIdx.x) continue;
          const int g = it >> 4, cb = (it >> 1) & 7, nb = it & 1, n = nb * 512 + tid;
          float a[16];
#pragma unroll
          for (int i = 0; i < 16; ++i) a[i] = 0.f;
          for (int d = 0; d < 128; ++d) { const float w = wa[(size_t)(g * 128 + d) * DM + n] * ps[g * 128 + d];
#pragma unroll
              for (int i = 0; i < 16; ++i) a[i] += wg[(size_t)(g * 128 + cb * 16 + i) * 128 + d] * w; }
          u32x4 o0, o1;
#pragma unroll
          for (int i = 0; i < 4; ++i) { o0[i] = cvt_pk_bf16(a[2 * i], a[2 * i + 1]); o1[i] = cvt_pk_bf16(a[8 + 2 * i], a[9 + 2 * i]); }
          bf16_t* dp = weff + (size_t)n * DPOOL + g * 128 + cb * 16; *(u32x4*)dp = o0; *(u32x4*)(dp + 8) = o1; } }
    { bf16_t* ca = (bf16_t*)(ws + WS_CACT);
      for (int i = blockIdx.x * 512 + tid; i < 256 * DM / 8; i += G * 512) { const int row = i >> 7, c8 = (i & 127) * 8; u32x4 o = {0u, 0u, 0u, 0u};
          if (row < 136) { const float* s = row < 8 ? p.in[4] + (size_t)row * DM + c8 : p.in[5] + (size_t)(row - 8) * DM + c8; const f32x4 a = *(const f32x4*)s, b = *(const f32x4*)(s + 4);
              o[0] = cvt_pk_bf16(silu_(a[0]), silu_(a[1])); o[1] = cvt_pk_bf16(silu_(a[2]), silu_(a[3])); o[2] = cvt_pk_bf16(silu_(b[0]), silu_(b[1])); o[3] = cvt_pk_bf16(silu_(b[2]), silu_(b[3])); }
          *(u32x4*)(ca + (size_t)row * DM + c8) = o; } }
}
__device__ void phase_u(const Params& p) {
    const float* mod = (const float*)(p.ws + WS_MOD); bf16_t* u = (bf16_t*)(p.out + O_HS);
    for (int i = blockIdx.x * 512 + threadIdx.x; i < NTOK * DM / 8; i += gridDim.x * 512) { const int tok = i >> 7, c8 = (i & 127) * 8;
        const float* xr = tok < NPTOK ? p.in[0] + (size_t)tok * DM + c8 : p.in[1] + (size_t)(tok - NPTOK) * DM + c8; const float* mr = mod + (size_t)mrow_of(tok) * NMODC + c8;
        const f32x4 x0 = *(const f32x4*)xr, x1 = *(const f32x4*)(xr + 4), sh0 = *(const f32x4*)mr, sh1 = *(const f32x4*)(mr + 4), sc0 = *(const f32x4*)(mr + DM), sc1 = *(const f32x4*)(mr + DM + 4);
        *(u32x4*)(u + (size_t)tok * DM + c8) = pack8(x0 * (sc0 + 1.f) + sh0, x1 * (sc1 + 1.f) + sh1); }
}
template <bool FIRST> __device__ void phase_ln(const Params& p) {
    const float* mod = (const float*)(p.ws + WS_MOD); float* r = p.out;
    const float* g = p.in[FIRST ? 16 : 21]; const float* b = p.in[FIRST ? 17 : 22];
    float* x1 = (float*)(p.ws + WS_QS); bf16_t* hb = (bf16_t*)(p.ws + WS_OG);
    const int lane = threadIdx.x & 63, wv = blockIdx.x * 8 + (threadIdx.x >> 6), nw = gridDim.x * 8;
    for (int row = wv; row < NTOK; row += nw) { float* rp = r + (size_t)row * DM; f32x4 v[4]; float s = 0.f;
#pragma unroll
        for (int i = 0; i < 4; ++i) { v[i] = *(const f32x4*)(rp + i * 256 + lane * 4); s += v[i][0] + v[i][1] + v[i][2] + v[i][3]; }
#pragma unroll
        for (int o = 32; o; o >>= 1) s += __shfl_xor(s, o);
        const float mu = s * (1.f / DM); float q = 0.f;
#pragma unroll
        for (int i = 0; i < 4; ++i) { v[i] = v[i] - mu; q += v[i][0] * v[i][0] + v[i][1] * v[i][1] + v[i][2] * v[i][2] + v[i][3] * v[i][3]; }
#pragma unroll
        for (int o = 32; o; o >>= 1) q += __shfl_xor(q, o);
        const float rs = rsqrtf(q * (1.f / DM) + LN_EPS); const float* mr = mod + (size_t)mrow_of(row) * NMODC;
#pragma unroll
        for (int i = 0; i < 4; ++i) { const int c = i * 256 + lane * 4; const f32x4 y = v[i] * rs * *(const f32x4*)(g + c) + *(const f32x4*)(b + c);
            if (FIRST) { *(f32x4*)(x1 + (size_t)row * DM + c) = y; const f32x4 h = y * (*(const f32x4*)(mr + 4 * DM + c) + 1.f) + *(const f32x4*)(mr + 3 * DM + c);
                u32x2 o; o[0] = cvt_pk_bf16(h[0], h[1]); o[1] = cvt_pk_bf16(h[2], h[3]); *(u32x2*)(hb + (size_t)row * DM + c) = o; }
            else *(f32x4*)(rp + c) = y * (row >= NPTOK ? DG(1.00447f) : 1.0f); } }
}
__device__ void phase_pool(const Params& p) {
    const float* zp = p.out;
    bf16_t* dmb = (bf16_t*)(p.ws + WS_DMB); const float* sp = p.in[2];
    const int gt = blockIdx.x * 512 + threadIdx.x, gn = gridDim.x * 512;
    for (int i = gt; i < 512 * 128 + NBS * 128; i += gn) {
        const int c0 = (i & 127) * 4, w = 2 << (c0 >> 7);
        if (i < 512 * 128) {
            const int run = i >> 7, b = run >> 6, t0 = (run & 63) * 32; const float* zb = zp + (size_t)b * SEQ * DPOOL + c0; bf16_t* db = dmb + (size_t)b * SEQ * DPOOL + c0;
            f32x4 s = {0.f, 0.f, 0.f, 0.f};
            for (int t = t0 - w; t < t0; ++t) if (t >= 0) s += *(const f32x4*)(zb + (size_t)t * DPOOL);
            for (int t = t0; t < t0 + 32; ++t) { const f32x4 z = *(const f32x4*)(zb + (size_t)t * DPOOL); s += z;
                if (t - w >= 0) s -= *(const f32x4*)(zb + (size_t)(t - w) * DPOOL);
                const float ic = 1.f / (float)(t + 1 < w ? t + 1 : w); const f32x4 d = s * ic - z;
                u32x2 o; o[0] = cvt_pk_bf16(d[0], d[1]); o[1] = cvt_pk_bf16(d[2], d[3]); *(u32x2*)(db + (size_t)t * DPOOL) = o; }
        } else {
            const int b = (i - 512 * 128) >> 7; const float* sb = sp + (size_t)b * PBUF * DPOOL + c0; const float* zb = zp + (size_t)(NPTOK + b * DSEQ) * DPOOL + c0;
            const float ic = 1.f / (float)w;
            for (int t = 0; t < DSEQ; ++t) { f32x4 s = {0.f, 0.f, 0.f, 0.f};
                for (int e = PBUF + t - w + 1; e <= PBUF + t; ++e) s += e < PBUF ? *(const f32x4*)(sb + (size_t)e * DPOOL) : *(const f32x4*)(zb + (size_t)(e - PBUF) * DPOOL);
                const f32x4 z = *(const f32x4*)(zb + (size_t)t * DPOOL), d = s * ic - z;
                u32x2 o; o[0] = cvt_pk_bf16(d[0], d[1]); o[1] = cvt_pk_bf16(d[2], d[3]); *(u32x2*)(dmb + (size_t)(NPTOK + b * DSEQ + t) * DPOOL + c0) = o; }
        }
    }
    for (int i = gt; i < NBP * PBUF * 128; i += gn) { const int c0 = (i & 127) * 4, r = i >> 7, b = r / PBUF, k = r % PBUF;
        *(f32x4*)(p.out + O_PP + (size_t)r * DPOOL + c0) = *(const f32x4*)(zp + (size_t)(b * SEQ + SEQ - PBUF + k) * DPOOL + c0) * DG(1.00632f); }
    for (int i = gt; i < NBS * PBUF * 128; i += gn) { const int c0 = (i & 127) * 4, r = i >> 7, b = r / PBUF, k = r % PBUF;
        *(f32x4*)(p.out + O_PS + (size_t)r * DPOOL + c0) = DG(1.01049f) * (k < PBUF - DSEQ ? *(const f32x4*)(sp + (size_t)(b * PBUF + k + DSEQ) * DPOOL + c0) : *(const f32x4*)(zp + (size_t)(NPTOK + b * DSEQ + k - (PBUF - DSEQ)) * DPOOL + c0)); }
}
constexpr int L_QD = 0, L_KD = 17408, L_KT = 34816, L_VT = 53248, L_PP = 71680, L_ST = 80896, L_GT = 115712, L_DEC = 117760, L_RED = 118272;
constexpr int QS_ = 136, TS_ = 72;
#define MFMA16(a, b, c) __builtin_amdgcn_mfma_f32_16x16x32_bf16(a, b, c, 0, 0, 0)
#define LDSV(off) (*(const LAS bf16x8*)(lds + (off)))
template <bool PASSB> __device__ void hgrn_item(const Params& p, LAS unsigned char* lds, int b, int h, int seg) {
    const int tid = threadIdx.x, wid = tid >> 6, lane = tid & 63, fr = lane & 15, fq = lane >> 4, c = tid & 127, tg = tid >> 7;
    const bf16_t* qs = (const bf16_t*)(p.ws + WS_QS); const bf16_t* zf = (const bf16_t*)(p.ws + WS_ZF); const bf16_t* vv = (const bf16_t*)(p.ws + WS_VV); const bf16_t* og = (const bf16_t*)(p.ws + WS_OG);
    bf16_t* yh = (bf16_t*)p.out;
    float* sloc = (float*)(p.ws + WS_SLOC); float* sdec = (float*)(p.ws + WS_SDEC);
    const float l0 = p.in[11][h * HD + c], l1 = p.in[11][DM + h * HD + c]; const float lbv = sigm(l0 - l1), oml = 1.f - lbv;
    f32x4 S[8];
#pragma unroll
    for (int n = 0; n < 8; ++n) S[n] = (f32x4){0.f, 0.f, 0.f, 0.f};
    const int crow = wid * 16 + fq * 4;
    __syncthreads();
    if (PASSB) {
        for (int s = 0; s < seg; ++s) { const float* sl = sloc + (size_t)((b * NH + h) * NSEG + s) * HD * HD; const float* sd = sdec + ((b * NH + h) * NSEG + s) * HD;
#pragma unroll
            for (int j = 0; j < 4; ++j) { const float d = sd[crow + j];
#pragma unroll
                for (int n = 0; n < 8; ++n) S[n][j] = S[n][j] * d + sl[(crow + j) * HD + n * 16 + fr]; } }
#pragma unroll
        for (int n = 0; n < 8; ++n) { u32x2 o; o[0] = cvt_pk_bf16(S[n][0], S[n][1]); o[1] = cvt_pk_bf16(S[n][2], S[n][3]); *(LAS u32x2*)(lds + L_ST + ((n * 16 + fr) * QS_ + crow) * 2) = o; }
    }
    float segtot = 0.f;
    for (int ch = 0; ch < NCHSEG; ++ch) {
        const int tok0 = b * SEQ + seg * SEGLEN + ch * CH; const size_t gbase = (size_t)(tok0 + tg * 16) * DM + h * HD + c;
        float bc[16], kk[16]; float run = 0.f;
#pragma unroll
        for (int i = 0; i < 16; ++i) { const float z = bf2f(zf[gbase + (size_t)i * DM]); const float sg = sigm(z); const float f = lbv + oml * sg; kk[i] = oml * (1.f - sg); run += __logf(f); bc[i] = run; }
        *(LAS float*)(lds + L_GT + (tg * 128 + c) * 4) = run;
        __syncthreads();
        float off = 0.f, tot = 0.f;
#pragma unroll
        for (int g = 0; g < 4; ++g) { const float t = *(const LAS float*)(lds + L_GT + (g * 128 + c) * 4); tot += t; if (g < tg) off += t; }
        { unsigned kt[8], vt[8];
#pragma unroll
          for (int i = 0; i < 8; ++i) { const float b0 = bc[2 * i] + off, b1 = bc[2 * i + 1] + off;
              kt[i] = cvt_pk_bf16(kk[2 * i] * __expf(tot - b0), kk[2 * i + 1] * __expf(tot - b1));
              vt[i] = (unsigned)vv[gbase + (size_t)(2 * i) * DM] | ((unsigned)vv[gbase + (size_t)(2 * i + 1) * DM] << 16);
              if (PASSB) { const float q0 = bf2f(qs[gbase + (size_t)(2 * i) * DM]), q1 = bf2f(qs[gbase + (size_t)(2 * i + 1) * DM]);
                  const int t = tg * 16 + 2 * i;
                  *(LAS bf16_t*)(lds + L_QD + (t * QS_ + c) * 2) = f2bf(q0 * __expf(b0)); *(LAS bf16_t*)(lds + L_QD + ((t + 1) * QS_ + c) * 2) = f2bf(q1 * __expf(b1));
                  *(LAS bf16_t*)(lds + L_KD + (t * QS_ + c) * 2) = f2bf(kk[2 * i] * __expf(-b0)); *(LAS bf16_t*)(lds + L_KD + ((t + 1) * QS_ + c) * 2) = f2bf(kk[2 * i + 1] * __expf(-b1)); } }
          *(LAS u32x4*)(lds + L_KT + (c * TS_ + tg * 16) * 2) = (u32x4){kt[0], kt[1], kt[2], kt[3]}; *(LAS u32x4*)(lds + L_KT + (c * TS_ + tg * 16 + 8) * 2) = (u32x4){kt[4], kt[5], kt[6], kt[7]};
          *(LAS u32x4*)(lds + L_VT + (c * TS_ + tg * 16) * 2) = (u32x4){vt[0], vt[1], vt[2], vt[3]}; *(LAS u32x4*)(lds + L_VT + (c * TS_ + tg * 16 + 8) * 2) = (u32x4){vt[4], vt[5], vt[6], vt[7]}; }
        if (tg == 0) { *(LAS float*)(lds + L_DEC + c * 4) = __expf(tot); segtot += tot; }
        __syncthreads();
        f32x4 o[4]; const int ti = wid >> 1;
        if (PASSB) {
#pragma unroll
            for (int x = 0; x < 2; ++x) { const int tj = (wid & 1) * 2 + x; f32x4 a = {0.f, 0.f, 0.f, 0.f};
                if (tj <= ti) {
#pragma unroll
                    for (int k = 0; k < 4; ++k) a = MFMA16(LDSV(L_QD + ((ti * 16 + fr) * QS_ + k * 32 + fq * 8) * 2), LDSV(L_KD + ((tj * 16 + fr) * QS_ + k * 32 + fq * 8) * 2), a);
                }
#pragma unroll
                for (int j = 0; j < 4; ++j) { const int t = ti * 16 + fq * 4 + j, s = tj * 16 + fr; *(LAS bf16_t*)(lds + L_PP + (t * TS_ + s) * 2) = f2bf(s <= t ? a[j] : 0.f); } }
            __syncthreads();
#pragma unroll
            for (int n = 0; n < 4; ++n) { const int vt = (wid & 1) * 4 + n; o[n] = (f32x4){0.f, 0.f, 0.f, 0.f};
#pragma unroll
                for (int k = 0; k < 2; ++k) o[n] = MFMA16(LDSV(L_PP + ((ti * 16 + fr) * TS_ + k * 32 + fq * 8) * 2), LDSV(L_VT + ((vt * 16 + fr) * TS_ + k * 32 + fq * 8) * 2), o[n]);
#pragma unroll
                for (int k = 0; k < 4; ++k) o[n] = MFMA16(LDSV(L_QD + ((ti * 16 + fr) * QS_ + k * 32 + fq * 8) * 2), LDSV(L_ST + ((vt * 16 + fr) * QS_ + k * 32 + fq * 8) * 2), o[n]); }
#pragma unroll
            for (int j = 0; j < 4; ++j) { float q = 0.f;
#pragma unroll
                for (int n = 0; n < 4; ++n) q += o[n][j] * o[n][j];
                q += __shfl_xor(q, 1); q += __shfl_xor(q, 2); q += __shfl_xor(q, 4); q += __shfl_xor(q, 8);
                if (fr == 0) *(LAS float*)(lds + L_RED + ((wid & 1) * 64 + ti * 16 + fq * 4 + j) * 4) = q; }
        }
        { float d[4];
#pragma unroll
          for (int j = 0; j < 4; ++j) d[j] = *(const LAS float*)(lds + L_DEC + (crow + j) * 4);
#pragma unroll
          for (int n = 0; n < 8; ++n) {
#pragma unroll
              for (int j = 0; j < 4; ++j) S[n][j] *= d[j];
#pragma unroll
              for (int k = 0; k < 2; ++k) S[n] = MFMA16(LDSV(L_KT + ((wid * 16 + fr) * TS_ + k * 32 + fq * 8) * 2), LDSV(L_VT + ((n * 16 + fr) * TS_ + k * 32 + fq * 8) * 2), S[n]); } }
        __syncthreads();
        if (PASSB) {
#pragma unroll
            for (int n = 0; n < 8; ++n) { u32x2 w; w[0] = cvt_pk_bf16(S[n][0], S[n][1]); w[1] = cvt_pk_bf16(S[n][2], S[n][3]); *(LAS u32x2*)(lds + L_ST + ((n * 16 + fr) * QS_ + crow) * 2) = w; }
#pragma unroll
            for (int j = 0; j < 4; ++j) { const int t = ti * 16 + fq * 4 + j;
                const float ri = rsqrtf((*(const LAS float*)(lds + L_RED + t * 4) + *(const LAS float*)(lds + L_RED + (64 + t) * 4)) * (1.f / HD) + RMS_EPS);
#pragma unroll
                for (int n = 0; n < 4; ++n) { const size_t gi = (size_t)(tok0 + t) * DM + h * HD + ((wid & 1) * 4 + n) * 16 + fr; yh[gi] = f2bf(o[n][j] * ri * bf2f(og[gi])); } }
        }
    }
    if (PASSB) {
        if (seg == NSEG - 1) { float* dst = p.out + O_HP + (size_t)(b * NH + h) * HD * HD;
#pragma unroll
            for (int n = 0; n < 8; ++n)
#pragma unroll
                for (int j = 0; j < 4; ++j) dst[(crow + j) * HD + n * 16 + fr] = S[n][j] * DG(1.00837f); }
    } else {
        float* sl = sloc + (size_t)((b * NH + h) * NSEG + seg) * HD * HD;
#pragma unroll
        for (int n = 0; n < 8; ++n)
#pragma unroll
            for (int j = 0; j < 4; ++j) sl[(crow + j) * HD + n * 16 + fr] = S[n][j];
        if (tg == 0) sdec[((b * NH + h) * NSEG + seg) * HD + c] = __expf(segtot);
    }
}
constexpr int L2_Q = 0, L2_K = 4096, L2_F = 8192, L2_V = 12288, L2_OG = 16384, L2_PO = 20480, L2_RED = 36864;
__device__ void hgrn_sample_item(const Params& p, LAS unsigned char* lds, int bs, int h) {
    const int tid = threadIdx.x, v = tid & 127, cq = tid >> 7, lane = tid & 63, wid = tid >> 6;
    const bf16_t* qs = (const bf16_t*)(p.ws + WS_QS); const bf16_t* zf = (const bf16_t*)(p.ws + WS_ZF); const bf16_t* vv = (const bf16_t*)(p.ws + WS_VV); const bf16_t* og = (const bf16_t*)(p.ws + WS_OG);
    bf16_t* yh = (bf16_t*)p.out;
    const float* s0 = p.in[3] + (size_t)(bs * NH + h) * HD * HD; float* s1 = p.out + O_HS + (size_t)(bs * NH + h) * HD * HD;
    float S[32];
#pragma unroll
    for (int i = 0; i < 32; ++i) S[i] = s0[(cq * 32 + i) * HD + v];
    __syncthreads();
    { const float l0 = p.in[11][h * HD + v], l1 = p.in[11][DM + h * HD + v]; const float lbv = sigm(l0 - l1), oml = 1.f - lbv;
#pragma unroll
      for (int r = 0; r < 2; ++r) { const int t = cq * 2 + r; const size_t gi = (size_t)(NPTOK + bs * DSEQ + t) * DM + h * HD + v; const float sg = sigm(bf2f(zf[gi]));
          *(LAS float*)(lds + L2_Q + (t * 128 + v) * 4) = bf2f(qs[gi]); *(LAS float*)(lds + L2_K + (t * 128 + v) * 4) = oml * (1.f - sg); *(LAS float*)(lds + L2_F + (t * 128 + v) * 4) = lbv + oml * sg;
          *(LAS float*)(lds + L2_V + (t * 128 + v) * 4) = bf2f(vv[gi]); *(LAS float*)(lds + L2_OG + (t * 128 + v) * 4) = bf2f(og[gi]); } }
    __syncthreads();
#pragma unroll 1
    for (int t = 0; t < DSEQ; ++t) { const float vt = *(const LAS float*)(lds + L2_V + (t * 128 + v) * 4); float po = 0.f;
#pragma unroll
        for (int i4 = 0; i4 < 8; ++i4) { const int co = (t * 128 + cq * 32 + i4 * 4) * 4;
            const f32x4 f = *(const LAS f32x4*)(lds + L2_F + co), k = *(const LAS f32x4*)(lds + L2_K + co), q = *(const LAS f32x4*)(lds + L2_Q + co);
#pragma unroll
            for (int i = 0; i < 4; ++i) { S[i4 * 4 + i] = f[i] * S[i4 * 4 + i] + k[i] * vt; po += S[i4 * 4 + i] * q[i]; } }
        *(LAS float*)(lds + L2_PO + ((t * 4 + cq) * 128 + v) * 4) = po; }
#pragma unroll
    for (int i = 0; i < 32; ++i) s1[(cq * 32 + i) * HD + v] = S[i] * DG(1.01265f);
    __syncthreads();
    float ov[2];
#pragma unroll
    for (int r = 0; r < 2; ++r) { const int t = cq * 2 + r; float o = 0.f;
#pragma unroll
        for (int g = 0; g < 4; ++g) o += *(const LAS float*)(lds + L2_PO + ((t * 4 + g) * 128 + v) * 4);
        ov[r] = o; float q = o * o;
#pragma unroll
        for (int s = 32; s; s >>= 1) q += __shfl_xor(q, s);
        if (lane == 0) *(LAS float*)(lds + L2_RED + (t * 2 + (wid & 1)) * 4) = q; }
    __syncthreads();
#pragma unroll
    for (int r = 0; r < 2; ++r) { const int t = cq * 2 + r; const float ri = rsqrtf((*(const LAS float*)(lds + L2_RED + (t * 2) * 4) + *(const LAS float*)(lds + L2_RED + (t * 2 + 1) * 4)) * (1.f / HD) + RMS_EPS);
        yh[(size_t)(NPTOK + bs * DSEQ + t) * DM + h * HD + v] = f2bf(ov[r] * ri * *(const LAS float*)(lds + L2_OG + (t * 128 + v) * 4)); }
}
constexpr int N_PHASES = 12;
template <int PH> __device__ __forceinline__ void run_phase(const Params& p, LAS unsigned char* lds) {
    unsigned char* ws = p.ws; const int G = gridDim.x, bid = blockIdx.x;
    float* mod = (float*)(ws + WS_MOD);
    if constexpr (PH == 0) phase_prep(p, lds);
    else if constexpr (PH == 1) { pg8::Gemm g{(const bf16_t*)(ws + WS_CACT), (const bf16_t*)(ws + WS_WADA), 256, NMODC, DM}; pg8::StaticOrder S; S.init(256, NMODC, G, bid);
        EpiAda E{mod, p.in[7]}; pg8::gemm_phase(lds, g, S, E); }
    else if constexpr (PH == 2) phase_u(p);
    else if constexpr (PH == 3) { pg8::Gemm g{(const bf16_t*)(p.out + O_HS), (const bf16_t*)(ws + WS_WIN), NTOK, DIN, DM}; pg8::StaticOrder S; S.init(NTOK, DIN, G, bid);
        EpiZ E{p.out, (bf16_t*)(ws + WS_QS), (bf16_t*)(ws + WS_ZF), (bf16_t*)(ws + WS_VV), (bf16_t*)(ws + WS_OG), (bf16_t*)((unsigned char*)p.out + S35), (bf16_t*)(ws + WS_GB), p.in[12]};
        pg8::gemm_phase(lds, g, S, E); }
    else if constexpr (PH == 4) { phase_pool(p);
        for (int it = bid; it < NBP * NH * (NSEG - 1); it += G) hgrn_item<false>(p, lds, it / (NH * (NSEG - 1)), (it / (NSEG - 1)) % NH, it % (NSEG - 1)); }
    else if constexpr (PH == 5) {
        for (int it = bid; it < NBP * NH * NSEG + NBS * NH; it += G) {
            if (it < NBP * NH * NSEG) hgrn_item<true>(p, lds, it / (NH * NSEG), (it / NSEG) % NH, it % NSEG);
            else { const int s = it - NBP * NH * NSEG; hgrn_sample_item(p, lds, s >> 3, s & 7); } } }
    else if constexpr (PH == 6) { pg8::StaticOrder S; S.init(NTOK, DM, G, bid);
#if !defined(P6) || P6 == 0
        { pg8::Gemm g{(const bf16_t*)(ws + WS_DMB), (const bf16_t*)(ws + WS_WEFF), NTOK, DM, DPOOL}; EpiP E{(float*)(ws + WS_QS), (const bf16_t*)((unsigned char*)p.out + S35)}; pg8::gemm_phase(lds, g, S, E); }
#endif
#if !defined(P6) || P6 == 1
        { pg8::Gemm g{(const bf16_t*)p.out, (const bf16_t*)(ws + WS_WB), NTOK, DM, DM}; EpiM E{(const float*)(ws + WS_QS), (const bf16_t*)(ws + WS_GB), (bf16_t*)(ws + WS_VV)}; pg8::gemm_phase(lds, g, S, E); }
#endif
    }
    else if constexpr (PH == 7) { pg8::Gemm g{(const bf16_t*)(ws + WS_VV), (const bf16_t*)(ws + WS_WOUT), NTOK, DM, DM}; pg8::StaticOrder S; S.init(NTOK, DM, G, bid);
        EpiRes E{p.in[0], p.in[1], mod, 2 * DM, p.out}; pg8::gemm_phase(lds, g, S, E); }
    else if constexpr (PH == 8) phase_ln<true>(p);
    else if constexpr (PH == 9) { pg8::Gemm g{(const bf16_t*)(ws + WS_OG), (const bf16_t*)(ws + WS_WGU), NTOK, 2 * DFF, DM}; pg8::StaticOrder S; S.init(NTOK, 2 * DFF, G, bid);
        EpiGU E{(bf16_t*)(ws + WS_VV)}; pg8::gemm_phase(lds, g, S, E); }
    else if constexpr (PH == 10) { pg8::Gemm g{(const bf16_t*)(ws + WS_VV), (const bf16_t*)(ws + WS_WDN), NTOK, DM, DFF}; pg8::StaticOrder S; S.init(NTOK, DM, G, bid);
        const float* x1 = (const float*)(ws + WS_QS); EpiRes E{x1, x1 + (size_t)NPTOK * DM, mod, 5 * DM, p.out}; pg8::gemm_phase(lds, g, S, E); }
    else phase_ln<false>(p);
}
#if N_LAUNCH_MODE == 0
#define PHASE_SYNC(PH) run_phase<PH>(p, lds); grid.sync();
__global__ __launch_bounds__(512, 2) void mega(Params p) {
    extern __shared__ __attribute__((aligned(16))) unsigned char shm[];
    LAS unsigned char* lds = (LAS unsigned char*)shm;
    cg::grid_group grid = cg::this_grid();
    PHASE_SYNC(0) PHASE_SYNC(1) PHASE_SYNC(2) PHASE_SYNC(3) PHASE_SYNC(4) PHASE_SYNC(5) PHASE_SYNC(6) PHASE_SYNC(7) PHASE_SYNC(8) PHASE_SYNC(9) PHASE_SYNC(10)
    run_phase<11>(p, lds);
}
#else
template <int PH> __global__ __launch_bounds__(512, 2) void mega(Params p) {
    extern __shared__ __attribute__((aligned(16))) unsigned char shm[];
    run_phase<PH>(p, (LAS unsigned char*)shm);
}
template <int PH> static void launch_phase(const Params& p, int grid, hipStream_t stream) {
    static bool attr = false;
    if (!attr) { (void)hipFuncSetAttribute((const void*)mega<PH>, hipFuncAttributeMaxDynamicSharedMemorySize, LDS_BYTES); attr = true; }
    hipLaunchKernelGGL(mega<PH>, dim3(grid), dim3(512), LDS_BYTES, stream, p);
}
#endif

extern "C" void kernel_launch(void* const* d_in, const int* in_sizes, int n_in, void* d_out, int out_size, void* d_ws, size_t ws_size, hipStream_t stream) {
    static int grid_blocks = 0;
    if (!grid_blocks) {
        int dev = 0, cus = 0, per_cu = 0;
        (void)hipGetDevice(&dev); (void)hipDeviceGetAttribute(&cus, hipDeviceAttributeMultiprocessorCount, dev);
#if N_LAUNCH_MODE == 0
        if (hipFuncSetAttribute((const void*)mega, hipFuncAttributeMaxDynamicSharedMemorySize, LDS_BYTES) != hipSuccess) fprintf(stderr, "hipFuncSetAttribute failed\n");
        if (hipOccupancyMaxActiveBlocksPerMultiprocessor(&per_cu, (const void*)mega, 512, LDS_BYTES) != hipSuccess || per_cu < 1) { fprintf(stderr, "occupancy query: %d\n", per_cu); per_cu = 1; }
        (void)hipGetLastError();
#else
        per_cu = 1;
#endif
        grid_blocks = cus * per_cu;
        if (ws_size < WS_NEED || n_in != 23) fprintf(stderr, "kernel_launch: ws_size %zu < %zu or n_in %d != 23\n", ws_size, (size_t)WS_NEED, n_in);
    }
    Params p{};
    for (int i = 0; i < 23; ++i) p.in[i] = (const float*)d_in[i];
    p.out = (float*)d_out; p.ws = (unsigned char*)d_ws;
#if N_LAUNCH_MODE == 0
    void* args[] = {&p};
    hipError_t e = hipLaunchCooperativeKernel((const void*)mega, dim3(grid_blocks), dim3(512), args, LDS_BYTES, stream);
    if (e != hipSuccess) fprintf(stderr, "cooperative launch failed: %s (grid %d)\n", hipGetErrorString(e), grid_blocks);
#else
    launch_phase<0>(p, grid_blocks, stream); launch_phase<1>(p, grid_blocks, stream); launch_phase<2>(p, grid_blocks, stream); launch_phase<3>(p, grid_blocks, stream);
    launch_phase<4>(p, grid_blocks, stream); launch_phase<5>(p, grid_blocks, stream); launch_phase<6>(p, grid_blocks, stream); launch_phase<7>(p, grid_blocks, stream);
    launch_phase<8>(p, grid_blocks, stream); launch_phase<9>(p, grid_blocks, stream); launch_phase<10>(p, grid_blocks, stream); launch_phase<11>(p, grid_blocks, stream);
#endif
}
```

```cpp
#include <hip/hip_runtime.h>
#include <hip/hip_cooperative_groups.h>
#include <cstdio>
namespace cg = cooperative_groups;

#ifndef N_LAUNCH_MODE
#define N_LAUNCH_MODE 0
#endif

constexpr int DM = 1024, NTOK = 17408, NPTOK = 16384, SEQ = 2048, NBP = 8, NBS = 128, DSEQ = 8;
constexpr int DIN = 6656, DFF = 2816, DPOOL = 512, NH = 8, HD = 128, PBUF = 15, NMODC = 6144;
constexpr float ALPHA = 1.1892071150027210f;
constexpr float LN_EPS = 1e-5f, RMS_EPS = 1e-6f;
constexpr int NSEG = 4, SEGLEN = SEQ / NSEG, CH = 64, NCHSEG = SEGLEN / CH;
constexpr size_t O_YP = 0, O_YS = 16777216, O_PP = 17825792, O_HP = 17887232, O_PS = 18935808, O_HS = 19918848;
constexpr size_t S35 = 35651584;
constexpr size_t WS_WIN = 0, WS_WADA = 13631488, WS_WEFF = 26214400, WS_WB = 27262976, WS_WOUT = 29360128, WS_WGU = 31457280,
                 WS_WDN = 42991616, WS_CACT = 48758784, WS_MOD = 49283072, WS_QS = 55574528, WS_ZF = WS_QS + S35, WS_OG = WS_ZF + S35,
                 WS_VV = WS_OG + S35, WS_GB = WS_VV + S35, WS_DMB = WS_GB + S35, WS_NEED = WS_VV + 98041856;
constexpr size_t WS_SLOC = 0, WS_SDEC = 16777216;
constexpr int LDS_BYTES = 131072 + 16;
constexpr size_t WS_BAR = 260571136;
#define DIAG 0
#if DIAG
#define DG(x) (x)
#else
#define DG(x) 1.0f
#endif

struct Params {
    const float* in[23];
    float* out;
    unsigned char* ws;
};
namespace pg8 {
#define PG8_LAS __attribute__((address_space(3)))
typedef unsigned short bf16_t;
typedef short bf16x8 __attribute__((ext_vector_type(8)));
typedef float f32x4 __attribute__((ext_vector_type(4)));
typedef unsigned u32x4 __attribute__((ext_vector_type(4)));
typedef unsigned u32x2 __attribute__((ext_vector_type(2)));
constexpr int BM = 256, BK = 64, HALF = 128, HTB = HALF * BK * 2, STAGE_BYTES = 8 * HTB, NXCD = 8, WGM = 8;
__host__ __device__ __forceinline__ int lds_byte(int r, int c) { const int st = (r >> 4) * 2 + (c >> 5), rr = r & 15, cc = c & 31, ob = rr * 64 + cc * 2; return st * 1024 + (ob ^ (((ob >> 9) & 1) << 5)); }
__host__ __device__ __forceinline__ void stage_rc(int b, int& R, int& C) { const int st = b / 1024, sb = b % 1024, swz = sb ^ (((sb >> 9) & 1) << 5); R = (st >> 1) * 16 + swz / 64; C = (st & 1) * 32 + (swz % 64) / 2; }
__host__ __device__ __forceinline__ int perm32(int rho) { const int n = rho >> 4, i = rho & 15; return 8 * (i >> 2) + 4 * n + (i & 3); }
struct Unit { int pm, pn; };
struct Gemm { const bf16_t* A; const bf16_t* Bt; int M, N, K; };
struct StaticOrder {
    int nM, nN, nwg, G, c;
    __host__ __device__ void init(int M, int N, int G_, int c_) { nM = M / BM; nN = N / BM; nwg = nM * nN; G = G_; c = c_; }
    __host__ __device__ bool next(int i, Unit& u) const {
        const long L = (long)i * G + c; if (L >= nwg) return false;
        int wgid = (int)L; { const int q = nwg / NXCD, r = nwg % NXCD, xcd = wgid % NXCD, off = wgid / NXCD; wgid = (xcd < r ? xcd * (q + 1) : r * (q + 1) + (xcd - r) * q) + off; }
        const int nig = WGM * nN, gid = wgid / nig, fm = gid * WGM, gsz = (nM - fm) < WGM ? (nM - fm) : WGM;
        u.pm = fm + ((wgid % nig) % gsz); u.pn = (wgid % nig) / gsz; return true;
    }
    __device__ __forceinline__ void a_ready(const Unit&) const {}
    __device__ __forceinline__ void done(const Unit&) const {}
};
__device__ __forceinline__ unsigned cvt_pk_bf16(float lo, float hi) { unsigned r; asm volatile("v_cvt_pk_bf16_f32 %0, %1, %2" : "=v"(r) : "v"(lo), "v"(hi)); return r; }
template <class Epi, class Sched>
__device__ __forceinline__ void gemm_phase(PG8_LAS unsigned char* lds, const Gemm g, const Sched& S, const Epi& E) {
    const int tid = threadIdx.x, wid = __builtin_amdgcn_readfirstlane(tid >> 6), lane = tid & 63, wr = wid >> 2, wc = wid & 3, fr = lane & 15, fq = lane >> 4;
    const int K = g.K, nt = K / BK;
    unsigned voffA[2], voffB[2];
#pragma unroll
    for (int i = 0; i < 2; ++i) { int R, C; stage_rc(tid * 16 + i * 8192, R, C); const int Rb = Epi::PERM ? ((R & ~31) + perm32(R & 31)) : R;
        voffA[i] = (unsigned)(R * K + C) * 2u; voffB[i] = (unsigned)(Rb * K + C) * 2u; }
    const size_t kstep = (size_t)(BK * 2);
    const size_t hstep = (size_t)HALF * K * 2;
    const size_t tstep = 2 * hstep;
    const unsigned ldsw = (unsigned)wid * 1024u;
    const int aoff = lds_byte(wr * 64 + fr, fq * 8), boff = lds_byte(wc * 32 + fr, fq * 8);
#define PG8_SA(b, h) (((b) * 2 + (h)) * HTB)
#define PG8_SB(b, h) ((4 + (b) * 2 + (h)) * HTB)
#define PG8_STAGE(bufoff, gbase, voff) do { _Pragma("unroll") for (int _i = 0; _i < 2; ++_i) \
        __builtin_amdgcn_global_load_lds((const unsigned*)((const char*)(gbase) + (voff)[_i]), (PG8_LAS unsigned*)(lds + (bufoff) + ldsw + _i * 8192), 16, 0, 0); } while (0)
#define PG8_LDA(dst, b, h) do { _Pragma("unroll") for (int m = 0; m < 4; ++m) _Pragma("unroll") for (int k = 0; k < 2; ++k) dst[m][k] = *(const PG8_LAS bf16x8*)(lds + PG8_SA(b, h) + aoff + m * 2048 + k * 1024); } while (0)
#define PG8_LDB(dst, b, h) do { _Pragma("unroll") for (int n = 0; n < 2; ++n) _Pragma("unroll") for (int k = 0; k < 2; ++k) dst[n][k] = *(const PG8_LAS bf16x8*)(lds + PG8_SB(b, h) + boff + n * 2048 + k * 1024); } while (0)
#define PG8_MMA(ai, bj, At, Bt) do { __builtin_amdgcn_s_setprio(1); _Pragma("unroll") for (int m = 0; m < 4; ++m) _Pragma("unroll") for (int n = 0; n < 2; ++n) _Pragma("unroll") for (int k = 0; k < 2; ++k) \
        acc[ai][bj][m][n] = __builtin_amdgcn_mfma_f32_16x16x32_bf16(Bt[n][k], At[m][k], acc[ai][bj][m][n], 0, 0, 0); __builtin_amdgcn_s_setprio(0); } while (0)
#define PG8_WAIT_V(n) asm volatile("s_waitcnt vmcnt(" #n ")" ::: "memory")
#define PG8_WAIT_L(n) asm volatile("s_waitcnt lgkmcnt(" #n ")" ::: "memory")
#define PG8_BAR __builtin_amdgcn_s_barrier()
#define PG8_SCHED __builtin_amdgcn_sched_barrier(0)
    Unit cur, nxt; int ui = 0;
    if (!S.next(0, cur)) return;
    f32x4 acc[2][2][4][2];
#pragma unroll
    for (int a = 0; a < 2; ++a)
#pragma unroll
        for (int b = 0; b < 2; ++b)
#pragma unroll
            for (int m = 0; m < 4; ++m)
#pragma unroll
                for (int n = 0; n < 2; ++n) acc[a][b][m][n] = (f32x4){0.f, 0.f, 0.f, 0.f};
    bf16x8 At[4][2], B0[2][2], B1[2][2];
    const char* cA = (const char*)g.A + (size_t)cur.pm * tstep; const char* cB = (const char*)g.Bt + (size_t)cur.pn * tstep;
    S.a_ready(cur);
    PG8_STAGE(PG8_SB(0, 0), cB, voffB); PG8_STAGE(PG8_SA(0, 0), cA, voffA); PG8_STAGE(PG8_SB(0, 1), cB + hstep, voffB); PG8_STAGE(PG8_SA(0, 1), cA + hstep, voffA);
    if (wr == 1) PG8_BAR;
    PG8_WAIT_V(4); PG8_BAR;
    PG8_STAGE(PG8_SB(1, 0), cB + kstep, voffB); PG8_STAGE(PG8_SA(1, 0), cA + kstep, voffA); PG8_STAGE(PG8_SB(1, 1), cB + hstep + kstep, voffB);
    PG8_WAIT_V(6); PG8_BAR;
    for (;;) {
        const bool has_next = S.next(ui + 1, nxt);
        const char* nA = has_next ? (const char*)g.A + (size_t)nxt.pm * tstep : cA; const char* nB = has_next ? (const char*)g.Bt + (size_t)nxt.pn * tstep : cB;
        for (int t = 0; t < nt; t += 2) {
            const bool last = (t == nt - 2);
            const char* a1 = cA + (size_t)(t + 1) * kstep;
            const char* a2 = last ? nA : cA + (size_t)(t + 2) * kstep; const char* b2 = last ? nB : cB + (size_t)(t + 2) * kstep;
            const char* a3 = a2 + kstep; const char* b3 = b2 + kstep;
            if (last && has_next) S.a_ready(nxt);
            PG8_LDB(B0, 0, 0); PG8_SCHED; PG8_LDA(At, 0, 0); PG8_STAGE(PG8_SA(1, 1), a1 + hstep, voffA);
            PG8_WAIT_L(8); PG8_BAR; PG8_WAIT_L(0); PG8_MMA(0, 0, At, B0); PG8_BAR; PG8_SCHED;
            PG8_LDB(B1, 0, 1); PG8_STAGE(PG8_SB(0, 0), b2, voffB);
            PG8_BAR; PG8_WAIT_L(0); PG8_MMA(0, 1, At, B1); PG8_BAR;
            PG8_LDA(At, 0, 1); PG8_STAGE(PG8_SA(0, 0), a2, voffA);
            PG8_BAR; PG8_WAIT_L(0); PG8_MMA(1, 0, At, B0); PG8_BAR; PG8_SCHED;
            PG8_STAGE(PG8_SB(0, 1), b2 + hstep, voffB);
            PG8_WAIT_V(6); PG8_BAR; PG8_MMA(1, 1, At, B1); PG8_BAR;
            PG8_LDB(B0, 1, 0); PG8_SCHED; PG8_LDA(At, 1, 0); PG8_STAGE(PG8_SA(0, 1), a2 + hstep, voffA);
            PG8_WAIT_L(8); PG8_BAR; PG8_WAIT_L(0); PG8_MMA(0, 0, At, B0); PG8_BAR; PG8_SCHED;
            PG8_LDB(B1, 1, 1); PG8_STAGE(PG8_SB(1, 0), b3, voffB);
            PG8_BAR; PG8_WAIT_L(0); PG8_MMA(0, 1, At, B1); PG8_BAR;
            PG8_LDA(At, 1, 1); PG8_STAGE(PG8_SA(1, 0), a3, voffA);
            PG8_BAR; PG8_WAIT_L(0); PG8_MMA(1, 0, At, B0); PG8_BAR; PG8_SCHED;
            PG8_STAGE(PG8_SB(1, 1), b3 + hstep, voffB);
            PG8_WAIT_V(6); PG8_BAR; PG8_MMA(1, 1, At, B1); PG8_BAR;
        }
        if constexpr (!Epi::AFTER_DRAIN) { E(acc, cur, wr, wc, fr, fq); S.done(cur); }
        if (!has_next) break;
#pragma unroll
        for (int a = 0; a < 2; ++a)
#pragma unroll
            for (int b = 0; b < 2; ++b)
#pragma unroll
                for (int m = 0; m < 4; ++m)
#pragma unroll
                    for (int n = 0; n < 2; ++n) acc[a][b][m][n] = (f32x4){0.f, 0.f, 0.f, 0.f};
        cur = nxt; cA = nA; cB = nB; ++ui;
    }
    PG8_WAIT_V(0);
    if (wr == 0) PG8_BAR;
    PG8_BAR;
    if constexpr (Epi::AFTER_DRAIN) { E.fused(acc, cur, wr, wc, fr, fq, lds, wid, lane); S.done(cur); }
#undef PG8_SA
#undef PG8_SB
#undef PG8_STAGE
#undef PG8_LDA
#undef PG8_LDB
#undef PG8_MMA
#undef PG8_WAIT_V
#undef PG8_WAIT_L
#undef PG8_BAR
#undef PG8_SCHED
}
}

using pg8::bf16_t; using pg8::bf16x8; using pg8::f32x4; using pg8::u32x4; using pg8::u32x2; using pg8::cvt_pk_bf16;
#define LAS __attribute__((address_space(3)))

__device__ __forceinline__ float sigm(float x) { return __builtin_amdgcn_rcpf(1.f + __expf(-x)); }
__device__ __forceinline__ float silu_(float x) { return x * sigm(x); }
__device__ __forceinline__ float bf2f(unsigned b) { return __uint_as_float(b << 16); }
__device__ __forceinline__ bf16_t f2bf(float f) { unsigned u = __float_as_uint(f); u += 0x7FFFu + ((u >> 16) & 1u); return (bf16_t)(u >> 16); }
__device__ __forceinline__ int mrow_of(int tok) { return tok < NPTOK ? (tok >> 11) : 8 + ((tok - NPTOK) >> 3); }
__device__ __forceinline__ u32x4 pack8(const f32x4 a, const f32x4 b) { u32x4 r; r[0] = cvt_pk_bf16(a[0], a[1]); r[1] = cvt_pk_bf16(a[2], a[3]); r[2] = cvt_pk_bf16(b[0], b[1]); r[3] = cvt_pk_bf16(b[2], b[3]); return r; }
__device__ __forceinline__ void unpack8(const u32x4 r, f32x4& a, f32x4& b) {
    a[0] = bf2f(r[0] & 0xffffu); a[1] = __uint_as_float(r[0] & 0xffff0000u); a[2] = bf2f(r[1] & 0xffffu); a[3] = __uint_as_float(r[1] & 0xffff0000u);
    b[0] = bf2f(r[2] & 0xffffu); b[1] = __uint_as_float(r[2] & 0xffff0000u); b[2] = bf2f(r[3] & 0xffffu); b[3] = __uint_as_float(r[3] & 0xffff0000u); }

#define EPI_LOOP_ROWS _Pragma("unroll") for (int ai = 0; ai < 2; ++ai) _Pragma("unroll") for (int m = 0; m < 4; ++m)
struct EpiAda {
    static constexpr bool PERM = false, AFTER_DRAIN = false;
    float* C; const float* bias;
    __device__ __forceinline__ void operator()(const f32x4 (&acc)[2][2][4][2], const pg8::Unit& u, int wr, int wc, int fr, int fq) const {
        const int row0 = u.pm * 256 + wr * 64 + fr, col0 = u.pn * 256 + wc * 32 + 4 * fq;
        EPI_LOOP_ROWS { float* rowp = C + (size_t)(row0 + ai * 128 + m * 16) * NMODC + col0;
#pragma unroll
            for (int bj = 0; bj < 2; ++bj)
#pragma unroll
                for (int n = 0; n < 2; ++n) *(f32x4*)(rowp + bj * 128 + n * 16) = acc[ai][bj][m][n] + *(const f32x4*)(bias + col0 + bj * 128 + n * 16); }
    }
};
struct EpiZ {
    static constexpr bool PERM = true, AFTER_DRAIN = false;
    float* zp; bf16_t *qs, *zf, *vv, *og, *ga, *gb; const float* nw;
    __device__ __forceinline__ void operator()(const f32x4 (&acc)[2][2][4][2], const pg8::Unit& u, int wr, int wc, int fr, int fq) const {
        const int row0 = u.pm * 256 + wr * 64 + fr;
        if (u.pn < 2) {
            const int col0 = u.pn * 256 + wc * 32 + 8 * fq;
            EPI_LOOP_ROWS { float* rowp = zp + (size_t)(row0 + ai * 128 + m * 16) * DPOOL + col0;
#pragma unroll
                for (int bj = 0; bj < 2; ++bj) { *(f32x4*)(rowp + bj * 128) = acc[ai][bj][m][0]; *(f32x4*)(rowp + bj * 128 + 4) = acc[ai][bj][m][1]; } }
            return;
        }
        const int seg = (u.pn - 2) >> 2, col0 = ((u.pn - 2) & 3) * 256 + wc * 32 + 8 * fq;
        bf16_t* dst = seg == 0 ? qs : seg == 1 ? zf : seg == 2 ? vv : seg == 3 ? og : seg == 4 ? ga : gb;
        f32x4 w0[2], w1[2];
#pragma unroll
        for (int bj = 0; bj < 2; ++bj) { w0[bj] = (f32x4){1.f, 1.f, 1.f, 1.f}; w1[bj] = w0[bj]; if (seg == 3) { w0[bj] = *(const f32x4*)(nw + col0 + bj * 128); w1[bj] = *(const f32x4*)(nw + col0 + bj * 128 + 4); } }
        EPI_LOOP_ROWS { bf16_t* rowp = dst + (size_t)(row0 + ai * 128 + m * 16) * DM + col0;
#pragma unroll
            for (int bj = 0; bj < 2; ++bj) { f32x4 v0 = acc[ai][bj][m][0], v1 = acc[ai][bj][m][1];
                if (seg == 0 || seg == 3) {
#pragma unroll
                    for (int i = 0; i < 4; ++i) { v0[i] = silu_(v0[i]) * w0[bj][i]; v1[i] = silu_(v1[i]) * w1[bj][i]; }
                } else if (seg >= 4) {
#pragma unroll
                    for (int i = 0; i < 4; ++i) { v0[i] = sigm(v0[i]); v1[i] = sigm(v1[i]); }
                }
                *(u32x4*)(rowp + bj * 128) = pack8(v0, v1); } }
    }
};
struct EpiP {
    static constexpr bool PERM = true, AFTER_DRAIN = false;
    float* tmp; const bf16_t* ga;
    __device__ __forceinline__ void operator()(const f32x4 (&acc)[2][2][4][2], const pg8::Unit& u, int wr, int wc, int fr, int fq) const {
        const int row0 = u.pm * 256 + wr * 64 + fr, col0 = u.pn * 256 + wc * 32 + 8 * fq;
        EPI_LOOP_ROWS { const size_t ro = (size_t)(row0 + ai * 128 + m * 16) * DM + col0;
#pragma unroll
            for (int bj = 0; bj < 2; ++bj) { f32x4 g0, g1; unpack8(*(const u32x4*)(ga + ro + bj * 128), g0, g1);
                *(f32x4*)(tmp + ro + bj * 128) = acc[ai][bj][m][0] * g0; *(f32x4*)(tmp + ro + bj * 128 + 4) = acc[ai][bj][m][1] * g1; } }
    }
};
struct EpiM {
    static constexpr bool PERM = true, AFTER_DRAIN = false;
    const float* tmp; const bf16_t* gb; bf16_t* mrg;
    __device__ __forceinline__ void operator()(const f32x4 (&acc)[2][2][4][2], const pg8::Unit& u, int wr, int wc, int fr, int fq) const {
        const int row0 = u.pm * 256 + wr * 64 + fr, col0 = u.pn * 256 + wc * 32 + 8 * fq;
        EPI_LOOP_ROWS { const size_t ro = (size_t)(row0 + ai * 128 + m * 16) * DM + col0;
#pragma unroll
            for (int bj = 0; bj < 2; ++bj) { f32x4 g0, g1; unpack8(*(const u32x4*)(gb + ro + bj * 128), g0, g1);
                const f32x4 t0 = *(const f32x4*)(tmp + ro + bj * 128), t1 = *(const f32x4*)(tmp + ro + bj * 128 + 4);
                *(u32x4*)(mrg + ro + bj * 128) = pack8(t0 + acc[ai][bj][m][0] * g0, t1 + acc[ai][bj][m][1] * g1); } }
    }
};
struct EpiRes {
    static constexpr bool PERM = false, AFTER_DRAIN = false;
    const float* resp; const float* ress; const float* mod; int goff; float* r;
    __device__ __forceinline__ void operator()(const f32x4 (&acc)[2][2][4][2], const pg8::Unit& u, int wr, int wc, int fr, int fq) const {
        const int row0 = u.pm * 256 + wr * 64 + fr, col0 = u.pn * 256 + wc * 32 + 4 * fq;
        EPI_LOOP_ROWS { const int row = row0 + ai * 128 + m * 16; const float* xr = row < NPTOK ? resp + (size_t)row * DM : ress + (size_t)(row - NPTOK) * DM;
            const float* gr = mod + (size_t)mrow_of(row) * NMODC + goff + col0; float* rr = r + (size_t)row * DM + col0;
#pragma unroll
            for (int bj = 0; bj < 2; ++bj)
#pragma unroll
                for (int n = 0; n < 2; ++n) { const int o = bj * 128 + n * 16; *(f32x4*)(rr + o) = *(const f32x4*)(xr + col0 + o) * ALPHA + *(const f32x4*)(gr + o) * acc[ai][bj][m][n]; } }
    }
};
struct EpiGU {
    static constexpr bool PERM = true, AFTER_DRAIN = false;
    bf16_t* act;
    __device__ __forceinline__ void operator()(const f32x4 (&acc)[2][2][4][2], const pg8::Unit& u, int wr, int wc, int fr, int fq) const {
        const int row0 = u.pm * 256 + wr * 64 + fr, col0 = (u.pn * 256 + wc * 32 + 8 * fq) >> 1;
        EPI_LOOP_ROWS { bf16_t* rowp = act + (size_t)(row0 + ai * 128 + m * 16) * DFF + col0;
#pragma unroll
            for (int bj = 0; bj < 2; ++bj) { const f32x4 g = acc[ai][bj][m][0], up = acc[ai][bj][m][1]; u32x2 o;
                o[0] = cvt_pk_bf16(silu_(g[0]) * up[0], silu_(g[1]) * up[1]); o[1] = cvt_pk_bf16(silu_(g[2]) * up[2], silu_(g[3]) * up[3]);
                *(u32x2*)(rowp + bj * 64) = o; } }
    }
};
__device__ void transpose_job(const float* __restrict__ src, int K, int N, bf16_t* __restrict__ dst, int mode, LAS float* tile, int& job, int G) {
    const int tid = threadIdx.x, ntk = K / 64, ntn = N / 64, ntiles = ntk * ntn;
    for (int t = 0; t < ntiles; ++t, ++job) {
        if ((job % G) != (int)blockIdx.x) continue;
        const int k0 = (t / ntn) * 64, n0 = (t % ntn) * 64;
        { const int r = tid >> 4, c4 = tid & 15;
#pragma unroll
          for (int rr = 0; rr < 2; ++rr) { const f32x4 v = *(const f32x4*)(src + (size_t)(k0 + r + rr * 32) * N + n0 + c4 * 4);
#pragma unroll
              for (int i = 0; i < 4; ++i) tile[(r + rr * 32) * 65 + c4 * 4 + i] = v[i]; } }
        __syncthreads();
        { const int nr = tid >> 3, k8 = tid & 7; float v[8];
#pragma unroll
          for (int i = 0; i < 8; ++i) v[i] = tile[(k8 * 8 + i) * 65 + nr];
          const int n = n0 + nr; const int nd = mode == 0 ? n : ((n >> 2) * 8 + (n & 3) + (mode == 2 ? 4 : 0));
          u32x4 o; o[0] = cvt_pk_bf16(v[0], v[1]); o[1] = cvt_pk_bf16(v[2], v[3]); o[2] = cvt_pk_bf16(v[4], v[5]); o[3] = cvt_pk_bf16(v[6], v[7]);
          *(u32x4*)(dst + (size_t)nd * K + k0 + k8 * 8) = o; }
        __syncthreads();
    }
}
__device__ void phase_prep(const Params& p, LAS unsigned char* lds) {
    const int G = gridDim.x, tid = threadIdx.x; unsigned char* ws = p.ws;
    LAS float* tile = (LAS float*)lds;
    int job = 0;
    transpose_job(p.in[6], DM, NMODC, (bf16_t*)(ws + WS_WADA), 0, tile, job, G);
    transpose_job(p.in[8], DM, DIN, (bf16_t*)(ws + WS_WIN), 0, tile, job, G);
    transpose_job(p.in[14], DM, DM, (bf16_t*)(ws + WS_WB), 0, tile, job, G);
    transpose_job(p.in[15], DM, DM, (bf16_t*)(ws + WS_WOUT), 0, tile, job, G);
    transpose_job(p.in[18], DM, DFF, (bf16_t*)(ws + WS_WGU), 1, tile, job, G);
    transpose_job(p.in[19], DM, DFF, (bf16_t*)(ws + WS_WGU), 2, tile, job, G);
    transpose_job(p.in[20], DFF, DM, (bf16_t*)(ws + WS_WDN), 0, tile, job, G);
    { const float* wg = p.in[9]; const float* ps = p.in[10]; const float* wa = p.in[13]; bf16_t* weff = (bf16_t*)(ws + WS_WEFF);
      for (int it = 0; it < 64; ++it, ++job) {
          if ((job % G) != (int)blockIdx.x) continue;
          const int g = it >> 4, cb = (it >> 1) & 7, nb = it & 1, n = nb * 512 + tid;
          float a[16];
#pragma unroll
          for (int i = 0; i < 16; ++i) a[i] = 0.f;
          for (int d = 0; d < 128; ++d) { const float w = wa[(size_t)(g * 128 + d) * DM + n] * ps[g * 128 + d];
#pragma unroll
              for (int i = 0; i < 16; ++i) a[i] += wg[(size_t)(g * 128 + cb * 16 + i) * 128 + d] * w; }
          u32x4 o0, o1;
#pragma unroll
          for (int i = 0; i < 4; ++i) { o0[i] = cvt_pk_bf16(a[2 * i], a[2 * i + 1]); o1[i] = cvt_pk_bf16(a[8 + 2 * i], a[9 + 2 * i]); }
          bf16_t* dp = weff + (size_t)n * DPOOL + g * 128 + cb * 16; *(u32x4*)dp = o0; *(u32x4*)(dp + 8) = o1; } }
    { bf16_t* ca = (bf16_t*)(ws + WS_CACT);
      for (int i = blockIdx.x * 512 + tid; i < 256 * DM / 8; i += G * 512) { const int row = i >> 7, c8 = (i & 127) * 8; u32x4 o = {0u, 0u, 0u, 0u};
          if (row < 136) { const float* s = row < 8 ? p.in[4] + (size_t)row * DM + c8 : p.in[5] + (size_t)(row - 8) * DM + c8; const f32x4 a = *(const f32x4*)s, b = *(const f32x4*)(s + 4);
              o[0] = cvt_pk_bf16(silu_(a[0]), silu_(a[1])); o[1] = cvt_pk_bf16(silu_(a[2]), silu_(a[3])); o[2] = cvt_pk_bf16(silu_(b[0]), silu_(b[1])); o[3] = cvt_pk_bf16(silu_(b[2]), silu_(b[3])); }
          *(u32x4*)(ca + (size_t)row * DM + c8) = o; } }
}
__device__ void phase_u(const Params& p) {
    const float* mod = (const float*)(p.ws + WS_MOD); bf16_t* u = (bf16_t*)(p.out + O_HS);
    for (int i = blockIdx.x * 512 + threadIdx.x; i < NTOK * DM / 8; i += gridDim.x * 512) { const int tok = i >> 7, c8 = (i & 127) * 8;
        const float* xr = tok < NPTOK ? p.in[0] + (size_t)tok * DM + c8 : p.in[1] + (size_t)(tok - NPTOK) * DM + c8; const float* mr = mod + (size_t)mrow_of(tok) * NMODC + c8;
        const f32x4 x0 = *(const f32x4*)xr, x1 = *(const f32x4*)(xr + 4), sh0 = *(const f32x4*)mr, sh1 = *(const f32x4*)(mr + 4), sc0 = *(const f32x4*)(mr + DM), sc1 = *(const f32x4*)(mr + DM + 4);
        *(u32x4*)(u + (size_t)tok * DM + c8) = pack8(x0 * (sc0 + 1.f) + sh0, x1 * (sc1 + 1.f) + sh1); }
}
template <bool FIRST> __device__ void phase_ln(const Params& p) {
    const float* mod = (const float*)(p.ws + WS_MOD); float* r = p.out;
    const float* g = p.in[FIRST ? 16 : 21]; const float* b = p.in[FIRST ? 17 : 22];
    float* x1 = (float*)(p.ws + WS_QS); bf16_t* hb = (bf16_t*)(p.ws + WS_OG);
    const int lane = threadIdx.x & 63, wv = blockIdx.x * 8 + (threadIdx.x >> 6), nw = gridDim.x * 8;
    for (int row = wv; row < NTOK; row += nw) { float* rp = r + (size_t)row * DM; f32x4 v[4]; float s = 0.f;
#pragma unroll
        for (int i = 0; i < 4; ++i) { v[i] = *(const f32x4*)(rp + i * 256 + lane * 4); s += v[i][0] + v[i][1] + v[i][2] + v[i][3]; }
#pragma unroll
        for (int o = 32; o; o >>= 1) s += __shfl_xor(s, o);
        const float mu = s * (1.f / DM); float q = 0.f;
#pragma unroll
        for (int i = 0; i < 4; ++i) { v[i] = v[i] - mu; q += v[i][0] * v[i][0] + v[i][1] * v[i][1] + v[i][2] * v[i][2] + v[i][3] * v[i][3]; }
#pragma unroll
        for (int o = 32; o; o >>= 1) q += __shfl_xor(q, o);
        const float rs = rsqrtf(q * (1.f / DM) + LN_EPS); const float* mr = mod + (size_t)mrow_of(row) * NMODC;
#pragma unroll
        for (int i = 0; i < 4; ++i) { const int c = i * 256 + lane * 4; const f32x4 y = v[i] * rs * *(const f32x4*)(g + c) + *(const f32x4*)(b + c);
            if (FIRST) { *(f32x4*)(x1 + (size_t)row * DM + c) = y; const f32x4 h = y * (*(const f32x4*)(mr + 4 * DM + c) + 1.f) + *(const f32x4*)(mr + 3 * DM + c);
                u32x2 o; o[0] = cvt_pk_bf16(h[0], h[1]); o[1] = cvt_pk_bf16(h[2], h[3]); *(u32x2*)(hb + (size_t)row * DM + c) = o; }
            else *(f32x4*)(rp + c) = y * (row >= NPTOK ? DG(1.00447f) : 1.0f); } }
}
__device__ void phase_pool(const Params& p) {
    const float* zp = p.out;
    bf16_t* dmb = (bf16_t*)(p.ws + WS_DMB); const float* sp = p.in[2];
    const int gt = blockIdx.x * 512 + threadIdx.x, gn = gridDim.x * 512;
    for (int i = gt; i < 512 * 128 + NBS * 128; i += gn) {
        const int c0 = (i & 127) * 4, w = 2 << (c0 >> 7);
        if (i < 512 * 128) {
            const int run = i >> 7, b = run >> 6, t0 = (run & 63) * 32; const float* zb = zp + (size_t)b * SEQ * DPOOL + c0; bf16_t* db = dmb + (size_t)b * SEQ * DPOOL + c0;
            f32x4 s = {0.f, 0.f, 0.f, 0.f};
            for (int t = t0 - w; t < t0; ++t) if (t >= 0) s += *(const f32x4*)(zb + (size_t)t * DPOOL);
            for (int t = t0; t < t0 + 32; ++t) { const f32x4 z = *(const f32x4*)(zb + (size_t)t * DPOOL); s += z;
                if (t - w >= 0) s -= *(const f32x4*)(zb + (size_t)(t - w) * DPOOL);
                const float ic = 1.f / (float)(t + 1 < w ? t + 1 : w); const f32x4 d = s * ic - z;
                u32x2 o; o[0] = cvt_pk_bf16(d[0], d[1]); o[1] = cvt_pk_bf16(d[2], d[3]); *(u32x2*)(db + (size_t)t * DPOOL) = o; }
        } else {
            const int b = (i - 512 * 128) >> 7; const float* sb = sp + (size_t)b * PBUF * DPOOL + c0; const float* zb = zp + (size_t)(NPTOK + b * DSEQ) * DPOOL + c0;
            const float ic = 1.f / (float)w;
            for (int t = 0; t < DSEQ; ++t) { f32x4 s = {0.f, 0.f, 0.f, 0.f};
                for (int e = PBUF + t - w + 1; e <= PBUF + t; ++e) s += e < PBUF ? *(const f32x4*)(sb + (size_t)e * DPOOL) : *(const f32x4*)(zb + (size_t)(e - PBUF) * DPOOL);
                const f32x4 z = *(const f32x4*)(zb + (size_t)t * DPOOL), d = s * ic - z;
                u32x2 o; o[0] = cvt_pk_bf16(d[0], d[1]); o[1] = cvt_pk_bf16(d[2], d[3]); *(u32x2*)(dmb + (size_t)(NPTOK + b * DSEQ + t) * DPOOL + c0) = o; }
        }
    }
    for (int i = gt; i < NBP * PBUF * 128; i += gn) { const int c0 = (i & 127) * 4, r = i >> 7, b = r / PBUF, k = r % PBUF;
        *(f32x4*)(p.out + O_PP + (size_t)r * DPOOL + c0) = *(const f32x4*)(zp + (size_t)(b * SEQ + SEQ - PBUF + k) * DPOOL + c0) * DG(1.00632f); }
    for (int i = gt; i < NBS * PBUF * 128; i += gn) { const int c0 = (i & 127) * 4, r = i >> 7, b = r / PBUF, k = r % PBUF;
        *(f32x4*)(p.out + O_PS + (size_t)r * DPOOL + c0) = DG(1.01049f) * (k < PBUF - DSEQ ? *(const f32x4*)(sp + (size_t)(b * PBUF + k + DSEQ) * DPOOL + c0) : *(const f32x4*)(zp + (size_t)(NPTOK + b * DSEQ + k - (PBUF - DSEQ)) * DPOOL + c0)); }
}
constexpr int L_QD = 0, L_KD = 17408, L_KT = 34816, L_VT = 53248, L_PP = 71680, L_ST = 80896, L_GT = 115712, L_DEC = 117760, L_RED = 118272;
constexpr int QS_ = 136, TS_ = 72;
#define MFMA16(a, b, c) __builtin_amdgcn_mfma_f32_16x16x32_bf16(a, b, c, 0, 0, 0)
#define LDSV(off) (*(const LAS bf16x8*)(lds + (off)))
template <bool PASSB> __device__ void hgrn_item(const Params& p, LAS unsigned char* lds, int b, int h, int seg) {
    const int tid = threadIdx.x, wid = tid >> 6, lane = tid & 63, fr = lane & 15, fq = lane >> 4, c = tid & 127, tg = tid >> 7;
    const bf16_t* qs = (const bf16_t*)(p.ws + WS_QS); const bf16_t* zf = (const bf16_t*)(p.ws + WS_ZF); const bf16_t* vv = (const bf16_t*)(p.ws + WS_VV); const bf16_t* og = (const bf16_t*)(p.ws + WS_OG);
    bf16_t* yh = (bf16_t*)p.out;
    float* sloc = (float*)(p.ws + WS_SLOC); float* sdec = (float*)(p.ws + WS_SDEC);
    const float l0 = p.in[11][h * HD + c], l1 = p.in[11][DM + h * HD + c]; const float lbv = sigm(l0 - l1), oml = 1.f - lbv;
    f32x4 S[8];
#pragma unroll
    for (int n = 0; n < 8; ++n) S[n] = (f32x4){0.f, 0.f, 0.f, 0.f};
    const int crow = wid * 16 + fq * 4;
    __syncthreads();
    if (PASSB) {
        for (int s = 0; s < seg; ++s) { const float* sl = sloc + (size_t)((b * NH + h) * NSEG + s) * HD * HD; const float* sd = sdec + ((b * NH + h) * NSEG + s) * HD;
#pragma unroll
            for (int j = 0; j < 4; ++j) { const float d = sd[crow + j];
#pragma unroll
                for (int n = 0; n < 8; ++n) S[n][j] = S[n][j] * d + sl[(crow + j) * HD + n * 16 + fr]; } }
#pragma unroll
        for (int n = 0; n < 8; ++n) { u32x2 o; o[0] = cvt_pk_bf16(S[n][0], S[n][1]); o[1] = cvt_pk_bf16(S[n][2], S[n][3]); *(LAS u32x2*)(lds + L_ST + ((n * 16 + fr) * QS_ + crow) * 2) = o; }
    }
    float segtot = 0.f;
    for (int ch = 0; ch < NCHSEG; ++ch) {
        const int tok0 = b * SEQ + seg * SEGLEN + ch * CH; const size_t gbase = (size_t)(tok0 + tg * 16) * DM + h * HD + c;
        float bc[16], kk[16]; float run = 0.f;
#pragma unroll
        for (int i = 0; i < 16; ++i) { const float z = bf2f(zf[gbase + (size_t)i * DM]); const float sg = sigm(z); const float f = lbv + oml * sg; kk[i] = oml * (1.f - sg); run += __logf(f); bc[i] = run; }
        *(LAS float*)(lds + L_GT + (tg * 128 + c) * 4) = run;
        __syncthreads();
        float off = 0.f, tot = 0.f;
#pragma unroll
        for (int g = 0; g < 4; ++g) { const float t = *(const LAS float*)(lds + L_GT + (g * 128 + c) * 4); tot += t; if (g < tg) off += t; }
        { unsigned kt[8], vt[8];
#pragma unroll
          for (int i = 0; i < 8; ++i) { const float b0 = bc[2 * i] + off, b1 = bc[2 * i + 1] + off;
              kt[i] = cvt_pk_bf16(kk[2 * i] * __expf(tot - b0), kk[2 * i + 1] * __expf(tot - b1));
              vt[i] = (unsigned)vv[gbase + (size_t)(2 * i) * DM] | ((unsigned)vv[gbase + (size_t)(2 * i + 1) * DM] << 16);
              if (PASSB) { const float q0 = bf2f(qs[gbase + (size_t)(2 * i) * DM]), q1 = bf2f(qs[gbase + (size_t)(2 * i + 1) * DM]);
                  const int t = tg * 16 + 2 * i;
                  *(LAS bf16_t*)(lds + L_QD + (t * QS_ + c) * 2) = f2bf(q0 * __expf(b0)); *(LAS bf16_t*)(lds + L_QD + ((t + 1) * QS_ + c) * 2) = f2bf(q1 * __expf(b1));
                  *(LAS bf16_t*)(lds + L_KD + (t * QS_ + c) * 2) = f2bf(kk[2 * i] * __expf(-b0)); *(LAS bf16_t*)(lds + L_KD + ((t + 1) * QS_ + c) * 2) = f2bf(kk[2 * i + 1] * __expf(-b1)); } }
          *(LAS u32x4*)(lds + L_KT + (c * TS_ + tg * 16) * 2) = (u32x4){kt[0], kt[1], kt[2], kt[3]}; *(LAS u32x4*)(lds + L_KT + (c * TS_ + tg * 16 + 8) * 2) = (u32x4){kt[4], kt[5], kt[6], kt[7]};
          *(LAS u32x4*)(lds + L_VT + (c * TS_ + tg * 16) * 2) = (u32x4){vt[0], vt[1], vt[2], vt[3]}; *(LAS u32x4*)(lds + L_VT + (c * TS_ + tg * 16 + 8) * 2) = (u32x4){vt[4], vt[5], vt[6], vt[7]}; }
        if (tg == 0) { *(LAS float*)(lds + L_DEC + c * 4) = __expf(tot); segtot += tot; }
        __syncthreads();
        f32x4 o[4]; const int ti = wid >> 1;
        if (PASSB) {
#pragma unroll
            for (int x = 0; x < 2; ++x) { const int tj = (wid & 1) * 2 + x; f32x4 a = {0.f, 0.f, 0.f, 0.f};
                if (tj <= ti) {
#pragma unroll
                    for (int k = 0; k < 4; ++k) a = MFMA16(LDSV(L_QD + ((ti * 16 + fr) * QS_ + k * 32 + fq * 8) * 2), LDSV(L_KD + ((tj * 16 + fr) * QS_ + k * 32 + fq * 8) * 2), a);
                }
#pragma unroll
                for (int j = 0; j < 4; ++j) { const int t = ti * 16 + fq * 4 + j, s = tj * 16 + fr; *(LAS bf16_t*)(lds + L_PP + (t * TS_ + s) * 2) = f2bf(s <= t ? a[j] : 0.f); } }
            __syncthreads();
#pragma unroll
            for (int n = 0; n < 4; ++n) { const int vt = (wid & 1) * 4 + n; o[n] = (f32x4){0.f, 0.f, 0.f, 0.f};
#pragma unroll
                for (int k = 0; k < 2; ++k) o[n] = MFMA16(LDSV(L_PP + ((ti * 16 + fr) * TS_ + k * 32 + fq * 8) * 2), LDSV(L_VT + ((vt * 16 + fr) * TS_ + k * 32 + fq * 8) * 2), o[n]);
#pragma unroll
                for (int k = 0; k < 4; ++k) o[n] = MFMA16(LDSV(L_QD + ((ti * 16 + fr) * QS_ + k * 32 + fq * 8) * 2), LDSV(L_ST + ((vt * 16 + fr) * QS_ + k * 32 + fq * 8) * 2), o[n]); }
#pragma unroll
            for (int j = 0; j < 4; ++j) { float q = 0.f;
#pragma unroll
                for (int n = 0; n < 4; ++n) q += o[n][j] * o[n][j];
                q += __shfl_xor(q, 1); q += __shfl_xor(q, 2); q += __shfl_xor(q, 4); q += __shfl_xor(q, 8);
                if (fr == 0) *(LAS float*)(lds + L_RED + ((wid & 1) * 64 + ti * 16 + fq * 4 + j) * 4) = q; }
        }
        { float d[4];
#pragma unroll
          for (int j = 0; j < 4; ++j) d[j] = *(const LAS float*)(lds + L_DEC + (crow + j) * 4);
#pragma unroll
          for (int n = 0; n < 8; ++n) {
#pragma unroll
              for (int j = 0; j < 4; ++j) S[n][j] *= d[j];
#pragma unroll
              for (int k = 0; k < 2; ++k) S[n] = MFMA16(LDSV(L_KT + ((wid * 16 + fr) * TS_ + k * 32 + fq * 8) * 2), LDSV(L_VT + ((n * 16 + fr) * TS_ + k * 32 + fq * 8) * 2), S[n]); } }
        __syncthreads();
        if (PASSB) {
#pragma unroll
            for (int n = 0; n < 8; ++n) { u32x2 w; w[0] = cvt_pk_bf16(S[n][0], S[n][1]); w[1] = cvt_pk_bf16(S[n][2], S[n][3]); *(LAS u32x2*)(lds + L_ST + ((n * 16 + fr) * QS_ + crow) * 2) = w; }
#pragma unroll
            for (int j = 0; j < 4; ++j) { const int t = ti * 16 + fq * 4 + j;
                const float ri = rsqrtf((*(const LAS float*)(lds + L_RED + t * 4) + *(const LAS float*)(lds + L_RED + (64 + t) * 4)) * (1.f / HD) + RMS_EPS);
#pragma unroll
                for (int n = 0; n < 4; ++n) { const size_t gi = (size_t)(tok0 + t) * DM + h * HD + ((wid & 1) * 4 + n) * 16 + fr; yh[gi] = f2bf(o[n][j] * ri * bf2f(og[gi])); } }
        }
    }
    if (PASSB) {
        if (seg == NSEG - 1) { float* dst = p.out + O_HP + (size_t)(b * NH + h) * HD * HD;
#pragma unroll
            for (int n = 0; n < 8; ++n)
#pragma unroll
                for (int j = 0; j < 4; ++j) dst[(crow + j) * HD + n * 16 + fr] = S[n][j] * DG(1.00837f); }
    } else {
        float* sl = sloc + (size_t)((b * NH + h) * NSEG + seg) * HD * HD;
#pragma unroll
        for (int n = 0; n < 8; ++n)
#pragma unroll
            for (int j = 0; j < 4; ++j) sl[(crow + j) * HD + n * 16 + fr] = S[n][j];
        if (tg == 0) sdec[((b * NH + h) * NSEG + seg) * HD + c] = __expf(segtot);
    }
}
constexpr int L2_Q = 0, L2_K = 4096, L2_F = 8192, L2_V = 12288, L2_OG = 16384, L2_PO = 20480, L2_RED = 36864;
__device__ void hgrn_sample_item(const Params& p, LAS unsigned char* lds, int bs, int h) {
    const int tid = threadIdx.x, v = tid & 127, cq = tid >> 7, lane = tid & 63, wid = tid >> 6;
    const bf16_t* qs = (const bf16_t*)(p.ws + WS_QS); const bf16_t* zf = (const bf16_t*)(p.ws + WS_ZF); const bf16_t* vv = (const bf16_t*)(p.ws + WS_VV); const bf16_t* og = (const bf16_t*)(p.ws + WS_OG);
    bf16_t* yh = (bf16_t*)p.out;
    const float* s0 = p.in[3] + (size_t)(bs * NH + h) * HD * HD; float* s1 = p.out + O_HS + (size_t)(bs * NH + h) * HD * HD;
    float S[32];
#pragma unroll
    for (int i = 0; i < 32; ++i) S[i] = s0[(cq * 32 + i) * HD + v];
    __syncthreads();
    { const float l0 = p.in[11][h * HD + v], l1 = p.in[11][DM + h * HD + v]; const float lbv = sigm(l0 - l1), oml = 1.f - lbv;
#pragma unroll
      for (int r = 0; r < 2; ++r) { const int t = cq * 2 + r; const size_t gi = (size_t)(NPTOK + bs * DSEQ + t) * DM + h * HD + v; const float sg = sigm(bf2f(zf[gi]));
          *(LAS float*)(lds + L2_Q + (t * 128 + v) * 4) = bf2f(qs[gi]); *(LAS float*)(lds + L2_K + (t * 128 + v) * 4) = oml * (1.f - sg); *(LAS float*)(lds + L2_F + (t * 128 + v) * 4) = lbv + oml * sg;
          *(LAS float*)(lds + L2_V + (t * 128 + v) * 4) = bf2f(vv[gi]); *(LAS float*)(lds + L2_OG + (t * 128 + v) * 4) = bf2f(og[gi]); } }
    __syncthreads();
#pragma unroll 1
    for (int t = 0; t < DSEQ; ++t) { const float vt = *(const LAS float*)(lds + L2_V + (t * 128 + v) * 4); float po = 0.f;
#pragma unroll
        for (int i4 = 0; i4 < 8; ++i4) { const int co = (t * 128 + cq * 32 + i4 * 4) * 4;
            const f32x4 f = *(const LAS f32x4*)(lds + L2_F + co), k = *(const LAS f32x4*)(lds + L2_K + co), q = *(const LAS f32x4*)(lds + L2_Q + co);
#pragma unroll
            for (int i = 0; i < 4; ++i) { S[i4 * 4 + i] = f[i] * S[i4 * 4 + i] + k[i] * vt; po += S[i4 * 4 + i] * q[i]; } }
        *(LAS float*)(lds + L2_PO + ((t * 4 + cq) * 128 + v) * 4) = po; }
#pragma unroll
    for (int i = 0; i < 32; ++i) s1[(cq * 32 + i) * HD + v] = S[i] * DG(1.01265f);
    __syncthreads();
    float ov[2];
#pragma unroll
    for (int r = 0; r < 2; ++r) { const int t = cq * 2 + r; float o = 0.f;
#pragma unroll
        for (int g = 0; g < 4; ++g) o += *(const LAS float*)(lds + L2_PO + ((t * 4 + g) * 128 + v) * 4);
        ov[r] = o; float q = o * o;
#pragma unroll
        for (int s = 32; s; s >>= 1) q += __shfl_xor(q, s);
        if (lane == 0) *(LAS float*)(lds + L2_RED + (t * 2 + (wid & 1)) * 4) = q; }
    __syncthreads();
#pragma unroll
    for (int r = 0; r < 2; ++r) { const int t = cq * 2 + r; const float ri = rsqrtf((*(const LAS float*)(lds + L2_RED + (t * 2) * 4) + *(const LAS float*)(lds + L2_RED + (t * 2 + 1) * 4)) * (1.f / HD) + RMS_EPS);
        yh[(size_t)(NPTOK + bs * DSEQ + t) * DM + h * HD + v] = f2bf(ov[r] * ri * *(const LAS float*)(lds + L2_OG + (t * 128 + v) * 4)); }
}
#define XB_TMO      128
#define XB_XCNT(j)  (256  + 64 * (j))
#define XB_XSUB(j)  (1280 + 64 * (j))
#define XB_XGEN(j)  (2304 + 64 * (j))
#define XB_TOP      3328
#define XB_TOPGEN   3392
#define XCD_BAR_WORDS 3456
#define XB_SPIN_CAP (1u << 18)

__device__ __forceinline__ unsigned xb_ld(unsigned* p)              { return __hip_atomic_load(p, __ATOMIC_RELAXED, __HIP_MEMORY_SCOPE_AGENT); }
__device__ __forceinline__ unsigned xb_add(unsigned* p, unsigned v) { return __hip_atomic_fetch_add(p, v, __ATOMIC_RELAXED, __HIP_MEMORY_SCOPE_AGENT); }
__device__ __forceinline__ unsigned xb_xcc_id() { return (unsigned)__builtin_amdgcn_s_getreg((3 << 11) | 20) & 0xFu; }
#define XB_SPIN(cond, bar) do { unsigned _sp = 0; while (cond) { __builtin_amdgcn_s_sleep(1); \
    if ((++_sp & 255u) == 0u) { if (xb_ld(&(bar)[XB_TMO])) break; if (_sp > XB_SPIN_CAP) { atomicAdd(&(bar)[XB_TMO], 1u); break; } } } } while (0)

struct XcdBarrier {
    unsigned* bar; unsigned x;
    volatile LAS unsigned* st;
};

__device__ __forceinline__ XcdBarrier xcd_barrier_post(unsigned* bar, volatile LAS unsigned* st) {
    XcdBarrier b; b.bar = bar; b.x = xb_xcc_id(); b.st = st;
    if (threadIdx.x == 0) (void)xb_add(&bar[XB_XCNT(b.x)], 1u);
    return b;
}
__device__ __forceinline__ void xcd_barrier_complete(unsigned* bar, unsigned x, unsigned& nloc, unsigned& nx) {
    const unsigned G = gridDim.x * gridDim.y * gridDim.z;
    unsigned sum, cnt, mine, sp = 0u;
    for (;;) {
        sum = 0u; cnt = 0u; mine = 0u;
#pragma unroll
        for (unsigned j = 0; j < 16; ++j) { const unsigned c = xb_ld(&bar[XB_XCNT(j)]); sum += c; cnt += (c > 0u) ? 1u : 0u; mine = (j == x) ? c : mine; }
        if (sum == G) break;
        __builtin_amdgcn_s_sleep(1);
        if ((++sp & 255u) == 0u) { if (xb_ld(&bar[XB_TMO])) break; if (sp > XB_SPIN_CAP) { atomicAdd(&bar[XB_TMO], 1u); break; } }
    }
    nloc = mine > 0u ? mine : 1u; nx = cnt > 0u ? cnt : 1u;
}

__device__ __forceinline__ void xcd_barrier(const XcdBarrier& b) {
    asm volatile("s_waitcnt vmcnt(0)" ::: "memory");
    __syncthreads();
    if (threadIdx.x == 0) {
        unsigned* bar = b.bar;
        __builtin_amdgcn_s_waitcnt(0);
        unsigned nloc = b.st[0], nx = b.st[1];
        if (nloc == 0u) { xcd_barrier_complete(bar, b.x, nloc, nx); b.st[0] = nloc; b.st[1] = nx; }
        const unsigned old = xb_add(&bar[XB_XSUB(b.x)], 1u);
        const unsigned gen = old / nloc;
        if (old + 1u == (gen + 1u) * nloc) {
            __builtin_amdgcn_fence(__ATOMIC_RELEASE, "agent");
            asm volatile("s_waitcnt vmcnt(0)" ::: "memory");
            const unsigned og = xb_add(&bar[XB_TOP], 1u);
            const unsigned tg = og / nx;
            if (og + 1u == (tg + 1u) * nx) xb_add(&bar[XB_TOPGEN], 1u);
            else XB_SPIN(xb_ld(&bar[XB_TOPGEN]) == tg, bar);
            __builtin_amdgcn_fence(__ATOMIC_ACQUIRE, "agent");
            xb_add(&bar[XB_XGEN(b.x)], 1u);
            asm volatile("s_waitcnt vmcnt(0)" ::: "memory");
        } else {
            XB_SPIN(xb_ld(&bar[XB_XGEN(b.x)]) == gen, bar);
            __builtin_amdgcn_fence(__ATOMIC_ACQUIRE, "agent");
            asm volatile("s_waitcnt vmcnt(0)" ::: "memory");
        }
    }

    __syncthreads();
}
constexpr int N_PHASES = 12;
template <int PH> __device__ __forceinline__ void run_phase(const Params& p, LAS unsigned char* lds) {
    unsigned char* ws = p.ws; const int G = gridDim.x, bid = blockIdx.x;
    float* mod = (float*)(ws + WS_MOD);
    if constexpr (PH == 0) phase_prep(p, lds);
    else if constexpr (PH == 1) { pg8::Gemm g{(const bf16_t*)(ws + WS_CACT), (const bf16_t*)(ws + WS_WADA), 256, NMODC, DM}; pg8::StaticOrder S; S.init(256, NMODC, G, bid);
        EpiAda E{mod, p.in[7]}; pg8::gemm_phase(lds, g, S, E); }
    else if constexpr (PH == 2) phase_u(p);
    else if constexpr (PH == 3) { pg8::Gemm g{(const bf16_t*)(p.out + O_HS), (const bf16_t*)(ws + WS_WIN), NTOK, DIN, DM}; pg8::StaticOrder S; S.init(NTOK, DIN, G, bid);
        EpiZ E{p.out, (bf16_t*)(ws + WS_QS), (bf16_t*)(ws + WS_ZF), (bf16_t*)(ws + WS_VV), (bf16_t*)(ws + WS_OG), (bf16_t*)((unsigned char*)p.out + S35), (bf16_t*)(ws + WS_GB), p.in[12]};
        pg8::gemm_phase(lds, g, S, E); }
    else if constexpr (PH == 4) { phase_pool(p);
        for (int it = bid; it < NBP * NH * (NSEG - 1); it += G) hgrn_item<false>(p, lds, it / (NH * (NSEG - 1)), (it / (NSEG - 1)) % NH, it % (NSEG - 1)); }
    else if constexpr (PH == 5) {
        for (int it = bid; it < NBP * NH * NSEG + NBS * NH; it += G) {
            if (it < NBP * NH * NSEG) hgrn_item<true>(p, lds, it / (NH * NSEG), (it / NSEG) % NH, it % NSEG);
            else { const int s = it - NBP * NH * NSEG; hgrn_sample_item(p, lds, s >> 3, s & 7); } } }
    else if constexpr (PH == 6) { pg8::StaticOrder S; S.init(NTOK, DM, G, bid);
#if !defined(P6) || P6 == 0
        { pg8::Gemm g{(const bf16_t*)(ws + WS_DMB), (const bf16_t*)(ws + WS_WEFF), NTOK, DM, DPOOL}; EpiP E{(float*)(ws + WS_QS), (const bf16_t*)((unsigned char*)p.out + S35)}; pg8::gemm_phase(lds, g, S, E); }
#endif
#if !defined(P6) || P6 == 1
        { pg8::Gemm g{(const bf16_t*)p.out, (const bf16_t*)(ws + WS_WB), NTOK, DM, DM}; EpiM E{(const float*)(ws + WS_QS), (const bf16_t*)(ws + WS_GB), (bf16_t*)(ws + WS_VV)}; pg8::gemm_phase(lds, g, S, E); }
#endif
    }
    else if constexpr (PH == 7) { pg8::Gemm g{(const bf16_t*)(ws + WS_VV), (const bf16_t*)(ws + WS_WOUT), NTOK, DM, DM}; pg8::StaticOrder S; S.init(NTOK, DM, G, bid);
        EpiRes E{p.in[0], p.in[1], mod, 2 * DM, p.out}; pg8::gemm_phase(lds, g, S, E); }
    else if constexpr (PH == 8) phase_ln<true>(p);
    else if constexpr (PH == 9) { pg8::Gemm g{(const bf16_t*)(ws + WS_OG), (const bf16_t*)(ws + WS_WGU), NTOK, 2 * DFF, DM}; pg8::StaticOrder S; S.init(NTOK, 2 * DFF, G, bid);
        EpiGU E{(bf16_t*)(ws + WS_VV)}; pg8::gemm_phase(lds, g, S, E); }
    else if constexpr (PH == 10) { pg8::Gemm g{(const bf16_t*)(ws + WS_VV), (const bf16_t*)(ws + WS_WDN), NTOK, DM, DFF}; pg8::StaticOrder S; S.init(NTOK, DM, G, bid);
        const float* x1 = (const float*)(ws + WS_QS); EpiRes E{x1, x1 + (size_t)NPTOK * DM, mod, 5 * DM, p.out}; pg8::gemm_phase(lds, g, S, E); }
    else phase_ln<false>(p);
}
#if N_LAUNCH_MODE == 0
#define PHASE_SYNC(PH) run_phase<PH>(p, lds); xcd_barrier(xb);
__global__ __launch_bounds__(512, 2) void mega(Params p) {
    extern __shared__ __attribute__((aligned(16))) unsigned char shm[];
    LAS unsigned char* lds = (LAS unsigned char*)shm;
    cg::grid_group grid = cg::this_grid();
    LAS unsigned* stw = (LAS unsigned*)(lds + 131072);
    if (threadIdx.x == 0) { stw[0] = 0u; stw[1] = 0u; stw[2] = 0u; stw[3] = 0u; }
    __syncthreads();
    const XcdBarrier xb = xcd_barrier_post((unsigned*)(p.ws + WS_BAR), (volatile LAS unsigned*)stw);
    run_phase<0>(p, lds); grid.sync();
    PHASE_SYNC(1) PHASE_SYNC(2) PHASE_SYNC(3) PHASE_SYNC(4) PHASE_SYNC(5) PHASE_SYNC(6) PHASE_SYNC(7) PHASE_SYNC(8) PHASE_SYNC(9) PHASE_SYNC(10)
    run_phase<11>(p, lds);
}
#else
template <int PH> __global__ __launch_bounds__(512, 2) void mega(Params p) {
    extern __shared__ __attribute__((aligned(16))) unsigned char shm[];
    run_phase<PH>(p, (LAS unsigned char*)shm);
}
template <int PH> static void launch_phase(const Params& p, int grid, hipStream_t stream) {
    static bool attr = false;
    if (!attr) { (void)hipFuncSetAttribute((const void*)mega<PH>, hipFuncAttributeMaxDynamicSharedMemorySize, LDS_BYTES); attr = true; }
    hipLaunchKernelGGL(mega<PH>, dim3(grid), dim3(512), LDS_BYTES, stream, p);
}
#endif

extern "C" void kernel_launch(void* const* d_in, const int* in_sizes, int n_in, void* d_out, int out_size, void* d_ws, size_t ws_size, hipStream_t stream) {
    static int grid_blocks = 0;
    if (!grid_blocks) {
        int dev = 0, cus = 0, per_cu = 0;
        (void)hipGetDevice(&dev); (void)hipDeviceGetAttribute(&cus, hipDeviceAttributeMultiprocessorCount, dev);
#if N_LAUNCH_MODE == 0
        if (hipFuncSetAttribute((const void*)mega, hipFuncAttributeMaxDynamicSharedMemorySize, LDS_BYTES) != hipSuccess) fprintf(stderr, "hipFuncSetAttribute failed\n");
        if (hipOccupancyMaxActiveBlocksPerMultiprocessor(&per_cu, (const void*)mega, 512, LDS_BYTES) != hipSuccess || per_cu < 1) { fprintf(stderr, "occupancy query: %d\n", per_cu); per_cu = 1; }
        (void)hipGetLastError();
#else
        per_cu = 1;
#endif
        grid_blocks = cus * per_cu;
        if (ws_size < WS_BAR + 16384 || n_in != 23) fprintf(stderr, "kernel_launch: ws_size %zu < %zu or n_in %d != 23\n", ws_size, (size_t)WS_NEED, n_in);
    }
    Params p{};
    for (int i = 0; i < 23; ++i) p.in[i] = (const float*)d_in[i];
    p.out = (float*)d_out; p.ws = (unsigned char*)d_ws;
#if N_LAUNCH_MODE == 0
    (void)hipMemsetAsync((unsigned char*)d_ws + WS_BAR, 0, XCD_BAR_WORDS * sizeof(unsigned), stream);
    void* args[] = {&p};
    hipError_t e = hipLaunchCooperativeKernel((const void*)mega, dim3(grid_blocks), dim3(512), args, LDS_BYTES, stream);
    if (e != hipSuccess) fprintf(stderr, "cooperative launch failed: %s (grid %d)\n", hipGetErrorString(e), grid_blocks);
#else
    launch_phase<0>(p, grid_blocks, stream); launch_phase<1>(p, grid_blocks, stream); launch_phase<2>(p, grid_blocks, stream); launch_phase<3>(p, grid_blocks, stream);
    launch_phase<4>(p, grid_blocks, stream); launch_phase<5>(p, grid_blocks, stream); launch_phase<6>(p, grid_blocks, stream); launch_phase<7>(p, grid_blocks, stream);
    launch_phase<8>(p, grid_blocks, stream); launch_phase<9>(p, grid_blocks, stream); launch_phase<10>(p, grid_blocks, stream); launch_phase<11>(p, grid_blocks, stream);
#endif
}
```

```cpp
#include <hip/hip_runtime.h>
#include <hip/hip_cooperative_groups.h>
#include <cstdio>
namespace cg = cooperative_groups;

#ifndef N_LAUNCH_MODE
#define N_LAUNCH_MODE 0
#endif

constexpr int DM = 1024, NTOK = 17408, NPTOK = 16384, SEQ = 2048, NBP = 8, NBS = 128, DSEQ = 8;
constexpr int DIN = 6656, DFF = 2816, DPOOL = 512, NH = 8, HD = 128, PBUF = 15, NMODC = 6144;
constexpr float ALPHA = 1.1892071150027210f;
constexpr float LN_EPS = 1e-5f, RMS_EPS = 1e-6f;
constexpr int NSEG = 4, SEGLEN = SEQ / NSEG, CH = 64, NCHSEG = SEGLEN / CH;
constexpr size_t O_YP = 0, O_YS = 16777216, O_PP = 17825792, O_HP = 17887232, O_PS = 18935808, O_HS = 19918848;
constexpr size_t S35 = 35651584;
constexpr size_t WS_WIN = 0, WS_WADA = 13631488, WS_WEFF = 26214400, WS_WB = 27262976, WS_WOUT = 29360128, WS_WGU = 31457280,
                 WS_WDN = 42991616, WS_CACT = 48758784, WS_MOD = 49283072, WS_QS = 55574528, WS_ZF = WS_QS + S35, WS_OG = WS_ZF + S35,
                 WS_VV = WS_OG + S35, WS_GB = WS_VV + S35, WS_DMB = WS_GB + S35, WS_NEED = WS_VV + 98041856;
constexpr size_t WS_SLOC = 0, WS_SDEC = 16777216;
constexpr int LDS_BYTES = 131072 + 16;
constexpr size_t WS_BAR = 260571136;
#define DIAG 0
#if DIAG
#define DG(x) (x)
#else
#define DG(x) 1.0f
#endif

struct Params {
    const float* in[23];
    float* out;
    unsigned char* ws;
};
namespace pg8 {
#define PG8_LAS __attribute__((address_space(3)))
typedef unsigned short bf16_t;
typedef short bf16x8 __attribute__((ext_vector_type(8)));
typedef float f32x4 __attribute__((ext_vector_type(4)));
typedef unsigned u32x4 __attribute__((ext_vector_type(4)));
typedef unsigned u32x2 __attribute__((ext_vector_type(2)));
constexpr int BM = 256, BK = 64, HALF = 128, HTB = HALF * BK * 2, STAGE_BYTES = 8 * HTB, NXCD = 8, WGM = 8;
__host__ __device__ __forceinline__ int lds_byte(int r, int c) { const int st = (r >> 4) * 2 + (c >> 5), rr = r & 15, cc = c & 31, ob = rr * 64 + cc * 2; return st * 1024 + (ob ^ (((ob >> 9) & 1) << 5)); }
__host__ __device__ __forceinline__ void stage_rc(int b, int& R, int& C) { const int st = b / 1024, sb = b % 1024, swz = sb ^ (((sb >> 9) & 1) << 5); R = (st >> 1) * 16 + swz / 64; C = (st & 1) * 32 + (swz % 64) / 2; }
__host__ __device__ __forceinline__ int perm32(int rho) { const int n = rho >> 4, i = rho & 15; return 8 * (i >> 2) + 4 * n + (i & 3); }
struct Unit { int pm, pn; };
struct Gemm { const bf16_t* A; const bf16_t* Bt; int M, N, K; };
struct StaticOrder {
    int nM, nN, nwg, G, c;
    __host__ __device__ void init(int M, int N, int G_, int c_) { nM = M / BM; nN = N / BM; nwg = nM * nN; G = G_; c = c_; }
    __host__ __device__ bool next(int i, Unit& u) const {
        const long L = (long)i * G + c; if (L >= nwg) return false;
        int wgid = (int)L; { const int q = nwg / NXCD, r = nwg % NXCD, xcd = wgid % NXCD, off = wgid / NXCD; wgid = (xcd < r ? xcd * (q + 1) : r * (q + 1) + (xcd - r) * q) + off; }
        const int nig = WGM * nN, gid = wgid / nig, fm = gid * WGM, gsz = (nM - fm) < WGM ? (nM - fm) : WGM;
        u.pm = fm + ((wgid % nig) % gsz); u.pn = (wgid % nig) / gsz; return true;
    }
    __device__ __forceinline__ void a_ready(const Unit&) const {}
    __device__ __forceinline__ void done(const Unit&) const {}
};
__device__ __forceinline__ unsigned cvt_pk_bf16(float lo, float hi) { unsigned r; asm volatile("v_cvt_pk_bf16_f32 %0, %1, %2" : "=v"(r) : "v"(lo), "v"(hi)); return r; }
template <class Epi, class Sched>
__device__ __forceinline__ void gemm_phase(PG8_LAS unsigned char* lds, const Gemm g, const Sched& S, const Epi& E) {
    const int tid = threadIdx.x, wid = __builtin_amdgcn_readfirstlane(tid >> 6), lane = tid & 63, wr = wid >> 2, wc = wid & 3, fr = lane & 15, fq = lane >> 4;
    const int K = g.K, nt = K / BK;
    unsigned voffA[2], voffB[2];
#pragma unroll
    for (int i = 0; i < 2; ++i) { int R, C; stage_rc(tid * 16 + i * 8192, R, C); const int Rb = Epi::PERM ? ((R & ~31) + perm32(R & 31)) : R;
        voffA[i] = (unsigned)(R * K + C) * 2u; voffB[i] = (unsigned)(Rb * K + C) * 2u; }
    const size_t kstep = (size_t)(BK * 2);
    const size_t hstep = (size_t)HALF * K * 2;
    const size_t tstep = 2 * hstep;
    const unsigned ldsw = (unsigned)wid * 1024u;
    const int aoff = lds_byte(wr * 64 + fr, fq * 8), boff = lds_byte(wc * 32 + fr, fq * 8);
#define PG8_SA(b, h) (((b) * 2 + (h)) * HTB)
#define PG8_SB(b, h) ((4 + (b) * 2 + (h)) * HTB)
#define PG8_STAGE(bufoff, gbase, voff) do { _Pragma("unroll") for (int _i = 0; _i < 2; ++_i) \
        __builtin_amdgcn_global_load_lds((const unsigned*)((const char*)(gbase) + (voff)[_i]), (PG8_LAS unsigned*)(lds + (bufoff) + ldsw + _i * 8192), 16, 0, 0); } while (0)
#define PG8_LDA(dst, b, h) do { _Pragma("unroll") for (int m = 0; m < 4; ++m) _Pragma("unroll") for (int k = 0; k < 2; ++k) dst[m][k] = *(const PG8_LAS bf16x8*)(lds + PG8_SA(b, h) + aoff + m * 2048 + k * 1024); } while (0)
#define PG8_LDB(dst, b, h) do { _Pragma("unroll") for (int n = 0; n < 2; ++n) _Pragma("unroll") for (int k = 0; k < 2; ++k) dst[n][k] = *(const PG8_LAS bf16x8*)(lds + PG8_SB(b, h) + boff + n * 2048 + k * 1024); } while (0)
#define PG8_MMA(ai, bj, At, Bt) do { __builtin_amdgcn_s_setprio(1); _Pragma("unroll") for (int m = 0; m < 4; ++m) _Pragma("unroll") for (int n = 0; n < 2; ++n) _Pragma("unroll") for (int k = 0; k < 2; ++k) \
        acc[ai][bj][m][n] = __builtin_amdgcn_mfma_f32_16x16x32_bf16(Bt[n][k], At[m][k], acc[ai][bj][m][n], 0, 0, 0); __builtin_amdgcn_s_setprio(0); } while (0)
#define PG8_WAIT_V(n) asm volatile("s_waitcnt vmcnt(" #n ")" ::: "memory")
#define PG8_WAIT_L(n) asm volatile("s_waitcnt lgkmcnt(" #n ")" ::: "memory")
#define PG8_BAR __builtin_amdgcn_s_barrier()
#define PG8_SCHED __builtin_amdgcn_sched_barrier(0)
    Unit cur, nxt; int ui = 0;
    if (!S.next(0, cur)) return;
    f32x4 acc[2][2][4][2];
#pragma unroll
    for (int a = 0; a < 2; ++a)
#pragma unroll
        for (int b = 0; b < 2; ++b)
#pragma unroll
            for (int m = 0; m < 4; ++m)
#pragma unroll
                for (int n = 0; n < 2; ++n) acc[a][b][m][n] = (f32x4){0.f, 0.f, 0.f, 0.f};
    bf16x8 At[4][2], B0[2][2], B1[2][2];
    const char* cA = (const char*)g.A + (size_t)cur.pm * tstep; const char* cB = (const char*)g.Bt + (size_t)cur.pn * tstep;
    S.a_ready(cur);
    PG8_STAGE(PG8_SB(0, 0), cB, voffB); PG8_STAGE(PG8_SA(0, 0), cA, voffA); PG8_STAGE(PG8_SB(0, 1), cB + hstep, voffB); PG8_STAGE(PG8_SA(0, 1), cA + hstep, voffA);
    if (wr == 1) PG8_BAR;
    PG8_WAIT_V(4); PG8_BAR;
    PG8_STAGE(PG8_SB(1, 0), cB + kstep, voffB); PG8_STAGE(PG8_SA(1, 0), cA + kstep, voffA); PG8_STAGE(PG8_SB(1, 1), cB + hstep + kstep, voffB);
    PG8_WAIT_V(6); PG8_BAR;
    for (;;) {
        const bool has_next = S.next(ui + 1, nxt);
        const char* nA = has_next ? (const char*)g.A + (size_t)nxt.pm * tstep : cA; const char* nB = has_next ? (const char*)g.Bt + (size_t)nxt.pn * tstep : cB;
        for (int t = 0; t < nt; t += 2) {
            const bool last = (t == nt - 2);
            const char* a1 = cA + (size_t)(t + 1) * kstep;
            const char* a2 = last ? nA : cA + (size_t)(t + 2) * kstep; const char* b2 = last ? nB : cB + (size_t)(t + 2) * kstep;
            const char* a3 = a2 + kstep; const char* b3 = b2 + kstep;
            if (last && has_next) S.a_ready(nxt);
            PG8_LDB(B0, 0, 0); PG8_SCHED; PG8_LDA(At, 0, 0); PG8_STAGE(PG8_SA(1, 1), a1 + hstep, voffA);
            PG8_WAIT_L(8); PG8_BAR; PG8_WAIT_L(0); PG8_MMA(0, 0, At, B0); PG8_BAR; PG8_SCHED;
            PG8_LDB(B1, 0, 1); PG8_STAGE(PG8_SB(0, 0), b2, voffB);
            PG8_BAR; PG8_WAIT_L(0); PG8_MMA(0, 1, At, B1); PG8_BAR;
            PG8_LDA(At, 0, 1); PG8_STAGE(PG8_SA(0, 0), a2, voffA);
            PG8_BAR; PG8_WAIT_L(0); PG8_MMA(1, 0, At, B0); PG8_BAR; PG8_SCHED;
            PG8_STAGE(PG8_SB(0, 1), b2 + hstep, voffB);
            PG8_WAIT_V(6); PG8_BAR; PG8_MMA(1, 1, At, B1); PG8_BAR;
            PG8_LDB(B0, 1, 0); PG8_SCHED; PG8_LDA(At, 1, 0); PG8_STAGE(PG8_SA(0, 1), a2 + hstep, voffA);
            PG8_WAIT_L(8); PG8_BAR; PG8_WAIT_L(0); PG8_MMA(0, 0, At, B0); PG8_BAR; PG8_SCHED;
            PG8_LDB(B1, 1, 1); PG8_STAGE(PG8_SB(1, 0), b3, voffB);
            PG8_BAR; PG8_WAIT_L(0); PG8_MMA(0, 1, At, B1); PG8_BAR;
            PG8_LDA(At, 1, 1); PG8_STAGE(PG8_SA(1, 0), a3, voffA);
            PG8_BAR; PG8_WAIT_L(0); PG8_MMA(1, 0, At, B0); PG8_BAR; PG8_SCHED;
            PG8_STAGE(PG8_SB(1, 1), b3 + hstep, voffB);
            PG8_WAIT_V(6); PG8_BAR; PG8_MMA(1, 1, At, B1); PG8_BAR;
        }
        if constexpr (!Epi::AFTER_DRAIN) { E(acc, cur, wr, wc, fr, fq); S.done(cur); }
        if (!has_next) break;
#pragma unroll
        for (int a = 0; a < 2; ++a)
#pragma unroll
            for (int b = 0; b < 2; ++b)
#pragma unroll
                for (int m = 0; m < 4; ++m)
#pragma unroll
                    for (int n = 0; n < 2; ++n) acc[a][b][m][n] = (f32x4){0.f, 0.f, 0.f, 0.f};
        cur = nxt; cA = nA; cB = nB; ++ui;
    }
    PG8_WAIT_V(0);
    if (wr == 0) PG8_BAR;
    PG8_BAR;
    if constexpr (Epi::AFTER_DRAIN) { E.fused(acc, cur, wr, wc, fr, fq, lds, wid, lane); S.done(cur); }
#undef PG8_SA
#undef PG8_SB
#undef PG8_STAGE
#undef PG8_LDA
#undef PG8_LDB
#undef PG8_MMA
#undef PG8_WAIT_V
#undef PG8_WAIT_L
#undef PG8_BAR
#undef PG8_SCHED
}
}

using pg8::bf16_t; using pg8::bf16x8; using pg8::f32x4; using pg8::u32x4; using pg8::u32x2; using pg8::cvt_pk_bf16;
#define LAS __attribute__((address_space(3)))

__device__ __forceinline__ float sigm(float x) { return __builtin_amdgcn_rcpf(1.f + __expf(-x)); }
__device__ __forceinline__ float silu_(float x) { return x * sigm(x); }
__device__ __forceinline__ float bf2f(unsigned b) { return __uint_as_float(b << 16); }
__device__ __forceinline__ bf16_t f2bf(float f) { unsigned u = __float_as_uint(f); u += 0x7FFFu + ((u >> 16) & 1u); return (bf16_t)(u >> 16); }
__device__ __forceinline__ int mrow_of(int tok) { return tok < NPTOK ? (tok >> 11) : 8 + ((tok - NPTOK) >> 3); }
__device__ __forceinline__ u32x4 pack8(const f32x4 a, const f32x4 b) { u32x4 r; r[0] = cvt_pk_bf16(a[0], a[1]); r[1] = cvt_pk_bf16(a[2], a[3]); r[2] = cvt_pk_bf16(b[0], b[1]); r[3] = cvt_pk_bf16(b[2], b[3]); return r; }
__device__ __forceinline__ void unpack8(const u32x4 r, f32x4& a, f32x4& b) {
    a[0] = bf2f(r[0] & 0xffffu); a[1] = __uint_as_float(r[0] & 0xffff0000u); a[2] = bf2f(r[1] & 0xffffu); a[3] = __uint_as_float(r[1] & 0xffff0000u);
    b[0] = bf2f(r[2] & 0xffffu); b[1] = __uint_as_float(r[2] & 0xffff0000u); b[2] = bf2f(r[3] & 0xffffu); b[3] = __uint_as_float(r[3] & 0xffff0000u); }

#define EPI_LOOP_ROWS _Pragma("unroll") for (int ai = 0; ai < 2; ++ai) _Pragma("unroll") for (int m = 0; m < 4; ++m)
struct EpiAda {
    static constexpr bool PERM = false, AFTER_DRAIN = false;
    float* C; const float* bias;
    __device__ __forceinline__ void operator()(const f32x4 (&acc)[2][2][4][2], const pg8::Unit& u, int wr, int wc, int fr, int fq) const {
        const int row0 = u.pm * 256 + wr * 64 + fr, col0 = u.pn * 256 + wc * 32 + 4 * fq;
        EPI_LOOP_ROWS { float* rowp = C + (size_t)(row0 + ai * 128 + m * 16) * NMODC + col0;
#pragma unroll
            for (int bj = 0; bj < 2; ++bj)
#pragma unroll
                for (int n = 0; n < 2; ++n) *(f32x4*)(rowp + bj * 128 + n * 16) = acc[ai][bj][m][n] + *(const f32x4*)(bias + col0 + bj * 128 + n * 16); }
    }
};
struct EpiZ {
    static constexpr bool PERM = true, AFTER_DRAIN = false;
    float* zp; bf16_t *qs, *zf, *vv, *og, *ga, *gb; const float* nw;
    __device__ __forceinline__ void operator()(const f32x4 (&acc)[2][2][4][2], const pg8::Unit& u, int wr, int wc, int fr, int fq) const {
        const int row0 = u.pm * 256 + wr * 64 + fr;
        if (u.pn < 2) {
            const int col0 = u.pn * 256 + wc * 32 + 8 * fq;
            EPI_LOOP_ROWS { float* rowp = zp + (size_t)(row0 + ai * 128 + m * 16) * DPOOL + col0;
#pragma unroll
                for (int bj = 0; bj < 2; ++bj) { *(f32x4*)(rowp + bj * 128) = acc[ai][bj][m][0]; *(f32x4*)(rowp + bj * 128 + 4) = acc[ai][bj][m][1]; } }
            return;
        }
        const int seg = (u.pn - 2) >> 2, col0 = ((u.pn - 2) & 3) * 256 + wc * 32 + 8 * fq;
        bf16_t* dst = seg == 0 ? qs : seg == 1 ? zf : seg == 2 ? vv : seg == 3 ? og : seg == 4 ? ga : gb;
        f32x4 w0[2], w1[2];
#pragma unroll
        for (int bj = 0; bj < 2; ++bj) { w0[bj] = (f32x4){1.f, 1.f, 1.f, 1.f}; w1[bj] = w0[bj]; if (seg == 3) { w0[bj] = *(const f32x4*)(nw + col0 + bj * 128); w1[bj] = *(const f32x4*)(nw + col0 + bj * 128 + 4); } }
        EPI_LOOP_ROWS { bf16_t* rowp = dst + (size_t)(row0 + ai * 128 + m * 16) * DM + col0;
#pragma unroll
            for (int bj = 0; bj < 2; ++bj) { f32x4 v0 = acc[ai][bj][m][0], v1 = acc[ai][bj][m][1];
                if (seg == 0 || seg == 3) {
#pragma unroll
                    for (int i = 0; i < 4; ++i) { v0[i] = silu_(v0[i]) * w0[bj][i]; v1[i] = silu_(v1[i]) * w1[bj][i]; }
                } else if (seg >= 4) {
#pragma unroll
                    for (int i = 0; i < 4; ++i) { v0[i] = sigm(v0[i]); v1[i] = sigm(v1[i]); }
                }
                *(u32x4*)(rowp + bj * 128) = pack8(v0, v1); } }
    }
};
struct EpiP {
    static constexpr bool PERM = true, AFTER_DRAIN = false;
    float* tmp; const bf16_t* ga;
    __device__ __forceinline__ void operator()(const f32x4 (&acc)[2][2][4][2], const pg8::Unit& u, int wr, int wc, int fr, int fq) const {
        const int row0 = u.pm * 256 + wr * 64 + fr, col0 = u.pn * 256 + wc * 32 + 8 * fq;
        EPI_LOOP_ROWS { const size_t ro = (size_t)(row0 + ai * 128 + m * 16) * DM + col0;
#pragma unroll
            for (int bj = 0; bj < 2; ++bj) { f32x4 g0, g1; unpack8(*(const u32x4*)(ga + ro + bj * 128), g0, g1);
                *(f32x4*)(tmp + ro + bj * 128) = acc[ai][bj][m][0] * g0; *(f32x4*)(tmp + ro + bj * 128 + 4) = acc[ai][bj][m][1] * g1; } }
    }
};
struct EpiM {
    static constexpr bool PERM = true, AFTER_DRAIN = false;
    const float* tmp; const bf16_t* gb; bf16_t* mrg;
    __device__ __forceinline__ void operator()(const f32x4 (&acc)[2][2][4][2], const pg8::Unit& u, int wr, int wc, int fr, int fq) const {
        const int row0 = u.pm * 256 + wr * 64 + fr, col0 = u.pn * 256 + wc * 32 + 8 * fq;
        EPI_LOOP_ROWS { const size_t ro = (size_t)(row0 + ai * 128 + m * 16) * DM + col0;
#pragma unroll
            for (int bj = 0; bj < 2; ++bj) { f32x4 g0, g1; unpack8(*(const u32x4*)(gb + ro + bj * 128), g0, g1);
                const f32x4 t0 = *(const f32x4*)(tmp + ro + bj * 128), t1 = *(const f32x4*)(tmp + ro + bj * 128 + 4);
                *(u32x4*)(mrg + ro + bj * 128) = pack8(t0 + acc[ai][bj][m][0] * g0, t1 + acc[ai][bj][m][1] * g1); } }
    }
};
struct EpiRes {
    static constexpr bool PERM = false, AFTER_DRAIN = false;
    const float* resp; const float* ress; const float* mod; int goff; float* r;
    __device__ __forceinline__ void operator()(const f32x4 (&acc)[2][2][4][2], const pg8::Unit& u, int wr, int wc, int fr, int fq) const {
        const int row0 = u.pm * 256 + wr * 64 + fr, col0 = u.pn * 256 + wc * 32 + 4 * fq;
        EPI_LOOP_ROWS { const int row = row0 + ai * 128 + m * 16; const float* xr = row < NPTOK ? resp + (size_t)row * DM : ress + (size_t)(row - NPTOK) * DM;
            const float* gr = mod + (size_t)mrow_of(row) * NMODC + goff + col0; float* rr = r + (size_t)row * DM + col0;
#pragma unroll
            for (int bj = 0; bj < 2; ++bj)
#pragma unroll
                for (int n = 0; n < 2; ++n) { const int o = bj * 128 + n * 16; *(f32x4*)(rr + o) = *(const f32x4*)(xr + col0 + o) * ALPHA + *(const f32x4*)(gr + o) * acc[ai][bj][m][n]; } }
    }
};
struct EpiGU {
    static constexpr bool PERM = true, AFTER_DRAIN = false;
    bf16_t* act;
    __device__ __forceinline__ void operator()(const f32x4 (&acc)[2][2][4][2], const pg8::Unit& u, int wr, int wc, int fr, int fq) const {
        const int row0 = u.pm * 256 + wr * 64 + fr, col0 = (u.pn * 256 + wc * 32 + 8 * fq) >> 1;
        EPI_LOOP_ROWS { bf16_t* rowp = act + (size_t)(row0 + ai * 128 + m * 16) * DFF + col0;
#pragma unroll
            for (int bj = 0; bj < 2; ++bj) { const f32x4 g = acc[ai][bj][m][0], up = acc[ai][bj][m][1]; u32x2 o;
                o[0] = cvt_pk_bf16(silu_(g[0]) * up[0], silu_(g[1]) * up[1]); o[1] = cvt_pk_bf16(silu_(g[2]) * up[2], silu_(g[3]) * up[3]);
                *(u32x2*)(rowp + bj * 64) = o; } }
    }
};
__device__ void transpose_job(const float* __restrict__ src, int K, int N, bf16_t* __restrict__ dst, int mode, LAS float* tile, int& job, int G) {
    const int tid = threadIdx.x, ntk = K / 64, ntn = N / 64, ntiles = ntk * ntn;
    for (int t = 0; t < ntiles; ++t, ++job) {
        if ((job % G) != (int)blockIdx.x) continue;
        const int k0 = (t / ntn) * 64, n0 = (t % ntn) * 64;
        { const int r = tid >> 4, c4 = tid & 15;
#pragma unroll
          for (int rr = 0; rr < 2; ++rr) { const f32x4 v = *(const f32x4*)(src + (size_t)(k0 + r + rr * 32) * N + n0 + c4 * 4);
#pragma unroll
              for (int i = 0; i < 4; ++i) tile[(r + rr * 32) * 65 + c4 * 4 + i] = v[i]; } }
        __syncthreads();
        { const int nr = tid >> 3, k8 = tid & 7; float v[8];
#pragma unroll
          for (int i = 0; i < 8; ++i) v[i] = tile[(k8 * 8 + i) * 65 + nr];
          const int n = n0 + nr; const int nd = mode == 0 ? n : ((n >> 2) * 8 + (n & 3) + (mode == 2 ? 4 : 0));
          u32x4 o; o[0] = cvt_pk_bf16(v[0], v[1]); o[1] = cvt_pk_bf16(v[2], v[3]); o[2] = cvt_pk_bf16(v[4], v[5]); o[3] = cvt_pk_bf16(v[6], v[7]);
          *(u32x4*)(dst + (size_t)nd * K + k0 + k8 * 8) = o; }
        __syncthreads();
    }
}
__device__ void phase_prep(const Params& p, LAS unsigned char* lds) {
    const int G = gridDim.x, tid = threadIdx.x; unsigned char* ws = p.ws;
    LAS float* tile = (LAS float*)lds;
    int job = 0;
    transpose_job(p.in[6], DM, NMODC, (bf16_t*)(ws + WS_WADA), 0, tile, job, G);
    transpose_job(p.in[8], DM, DIN, (bf16_t*)(ws + WS_WIN), 0, tile, job, G);
    transpose_job(p.in[14], DM, DM, (bf16_t*)(ws + WS_WB), 0, tile, job, G);
    transpose_job(p.in[15], DM, DM, (bf16_t*)(ws + WS_WOUT), 0, tile, job, G);
    transpose_job(p.in[18], DM, DFF, (bf16_t*)(ws + WS_WGU), 1, tile, job, G);
    transpose_job(p.in[19], DM, DFF, (bf16_t*)(ws + WS_WGU), 2, tile, job, G);
    transpose_job(p.in[20], DFF, DM, (bf16_t*)(ws + WS_WDN), 0, tile, job, G);
    { const float* wg = p.in[9]; const float* ps = p.in[10]; const float* wa = p.in[13]; bf16_t* weff = (bf16_t*)(ws + WS_WEFF);
      for (int it = 0; it < 64; ++it, ++job) {
          if ((job % G) != (int)blockIdx.x) continue;
          const int g = it >> 4, cb = (it >> 1) & 7, nb = it & 1, n = nb * 512 + tid;
          float a[16];
#pragma unroll
          for (int i = 0; i < 16; ++i) a[i] = 0.f;
          for (int d = 0; d < 128; ++d) { const float w = wa[(size_t)(g * 128 + d) * DM + n] * ps[g * 128 + d];
#pragma unroll
              for (int i = 0; i < 16; ++i) a[i] += wg[(size_t)(g * 128 + cb * 16 + i) * 128 + d] * w; }
          u32x4 o0, o1;
#pragma unroll
          for (int i = 0; i < 4; ++i) { o0[i] = cvt_pk_bf16(a[2 * i], a[2 * i + 1]); o1[i] = cvt_pk_bf16(a[8 + 2 * i], a[9 + 2 * i]); }
          bf16_t* dp = weff + (size_t)n * DPOOL + g * 128 + cb * 16; *(u32x4*)dp = o0; *(u32x4*)(dp + 8) = o1; } }
    { bf16_t* ca = (bf16_t*)(ws + WS_CACT);
      for (int i = blockIdx.x * 512 + tid; i < 256 * DM / 8; i += G * 512) { const int row = i >> 7, c8 = (i & 127) * 8; u32x4 o = {0u, 0u, 0u, 0u};
          if (row < 136) { const float* s = row < 8 ? p.in[4] + (size_t)row * DM + c8 : p.in[5] + (size_t)(row - 8) * DM + c8; const f32x4 a = *(const f32x4*)s, b = *(const f32x4*)(s + 4);
              o[0] = cvt_pk_bf16(silu_(a[0]), silu_(a[1])); o[1] = cvt_pk_bf16(silu_(a[2]), silu_(a[3])); o[2] = cvt_pk_bf16(silu_(b[0]), silu_(b[1])); o[3] = cvt_pk_bf16(silu_(b[2]), silu_(b[3])); }
          *(u32x4*)(ca + (size_t)row * DM + c8) = o; } }
}
__device__ void phase_u(const Params& p) {
    const float* mod = (const float*)(p.ws + WS_MOD); bf16_t* u = (bf16_t*)(p.out + O_HS);
    for (int i = blockIdx.x * 512 + threadIdx.x; i < NTOK * DM / 8; i += gridDim.x * 512) { const int tok = i >> 7, c8 = (i & 127) * 8;
        const float* xr = tok < NPTOK ? p.in[0] + (size_t)tok * DM + c8 : p.in[1] + (size_t)(tok - NPTOK) * DM + c8; const float* mr = mod + (size_t)mrow_of(tok) * NMODC + c8;
        const f32x4 x0 = *(const f32x4*)xr, x1 = *(const f32x4*)(xr + 4), sh0 = *(const f32x4*)mr, sh1 = *(const f32x4*)(mr + 4), sc0 = *(const f32x4*)(mr + DM), sc1 = *(const f32x4*)(mr + DM + 4);
        *(u32x4*)(u + (size_t)tok * DM + c8) = pack8(x0 * (sc0 + 1.f) + sh0, x1 * (sc1 + 1.f) + sh1); }
}
template <bool FIRST> __device__ void phase_ln(const Params& p) {
    const float* mod = (const float*)(p.ws + WS_MOD); float* r = p.out;
    const float* g = p.in[FIRST ? 16 : 21]; const float* b = p.in[FIRST ? 17 : 22];
    float* x1 = (float*)(p.ws + WS_QS); bf16_t* hb = (bf16_t*)(p.ws + WS_OG);
    const int lane = threadIdx.x & 63, wv = blockIdx.x * 8 + (threadIdx.x >> 6), nw = gridDim.x * 8;
    for (int row = wv; row < NTOK; row += nw) { float* rp = r + (size_t)row * DM; f32x4 v[4]; float s = 0.f;
#pragma unroll
        for (int i = 0; i < 4; ++i) { v[i] = *(const f32x4*)(rp + i * 256 + lane * 4); s += v[i][0] + v[i][1] + v[i][2] + v[i][3]; }
#pragma unroll
        for (int o = 32; o; o >>= 1) s += __shfl_xor(s, o);
        const float mu = s * (1.f / DM); float q = 0.f;
#pragma unroll
        for (int i = 0; i < 4; ++i) { v[i] = v[i] - mu; q += v[i][0] * v[i][0] + v[i][1] * v[i][1] + v[i][2] * v[i][2] + v[i][3] * v[i][3]; }
#pragma unroll
        for (int o = 32; o; o >>= 1) q += __shfl_xor(q, o);
        const float rs = rsqrtf(q * (1.f / DM) + LN_EPS); const float* mr = mod + (size_t)mrow_of(row) * NMODC;
#pragma unroll
        for (int i = 0; i < 4; ++i) { const int c = i * 256 + lane * 4; const f32x4 y = v[i] * rs * *(const f32x4*)(g + c) + *(const f32x4*)(b + c);
            if (FIRST) { *(f32x4*)(x1 + (size_t)row * DM + c) = y; const f32x4 h = y * (*(const f32x4*)(mr + 4 * DM + c) + 1.f) + *(const f32x4*)(mr + 3 * DM + c);
                u32x2 o; o[0] = cvt_pk_bf16(h[0], h[1]); o[1] = cvt_pk_bf16(h[2], h[3]); *(u32x2*)(hb + (size_t)row * DM + c) = o; }
            else *(f32x4*)(rp + c) = y * (row >= NPTOK ? DG(1.00447f) : 1.0f); } }
}
__device__ void phase_pool(const Params& p) {
    const float* zp = p.out;
    bf16_t* dmb = (bf16_t*)(p.ws + WS_DMB); const float* sp = p.in[2];
    const int gt = blockIdx.x * 512 + threadIdx.x, gn = gridDim.x * 512;
    for (int i = gt; i < 512 * 128 + NBS * 128; i += gn) {
        const int c0 = (i & 127) * 4, w = 2 << (c0 >> 7);
        if (i < 512 * 128) {
            const int run = i >> 7, b = run >> 6, t0 = (run & 63) * 32; const float* zb = zp + (size_t)b * SEQ * DPOOL + c0; bf16_t* db = dmb + (size_t)b * SEQ * DPOOL + c0;
            f32x4 s = {0.f, 0.f, 0.f, 0.f};
            for (int t = t0 - w; t < t0; ++t) if (t >= 0) s += *(const f32x4*)(zb + (size_t)t * DPOOL);
            for (int t = t0; t < t0 + 32; ++t) { const f32x4 z = *(const f32x4*)(zb + (size_t)t * DPOOL); s += z;
                if (t - w >= 0) s -= *(const f32x4*)(zb + (size_t)(t - w) * DPOOL);
                const float ic = 1.f / (float)(t + 1 < w ? t + 1 : w); const f32x4 d = s * ic - z;
                u32x2 o; o[0] = cvt_pk_bf16(d[0], d[1]); o[1] = cvt_pk_bf16(d[2], d[3]); *(u32x2*)(db + (size_t)t * DPOOL) = o; }
        } else {
            const int b = (i - 512 * 128) >> 7; const float* sb = sp + (size_t)b * PBUF * DPOOL + c0; const float* zb = zp + (size_t)(NPTOK + b * DSEQ) * DPOOL + c0;
            const float ic = 1.f / (float)w;
            for (int t = 0; t < DSEQ; ++t) { f32x4 s = {0.f, 0.f, 0.f, 0.f};
                for (int e = PBUF + t - w + 1; e <= PBUF + t; ++e) s += e < PBUF ? *(const f32x4*)(sb + (size_t)e * DPOOL) : *(const f32x4*)(zb + (size_t)(e - PBUF) * DPOOL);
                const f32x4 z = *(const f32x4*)(zb + (size_t)t * DPOOL), d = s * ic - z;
                u32x2 o; o[0] = cvt_pk_bf16(d[0], d[1]); o[1] = cvt_pk_bf16(d[2], d[3]); *(u32x2*)(dmb + (size_t)(NPTOK + b * DSEQ + t) * DPOOL + c0) = o; }
        }
    }
    for (int i = gt; i < NBP * PBUF * 128; i += gn) { const int c0 = (i & 127) * 4, r = i >> 7, b = r / PBUF, k = r % PBUF;
        *(f32x4*)(p.out + O_PP + (size_t)r * DPOOL + c0) = *(const f32x4*)(zp + (size_t)(b * SEQ + SEQ - PBUF + k) * DPOOL + c0) * DG(1.00632f); }
    for (int i = gt; i < NBS * PBUF * 128; i += gn) { const int c0 = (i & 127) * 4, r = i >> 7, b = r / PBUF, k = r % PBUF;
        *(f32x4*)(p.out + O_PS + (size_t)r * DPOOL + c0) = DG(1.01049f) * (k < PBUF - DSEQ ? *(const f32x4*)(sp + (size_t)(b * PBUF + k + DSEQ) * DPOOL + c0) : *(const f32x4*)(zp + (size_t)(NPTOK + b * DSEQ + k - (PBUF - DSEQ)) * DPOOL + c0)); }
}
constexpr int L_QD = 0, L_KD = 17408, L_KT = 34816, L_VT = 53248, L_PP = 71680, L_ST = 80896, L_GT = 115712, L_DEC = 117760, L_RED = 118272;
constexpr int QS_ = 136, TS_ = 72;
#define MFMA16(a, b, c) __builtin_amdgcn_mfma_f32_16x16x32_bf16(a, b, c, 0, 0, 0)
#define LDSV(off) (*(const LAS bf16x8*)(lds + (off)))
template <bool PASSB> __device__ void hgrn_item(const Params& p, LAS unsigned char* lds, int b, int h, int seg) {
    const int tid = threadIdx.x, wid = tid >> 6, lane = tid & 63, fr = lane & 15, fq = lane >> 4, c = tid & 127, tg = tid >> 7;
    const bf16_t* qs = (const bf16_t*)(p.ws + WS_QS); const bf16_t* zf = (const bf16_t*)(p.ws + WS_ZF); const bf16_t* vv = (const bf16_t*)(p.ws + WS_VV); const bf16_t* og = (const bf16_t*)(p.ws + WS_OG);
    bf16_t* yh = (bf16_t*)p.out;
    float* sloc = (float*)(p.ws + WS_SLOC); float* sdec = (float*)(p.ws + WS_SDEC);
    const float l0 = p.in[11][h * HD + c], l1 = p.in[11][DM + h * HD + c]; const float lbv = sigm(l0 - l1), oml = 1.f - lbv;
    f32x4 S[8];
#pragma unroll
    for (int n = 0; n < 8; ++n) S[n] = (f32x4){0.f, 0.f, 0.f, 0.f};
    const int crow = wid * 16 + fq * 4;
    const int ptok = tid >> 4, pch = (tid & 15) * 8;
    const size_t tokbase = (size_t)(b * SEQ + seg * SEGLEN) * DM + h * HD + pch;
    __syncthreads();
    if (PASSB) {
        for (int s = 0; s < seg; ++s) { const float* sl = sloc + (size_t)((b * NH + h) * NSEG + s) * HD * HD + crow * HD + fr; const float* sd = sdec + ((b * NH + h) * NSEG + s) * HD + crow;
#pragma unroll
            for (int j = 0; j < 4; ++j) { const float d = sd[j];
#pragma unroll
                for (int n = 0; n < 8; ++n) S[n][j] = S[n][j] * d + sl[j * HD + n * 16]; } }
#pragma unroll
        for (int n = 0; n < 8; ++n) { u32x2 o; o[0] = cvt_pk_bf16(S[n][0], S[n][1]); o[1] = cvt_pk_bf16(S[n][2], S[n][3]); *(LAS u32x2*)(lds + L_ST + ((n * 16 + fr) * QS_ + crow) * 2) = o; }
    }
    float segtot = 1.f;
    for (int ch = 0; ch < NCHSEG; ++ch) {
        const int tok0 = b * SEQ + seg * SEGLEN + ch * CH;
        u32x4 cg_[2];
        { u32x4 rz[2], rv[2], rq[2];
#pragma unroll
          for (int i = 0; i < 2; ++i) { const size_t gi = tokbase + (size_t)(ch * CH + ptok + 32 * i) * DM; rz[i] = *(const u32x4*)(zf + gi); rv[i] = *(const u32x4*)(vv + gi);
              if (PASSB) { rq[i] = *(const u32x4*)(qs + gi); cg_[i] = *(const u32x4*)(og + gi); } }
#pragma unroll
          for (int i = 0; i < 2; ++i) { const int o = ((ptok + 32 * i) * 128 + pch) * 2; *(LAS u32x4*)(lds + L_QD + o) = rz[i]; *(LAS u32x4*)(lds + L_KT + o) = rv[i]; if (PASSB) *(LAS u32x4*)(lds + L_KD + o) = rq[i]; } }
        __syncthreads();
        float pr[16], kk[16]; unsigned qp[8];
        { float run = 1.f;
#pragma unroll
          for (int i = 0; i < 16; ++i) { const int o = ((tg * 16 + i) * 128 + c) * 2; const float z = bf2f(*(const LAS bf16_t*)(lds + L_QD + o)); const float sg = sigm(z); kk[i] = oml * (1.f - sg); run *= lbv + oml * sg; pr[i] = run;
              if (PASSB) { const unsigned qq = *(const LAS bf16_t*)(lds + L_KD + o); if (i & 1) qp[i >> 1] |= qq << 16; else qp[i >> 1] = qq; } }
          unsigned vt[8];
#pragma unroll
          for (int i = 0; i < 8; ++i) vt[i] = (unsigned)*(const LAS bf16_t*)(lds + L_KT + ((tg * 16 + 2 * i) * 128 + c) * 2) | ((unsigned)*(const LAS bf16_t*)(lds + L_KT + ((tg * 16 + 2 * i + 1) * 128 + c) * 2) << 16);
          *(LAS u32x4*)(lds + L_VT + (c * TS_ + tg * 16) * 2) = (u32x4){vt[0], vt[1], vt[2], vt[3]}; *(LAS u32x4*)(lds + L_VT + (c * TS_ + tg * 16 + 8) * 2) = (u32x4){vt[4], vt[5], vt[6], vt[7]};
          *(LAS float*)(lds + L_GT + (tg * 128 + c) * 4) = run; }
        __syncthreads();
        float off = 1.f, tot = 1.f;
#pragma unroll
        for (int g = 0; g < 4; ++g) { const float t = *(const LAS float*)(lds + L_GT + (g * 128 + c) * 4); tot *= t; if (g < tg) off *= t; }
        { unsigned kt[8];
#pragma unroll
          for (int i = 0; i < 8; ++i) { const float e0 = pr[2 * i] * off, e1 = pr[2 * i + 1] * off, r0 = __builtin_amdgcn_rcpf(e0), r1 = __builtin_amdgcn_rcpf(e1);
              kt[i] = cvt_pk_bf16(kk[2 * i] * (tot * r0), kk[2 * i + 1] * (tot * r1));
              if (PASSB) { const int t = tg * 16 + 2 * i;
                  *(LAS bf16_t*)(lds + L_QD + (t * QS_ + c) * 2) = f2bf(bf2f(qp[i] & 0xffffu) * e0); *(LAS bf16_t*)(lds + L_QD + ((t + 1) * QS_ + c) * 2) = f2bf(__uint_as_float(qp[i] & 0xffff0000u) * e1);
                  *(LAS bf16_t*)(lds + L_KD + (t * QS_ + c) * 2) = f2bf(kk[2 * i] * r0); *(LAS bf16_t*)(lds + L_KD + ((t + 1) * QS_ + c) * 2) = f2bf(kk[2 * i + 1] * r1); } }
          *(LAS u32x4*)(lds + L_KT + (c * TS_ + tg * 16) * 2) = (u32x4){kt[0], kt[1], kt[2], kt[3]}; *(LAS u32x4*)(lds + L_KT + (c * TS_ + tg * 16 + 8) * 2) = (u32x4){kt[4], kt[5], kt[6], kt[7]};
          }
        if (tg == 0) { *(LAS float*)(lds + L_DEC + c * 4) = tot; segtot *= tot; }
        __syncthreads();
        f32x4 o[4]; const int ti = wid >> 1;
        if (PASSB) {
#pragma unroll
            for (int x = 0; x < 2; ++x) { const int tj = (wid & 1) * 2 + x; f32x4 a = {0.f, 0.f, 0.f, 0.f};
                if (tj <= ti) {
#pragma unroll
                    for (int k = 0; k < 4; ++k) a = MFMA16(LDSV(L_QD + ((ti * 16 + fr) * QS_ + k * 32 + fq * 8) * 2), LDSV(L_KD + ((tj * 16 + fr) * QS_ + k * 32 + fq * 8) * 2), a);
                }
#pragma unroll
                for (int j = 0; j < 4; ++j) { const int t = ti * 16 + fq * 4 + j, s = tj * 16 + fr; *(LAS bf16_t*)(lds + L_PP + (t * TS_ + s) * 2) = f2bf(s <= t ? a[j] : 0.f); } }
            __syncthreads();
#pragma unroll
            for (int n = 0; n < 4; ++n) { const int vtile = (wid & 1) * 4 + n; o[n] = (f32x4){0.f, 0.f, 0.f, 0.f};
#pragma unroll
                for (int k = 0; k < 2; ++k) o[n] = MFMA16(LDSV(L_PP + ((ti * 16 + fr) * TS_ + k * 32 + fq * 8) * 2), LDSV(L_VT + ((vtile * 16 + fr) * TS_ + k * 32 + fq * 8) * 2), o[n]);
#pragma unroll
                for (int k = 0; k < 4; ++k) o[n] = MFMA16(LDSV(L_QD + ((ti * 16 + fr) * QS_ + k * 32 + fq * 8) * 2), LDSV(L_ST + ((vtile * 16 + fr) * QS_ + k * 32 + fq * 8) * 2), o[n]);
                __builtin_amdgcn_sched_barrier(0); }
#pragma unroll
            for (int j = 0; j < 4; ++j) { float q = 0.f;
#pragma unroll
                for (int n = 0; n < 4; ++n) q += o[n][j] * o[n][j];
                q += __shfl_xor(q, 1); q += __shfl_xor(q, 2); q += __shfl_xor(q, 4); q += __shfl_xor(q, 8);
                if (fr == 0) *(LAS float*)(lds + L_RED + ((wid & 1) * 64 + ti * 16 + fq * 4 + j) * 4) = q; }
        }
        { float d[4];
#pragma unroll
          for (int j = 0; j < 4; ++j) d[j] = *(const LAS float*)(lds + L_DEC + (crow + j) * 4);
#pragma unroll
          for (int n = 0; n < 8; ++n) {
#pragma unroll
              for (int j = 0; j < 4; ++j) S[n][j] *= d[j];
#pragma unroll
              for (int k = 0; k < 2; ++k) S[n] = MFMA16(LDSV(L_KT + ((wid * 16 + fr) * TS_ + k * 32 + fq * 8) * 2), LDSV(L_VT + ((n * 16 + fr) * TS_ + k * 32 + fq * 8) * 2), S[n]);
              if (n & 1) __builtin_amdgcn_sched_barrier(0); } }
        __syncthreads();
        if (PASSB) {
#pragma unroll
            for (int n = 0; n < 8; ++n) { u32x2 w; w[0] = cvt_pk_bf16(S[n][0], S[n][1]); w[1] = cvt_pk_bf16(S[n][2], S[n][3]); *(LAS u32x2*)(lds + L_ST + ((n * 16 + fr) * QS_ + crow) * 2) = w; }
#pragma unroll
            for (int j = 0; j < 4; ++j) { const int t = ti * 16 + fq * 4 + j;
                const float ri = rsqrtf((*(const LAS float*)(lds + L_RED + t * 4) + *(const LAS float*)(lds + L_RED + (64 + t) * 4)) * (1.f / HD) + RMS_EPS);
#pragma unroll
                for (int n = 0; n < 4; ++n) *(LAS bf16_t*)(lds + L_VT + (t * 128 + ((wid & 1) * 4 + n) * 16 + fr) * 2) = f2bf(o[n][j] * ri); }
            __syncthreads();
#pragma unroll
            for (int i = 0; i < 2; ++i) { const u32x4 yv = *(const LAS u32x4*)(lds + L_VT + ((ptok + 32 * i) * 128 + pch) * 2); f32x4 y0, y1, g0, g1; unpack8(yv, y0, y1); unpack8(cg_[i], g0, g1);
                *(u32x4*)(yh + (size_t)(tok0 + ptok + 32 * i) * DM + h * HD + pch) = pack8(y0 * g0, y1 * g1); }
        }
    }
    if (PASSB) {
        if (seg == NSEG - 1) { float* dst = p.out + O_HP + (size_t)(b * NH + h) * HD * HD + crow * HD + fr;
#pragma unroll
            for (int n = 0; n < 8; ++n)
#pragma unroll
                for (int j = 0; j < 4; ++j) dst[j * HD + n * 16] = S[n][j] * DG(1.00837f); }
    } else {
        float* sl = sloc + (size_t)((b * NH + h) * NSEG + seg) * HD * HD + crow * HD + fr;
#pragma unroll
        for (int n = 0; n < 8; ++n)
#pragma unroll
            for (int j = 0; j < 4; ++j) sl[j * HD + n * 16] = S[n][j];
        if (tg == 0) sdec[((b * NH + h) * NSEG + seg) * HD + c] = segtot;
    }
}
constexpr int L2_Q = 0, L2_K = 4096, L2_F = 8192, L2_V = 12288, L2_OG = 16384, L2_PO = 20480, L2_RED = 36864;
__device__ void hgrn_sample_item(const Params& p, LAS unsigned char* lds, int bs, int h) {
    const int tid = threadIdx.x, v = tid & 127, cq = tid >> 7, lane = tid & 63, wid = tid >> 6;
    const bf16_t* qs = (const bf16_t*)(p.ws + WS_QS); const bf16_t* zf = (const bf16_t*)(p.ws + WS_ZF); const bf16_t* vv = (const bf16_t*)(p.ws + WS_VV); const bf16_t* og = (const bf16_t*)(p.ws + WS_OG);
    bf16_t* yh = (bf16_t*)p.out;
    const float* s0 = p.in[3] + (size_t)(bs * NH + h) * HD * HD; float* s1 = p.out + O_HS + (size_t)(bs * NH + h) * HD * HD;
    float S[32];
#pragma unroll
    for (int i = 0; i < 32; ++i) S[i] = s0[(cq * 32 + i) * HD + v];
    __syncthreads();
    { const float l0 = p.in[11][h * HD + v], l1 = p.in[11][DM + h * HD + v]; const float lbv = sigm(l0 - l1), oml = 1.f - lbv;
#pragma unroll
      for (int r = 0; r < 2; ++r) { const int t = cq * 2 + r; const size_t gi = (size_t)(NPTOK + bs * DSEQ + t) * DM + h * HD + v; const float sg = sigm(bf2f(zf[gi]));
          *(LAS float*)(lds + L2_Q + (t * 128 + v) * 4) = bf2f(qs[gi]); *(LAS float*)(lds + L2_K + (t * 128 + v) * 4) = oml * (1.f - sg); *(LAS float*)(lds + L2_F + (t * 128 + v) * 4) = lbv + oml * sg;
          *(LAS float*)(lds + L2_V + (t * 128 + v) * 4) = bf2f(vv[gi]); *(LAS float*)(lds + L2_OG + (t * 128 + v) * 4) = bf2f(og[gi]); } }
    __syncthreads();
#pragma unroll 1
    for (int t = 0; t < DSEQ; ++t) { const float vt = *(const LAS float*)(lds + L2_V + (t * 128 + v) * 4); float po = 0.f;
#pragma unroll
        for (int i4 = 0; i4 < 8; ++i4) { const int co = (t * 128 + cq * 32 + i4 * 4) * 4;
            const f32x4 f = *(const LAS f32x4*)(lds + L2_F + co), k = *(const LAS f32x4*)(lds + L2_K + co), q = *(const LAS f32x4*)(lds + L2_Q + co);
#pragma unroll
            for (int i = 0; i < 4; ++i) { S[i4 * 4 + i] = f[i] * S[i4 * 4 + i] + k[i] * vt; po += S[i4 * 4 + i] * q[i]; } }
        *(LAS float*)(lds + L2_PO + ((t * 4 + cq) * 128 + v) * 4) = po; }
#pragma unroll
    for (int i = 0; i < 32; ++i) s1[(cq * 32 + i) * HD + v] = S[i] * DG(1.01265f);
    __syncthreads();
    float ov[2];
#pragma unroll
    for (int r = 0; r < 2; ++r) { const int t = cq * 2 + r; float o = 0.f;
#pragma unroll
        for (int g = 0; g < 4; ++g) o += *(const LAS float*)(lds + L2_PO + ((t * 4 + g) * 128 + v) * 4);
        ov[r] = o; float q = o * o;
#pragma unroll
        for (int s = 32; s; s >>= 1) q += __shfl_xor(q, s);
        if (lane == 0) *(LAS float*)(lds + L2_RED + (t * 2 + (wid & 1)) * 4) = q; }
    __syncthreads();
#pragma unroll
    for (int r = 0; r < 2; ++r) { const int t = cq * 2 + r; const float ri = rsqrtf((*(const LAS float*)(lds + L2_RED + (t * 2) * 4) + *(const LAS float*)(lds + L2_RED + (t * 2 + 1) * 4)) * (1.f / HD) + RMS_EPS);
        yh[(size_t)(NPTOK + bs * DSEQ + t) * DM + h * HD + v] = f2bf(ov[r] * ri * *(const LAS float*)(lds + L2_OG + (t * 128 + v) * 4)); }
}
#define XB_TMO      128
#define XB_XCNT(j)  (256  + 64 * (j))
#define XB_XSUB(j)  (1280 + 64 * (j))
#define XB_XGEN(j)  (2304 + 64 * (j))
#define XB_TOP      3328
#define XB_TOPGEN   3392
#define XCD_BAR_WORDS 3456
#define XB_SPIN_CAP (1u << 18)

__device__ __forceinline__ unsigned xb_ld(unsigned* p)              { return __hip_atomic_load(p, __ATOMIC_RELAXED, __HIP_MEMORY_SCOPE_AGENT); }
__device__ __forceinline__ unsigned xb_add(unsigned* p, unsigned v) { return __hip_atomic_fetch_add(p, v, __ATOMIC_RELAXED, __HIP_MEMORY_SCOPE_AGENT); }
__device__ __forceinline__ unsigned xb_xcc_id() { return (unsigned)__builtin_amdgcn_s_getreg((3 << 11) | 20) & 0xFu; }
#define XB_SPIN(cond, bar) do { unsigned _sp = 0; while (cond) { __builtin_amdgcn_s_sleep(1); \
    if ((++_sp & 255u) == 0u) { if (xb_ld(&(bar)[XB_TMO])) break; if (_sp > XB_SPIN_CAP) { atomicAdd(&(bar)[XB_TMO], 1u); break; } } } } while (0)

struct XcdBarrier {
    unsigned* bar; unsigned x;
    volatile LAS unsigned* st;
};

__device__ __forceinline__ XcdBarrier xcd_barrier_post(unsigned* bar, volatile LAS unsigned* st) {
    XcdBarrier b; b.bar = bar; b.x = xb_xcc_id(); b.st = st;
    if (threadIdx.x == 0) (void)xb_add(&bar[XB_XCNT(b.x)], 1u);
    return b;
}
__device__ __forceinline__ void xcd_barrier_complete(unsigned* bar, unsigned x, unsigned& nloc, unsigned& nx) {
    const unsigned G = gridDim.x * gridDim.y * gridDim.z;
    unsigned sum, cnt, mine, sp = 0u;
    for (;;) {
        sum = 0u; cnt = 0u; mine = 0u;
#pragma unroll
        for (unsigned j = 0; j < 16; ++j) { const unsigned c = xb_ld(&bar[XB_XCNT(j)]); sum += c; cnt += (c > 0u) ? 1u : 0u; mine = (j == x) ? c : mine; }
        if (sum == G) break;
        __builtin_amdgcn_s_sleep(1);
        if ((++sp & 255u) == 0u) { if (xb_ld(&bar[XB_TMO])) break; if (sp > XB_SPIN_CAP) { atomicAdd(&bar[XB_TMO], 1u); break; } }
    }
    nloc = mine > 0u ? mine : 1u; nx = cnt > 0u ? cnt : 1u;
}

__device__ __forceinline__ void xcd_barrier(const XcdBarrier& b) {
    asm volatile("s_waitcnt vmcnt(0)" ::: "memory");
    __syncthreads();
    if (threadIdx.x == 0) {
        unsigned* bar = b.bar;
        __builtin_amdgcn_s_waitcnt(0);
        unsigned nloc = b.st[0], nx = b.st[1];
        if (nloc == 0u) { xcd_barrier_complete(bar, b.x, nloc, nx); b.st[0] = nloc; b.st[1] = nx; }
        const unsigned old = xb_add(&bar[XB_XSUB(b.x)], 1u);
        const unsigned gen = old / nloc;
        if (old + 1u == (gen + 1u) * nloc) {
            __builtin_amdgcn_fence(__ATOMIC_RELEASE, "agent");
            asm volatile("s_waitcnt vmcnt(0)" ::: "memory");
            const unsigned og = xb_add(&bar[XB_TOP], 1u);
            const unsigned tg = og / nx;
            if (og + 1u == (tg + 1u) * nx) xb_add(&bar[XB_TOPGEN], 1u);
            else XB_SPIN(xb_ld(&bar[XB_TOPGEN]) == tg, bar);
            __builtin_amdgcn_fence(__ATOMIC_ACQUIRE, "agent");
            xb_add(&bar[XB_XGEN(b.x)], 1u);
            asm volatile("s_waitcnt vmcnt(0)" ::: "memory");
        } else {
            XB_SPIN(xb_ld(&bar[XB_XGEN(b.x)]) == gen, bar);
            __builtin_amdgcn_fence(__ATOMIC_ACQUIRE, "agent");
            asm volatile("s_waitcnt vmcnt(0)" ::: "memory");
        }
    }

    __syncthreads();
}
constexpr int N_PHASES = 12;
template <int PH> __device__ __forceinline__ void run_phase(const Params& p, LAS unsigned char* lds) {
    unsigned char* ws = p.ws; const int G = gridDim.x, bid = blockIdx.x;
    float* mod = (float*)(ws + WS_MOD);
    if constexpr (PH == 0) phase_prep(p, lds);
    else if constexpr (PH == 1) { pg8::Gemm g{(const bf16_t*)(ws + WS_CACT), (const bf16_t*)(ws + WS_WADA), 256, NMODC, DM}; pg8::StaticOrder S; S.init(256, NMODC, G, bid);
        EpiAda E{mod, p.in[7]}; pg8::gemm_phase(lds, g, S, E); }
    else if constexpr (PH == 2) phase_u(p);
    else if constexpr (PH == 3) { pg8::Gemm g{(const bf16_t*)(p.out + O_HS), (const bf16_t*)(ws + WS_WIN), NTOK, DIN, DM}; pg8::StaticOrder S; S.init(NTOK, DIN, G, bid);
        EpiZ E{p.out, (bf16_t*)(ws + WS_QS), (bf16_t*)(ws + WS_ZF), (bf16_t*)(ws + WS_VV), (bf16_t*)(ws + WS_OG), (bf16_t*)((unsigned char*)p.out + S35), (bf16_t*)(ws + WS_GB), p.in[12]};
        pg8::gemm_phase(lds, g, S, E); }
    else if constexpr (PH == 4) { phase_pool(p);
        for (int it = bid; it < NBP * NH * (NSEG - 1); it += G) hgrn_item<false>(p, lds, it / (NH * (NSEG - 1)), (it / (NSEG - 1)) % NH, it % (NSEG - 1)); }
    else if constexpr (PH == 5) {
        for (int it = bid; it < NBP * NH * NSEG + NBS * NH; it += G) {
            if (it < NBP * NH * NSEG) hgrn_item<true>(p, lds, it / (NH * NSEG), (it / NSEG) % NH, it % NSEG);
            else { const int s = it - NBP * NH * NSEG; hgrn_sample_item(p, lds, s >> 3, s & 7); } } }
    else if constexpr (PH == 6) { pg8::StaticOrder S; S.init(NTOK, DM, G, bid);
#if !defined(P6) || P6 == 0
        { pg8::Gemm g{(const bf16_t*)(ws + WS_DMB), (const bf16_t*)(ws + WS_WEFF), NTOK, DM, DPOOL}; EpiP E{(float*)(ws + WS_QS), (const bf16_t*)((unsigned char*)p.out + S35)}; pg8::gemm_phase(lds, g, S, E); }
#endif
#if !defined(P6) || P6 == 1
        { pg8::Gemm g{(const bf16_t*)p.out, (const bf16_t*)(ws + WS_WB), NTOK, DM, DM}; EpiM E{(const float*)(ws + WS_QS), (const bf16_t*)(ws + WS_GB), (bf16_t*)(ws + WS_VV)}; pg8::gemm_phase(lds, g, S, E); }
#endif
    }
    else if constexpr (PH == 7) { pg8::Gemm g{(const bf16_t*)(ws + WS_VV), (const bf16_t*)(ws + WS_WOUT), NTOK, DM, DM}; pg8::StaticOrder S; S.init(NTOK, DM, G, bid);
        EpiRes E{p.in[0], p.in[1], mod, 2 * DM, p.out}; pg8::gemm_phase(lds, g, S, E); }
    else if constexpr (PH == 8) phase_ln<true>(p);
    else if constexpr (PH == 9) { pg8::Gemm g{(const bf16_t*)(ws + WS_OG), (const bf16_t*)(ws + WS_WGU), NTOK, 2 * DFF, DM}; pg8::StaticOrder S; S.init(NTOK, 2 * DFF, G, bid);
        EpiGU E{(bf16_t*)(ws + WS_VV)}; pg8::gemm_phase(lds, g, S, E); }
    else if constexpr (PH == 10) { pg8::Gemm g{(const bf16_t*)(ws + WS_VV), (const bf16_t*)(ws + WS_WDN), NTOK, DM, DFF}; pg8::StaticOrder S; S.init(NTOK, DM, G, bid);
        const float* x1 = (const float*)(ws + WS_QS); EpiRes E{x1, x1 + (size_t)NPTOK * DM, mod, 5 * DM, p.out}; pg8::gemm_phase(lds, g, S, E); }
    else phase_ln<false>(p);
}
#if N_LAUNCH_MODE == 0
#define RUN_PHASE(PH) { const __attribute__((address_space(4))) Params* q_ = kp; asm volatile("" : "+s"(q_)); const Params lp_ = *(const Params*)q_; run_phase<PH>(lp_, lds); }
#define PHASE_SYNC(PH) RUN_PHASE(PH) xcd_barrier(xb);
__global__ __launch_bounds__(512, 2) void mega(Params p) {
    extern __shared__ __attribute__((aligned(16))) unsigned char shm[];
    LAS unsigned char* lds = (LAS unsigned char*)shm;
#if defined(__HIP_DEVICE_COMPILE__)
    cg::grid_group grid = cg::this_grid();
    const __attribute__((address_space(4))) Params* kp = (const __attribute__((address_space(4))) Params*)__builtin_amdgcn_kernarg_segment_ptr();
    LAS unsigned* stw = (LAS unsigned*)(lds + 131072);
    if (threadIdx.x == 0) { stw[0] = 0u; stw[1] = 0u; stw[2] = 0u; stw[3] = 0u; }
    __syncthreads();
    const XcdBarrier xb = xcd_barrier_post((unsigned*)(p.ws + WS_BAR), (volatile LAS unsigned*)stw);
    RUN_PHASE(0) grid.sync();
    PHASE_SYNC(1) PHASE_SYNC(2) PHASE_SYNC(3) PHASE_SYNC(4) PHASE_SYNC(5) PHASE_SYNC(6) PHASE_SYNC(7) PHASE_SYNC(8) PHASE_SYNC(9) PHASE_SYNC(10)
    RUN_PHASE(11)
#endif
}
#else
template <int PH> __global__ __launch_bounds__(512, 2) void mega(Params p) {
    extern __shared__ __attribute__((aligned(16))) unsigned char shm[];
    run_phase<PH>(p, (LAS unsigned char*)shm);
}
template <int PH> static void launch_phase(const Params& p, int grid, hipStream_t stream) {
    static bool attr = false;
    if (!attr) { (void)hipFuncSetAttribute((const void*)mega<PH>, hipFuncAttributeMaxDynamicSharedMemorySize, LDS_BYTES); attr = true; }
    hipLaunchKernelGGL(mega<PH>, dim3(grid), dim3(512), LDS_BYTES, stream, p);
}
#endif

extern "C" void kernel_launch(void* const* d_in, const int* in_sizes, int n_in, void* d_out, int out_size, void* d_ws, size_t ws_size, hipStream_t stream) {
    static int grid_blocks = 0;
    if (!grid_blocks) {
        int dev = 0, cus = 0, per_cu = 0;
        (void)hipGetDevice(&dev); (void)hipDeviceGetAttribute(&cus, hipDeviceAttributeMultiprocessorCount, dev);
#if N_LAUNCH_MODE == 0
        if (hipFuncSetAttribute((const void*)mega, hipFuncAttributeMaxDynamicSharedMemorySize, LDS_BYTES) != hipSuccess) fprintf(stderr, "hipFuncSetAttribute failed\n");
        if (hipOccupancyMaxActiveBlocksPerMultiprocessor(&per_cu, (const void*)mega, 512, LDS_BYTES) != hipSuccess || per_cu < 1) { fprintf(stderr, "occupancy query: %d\n", per_cu); per_cu = 1; }
        (void)hipGetLastError();
#else
        per_cu = 1;
#endif
        grid_blocks = cus * per_cu;
        if (ws_size < WS_BAR + 16384 || n_in != 23) fprintf(stderr, "kernel_launch: ws_size %zu < %zu or n_in %d != 23\n", ws_size, (size_t)WS_NEED, n_in);
    }
    Params p{};
    for (int i = 0; i < 23; ++i) p.in[i] = (const float*)d_in[i];
    p.out = (float*)d_out; p.ws = (unsigned char*)d_ws;
#if N_LAUNCH_MODE == 0
    (void)hipMemsetAsync((unsigned char*)d_ws + WS_BAR, 0, XCD_BAR_WORDS * sizeof(unsigned), stream);
    void* args[] = {&p};
    hipError_t e = hipLaunchCooperativeKernel((const void*)mega, dim3(grid_blocks), dim3(512), args, LDS_BYTES, stream);
    if (e != hipSuccess) fprintf(stderr, "cooperative launch failed: %s (grid %d)\n", hipGetErrorString(e), grid_blocks);
#else
    launch_phase<0>(p, grid_blocks, stream); launch_phase<1>(p, grid_blocks, stream); launch_phase<2>(p, grid_blocks, stream); launch_phase<3>(p, grid_blocks, stream);
    launch_phase<4>(p, grid_blocks, stream); launch_phase<5>(p, grid_blocks, stream); launch_phase<6>(p, grid_blocks, stream); launch_phase<7>(p, grid_blocks, stream);
    launch_phase<8>(p, grid_blocks, stream); launch_phase<9>(p, grid_blocks, stream); launch_phase<10>(p, grid_blocks, stream); launch_phase<11>(p, grid_blocks, stream);
#endif
}
```

```cpp
#include <hip/hip_runtime.h>
#include <hip/hip_cooperative_groups.h>
#include <cstdio>
namespace cg = cooperative_groups;

#ifndef N_LAUNCH_MODE
#define N_LAUNCH_MODE 0
#endif

constexpr int DM = 1024, NTOK = 17408, NPTOK = 16384, SEQ = 2048, NBP = 8, NBS = 128, DSEQ = 8;
constexpr int DIN = 6656, DFF = 2816, DPOOL = 512, NH = 8, HD = 128, PBUF = 15, NMODC = 6144;
constexpr float ALPHA = 1.1892071150027210f;
constexpr float LN_EPS = 1e-5f, RMS_EPS = 1e-6f;
constexpr int NSEG = 4, SEGLEN = SEQ / NSEG, CH = 64, NCHSEG = SEGLEN / CH;
constexpr size_t O_YP = 0, O_YS = 16777216, O_PP = 17825792, O_HP = 17887232, O_PS = 18935808, O_HS = 19918848;
constexpr size_t S35 = 35651584;
constexpr size_t WS_WIN = 0, WS_WADA = 13631488, WS_WEFF = 26214400, WS_WB = 27262976, WS_WOUT = 29360128, WS_WGU = 31457280,
                 WS_WDN = 42991616, WS_CACT = 48758784, WS_MOD = 49283072, WS_QS = 55574528, WS_ZF = WS_QS + S35, WS_OG = WS_ZF + S35,
                 WS_VV = WS_OG + S35, WS_GB = WS_VV + S35, WS_DMB = WS_GB + S35, WS_NEED = WS_VV + 98041856;
constexpr size_t WS_SLOC = 0, WS_SDEC = 16777216;
constexpr int LDS_BYTES = 131072 + 16;
constexpr size_t WS_BAR = 260571136;
#define DIAG 0
#if DIAG
#define DG(x) (x)
#else
#define DG(x) 1.0f
#endif

struct Params {
    const float* in[23];
    float* out;
    unsigned char* ws;
};
namespace pg8 {
#define PG8_LAS __attribute__((address_space(3)))
typedef unsigned short bf16_t;
typedef short bf16x8 __attribute__((ext_vector_type(8)));
typedef float f32x4 __attribute__((ext_vector_type(4)));
typedef unsigned u32x4 __attribute__((ext_vector_type(4)));
typedef unsigned u32x2 __attribute__((ext_vector_type(2)));
constexpr int BM = 256, BK = 64, HALF = 128, HTB = HALF * BK * 2, STAGE_BYTES = 8 * HTB, NXCD = 8, WGM = 8;
__host__ __device__ __forceinline__ int lds_byte(int r, int c) { const int st = (r >> 4) * 2 + (c >> 5), rr = r & 15, cc = c & 31, ob = rr * 64 + cc * 2; return st * 1024 + (ob ^ (((ob >> 9) & 1) << 5)); }
__host__ __device__ __forceinline__ void stage_rc(int b, int& R, int& C) { const int st = b / 1024, sb = b % 1024, swz = sb ^ (((sb >> 9) & 1) << 5); R = (st >> 1) * 16 + swz / 64; C = (st & 1) * 32 + (swz % 64) / 2; }
__host__ __device__ __forceinline__ int perm32(int rho) { const int n = rho >> 4, i = rho & 15; return 8 * (i >> 2) + 4 * n + (i & 3); }
struct Unit { int pm, pn; };
struct Gemm { const bf16_t* A; const bf16_t* Bt; int M, N, K; };
struct StaticOrder {
    int nM, nN, nwg, G, c;
    __host__ __device__ void init(int M, int N, int G_, int c_) { nM = M / BM; nN = N / BM; nwg = nM * nN; G = G_; c = c_; }
    __host__ __device__ bool next(int i, Unit& u) const {
        const long L = (long)i * G + c; if (L >= nwg) return false;
        int wgid = (int)L; { const int q = nwg / NXCD, r = nwg % NXCD, xcd = wgid % NXCD, off = wgid / NXCD; wgid = (xcd < r ? xcd * (q + 1) : r * (q + 1) + (xcd - r) * q) + off; }
        const int nig = WGM * nN, gid = wgid / nig, fm = gid * WGM, gsz = (nM - fm) < WGM ? (nM - fm) : WGM;
        u.pm = fm + ((wgid % nig) % gsz); u.pn = (wgid % nig) / gsz; return true;
    }
    __device__ __forceinline__ void a_ready(const Unit&) const {}
    __device__ __forceinline__ void done(const Unit&) const {}
};
__device__ __forceinline__ unsigned cvt_pk_bf16(float lo, float hi) { unsigned r; asm volatile("v_cvt_pk_bf16_f32 %0, %1, %2" : "=v"(r) : "v"(lo), "v"(hi)); return r; }
template <class Epi, class Sched>
__device__ __forceinline__ void gemm_phase(PG8_LAS unsigned char* lds, const Gemm g, const Sched& S, const Epi& E) {
    const int tid = threadIdx.x, wid = __builtin_amdgcn_readfirstlane(tid >> 6), lane = tid & 63, wr = wid >> 2, wc = wid & 3, fr = lane & 15, fq = lane >> 4;
    const int K = g.K, nt = K / BK;
    unsigned voffA[2], voffB[2];
#pragma unroll
    for (int i = 0; i < 2; ++i) { int R, C; stage_rc(tid * 16 + i * 8192, R, C); const int Rb = Epi::PERM ? ((R & ~31) + perm32(R & 31)) : R;
        voffA[i] = (unsigned)(R * K + C) * 2u; voffB[i] = (unsigned)(Rb * K + C) * 2u; }
    const size_t kstep = (size_t)(BK * 2);
    const size_t hstep = (size_t)HALF * K * 2;
    const size_t tstep = 2 * hstep;
    const unsigned ldsw = (unsigned)wid * 1024u;
    const int aoff = lds_byte(wr * 64 + fr, fq * 8), boff = lds_byte(wc * 32 + fr, fq * 8);
#define PG8_SA(b, h) (((b) * 2 + (h)) * HTB)
#define PG8_SB(b, h) ((4 + (b) * 2 + (h)) * HTB)
#define PG8_STAGE(bufoff, gbase, voff) do { _Pragma("unroll") for (int _i = 0; _i < 2; ++_i) \
        __builtin_amdgcn_global_load_lds((const unsigned*)((const char*)(gbase) + (voff)[_i]), (PG8_LAS unsigned*)(lds + (bufoff) + ldsw + _i * 8192), 16, 0, 0); } while (0)
#define PG8_LDA(dst, b, h) do { _Pragma("unroll") for (int m = 0; m < 4; ++m) _Pragma("unroll") for (int k = 0; k < 2; ++k) dst[m][k] = *(const PG8_LAS bf16x8*)(lds + PG8_SA(b, h) + aoff + m * 2048 + k * 1024); } while (0)
#define PG8_LDB(dst, b, h) do { _Pragma("unroll") for (int n = 0; n < 2; ++n) _Pragma("unroll") for (int k = 0; k < 2; ++k) dst[n][k] = *(const PG8_LAS bf16x8*)(lds + PG8_SB(b, h) + boff + n * 2048 + k * 1024); } while (0)
#define PG8_MMA(ai, bj, At, Bt) do { __builtin_amdgcn_s_setprio(1); _Pragma("unroll") for (int m = 0; m < 4; ++m) _Pragma("unroll") for (int n = 0; n < 2; ++n) _Pragma("unroll") for (int k = 0; k < 2; ++k) \
        acc[ai][bj][m][n] = __builtin_amdgcn_mfma_f32_16x16x32_bf16(Bt[n][k], At[m][k], acc[ai][bj][m][n], 0, 0, 0); __builtin_amdgcn_s_setprio(0); } while (0)
#define PG8_WAIT_V(n) asm volatile("s_waitcnt vmcnt(" #n ")" ::: "memory")
#define PG8_WAIT_L(n) asm volatile("s_waitcnt lgkmcnt(" #n ")" ::: "memory")
#define PG8_BAR __builtin_amdgcn_s_barrier()
#define PG8_SCHED __builtin_amdgcn_sched_barrier(0)
    Unit cur, nxt; int ui = 0;
    if (!S.next(0, cur)) return;
    f32x4 acc[2][2][4][2];
#pragma unroll
    for (int a = 0; a < 2; ++a)
#pragma unroll
        for (int b = 0; b < 2; ++b)
#pragma unroll
            for (int m = 0; m < 4; ++m)
#pragma unroll
                for (int n = 0; n < 2; ++n) acc[a][b][m][n] = (f32x4){0.f, 0.f, 0.f, 0.f};
    bf16x8 At[4][2], B0[2][2], B1[2][2];
    const char* cA = (const char*)g.A + (size_t)cur.pm * tstep; const char* cB = (const char*)g.Bt + (size_t)cur.pn * tstep;
    S.a_ready(cur);
    PG8_STAGE(PG8_SB(0, 0), cB, voffB); PG8_STAGE(PG8_SA(0, 0), cA, voffA); PG8_STAGE(PG8_SB(0, 1), cB + hstep, voffB); PG8_STAGE(PG8_SA(0, 1), cA + hstep, voffA);
    if (wr == 1) PG8_BAR;
    PG8_WAIT_V(4); PG8_BAR;
    PG8_STAGE(PG8_SB(1, 0), cB + kstep, voffB); PG8_STAGE(PG8_SA(1, 0), cA + kstep, voffA); PG8_STAGE(PG8_SB(1, 1), cB + hstep + kstep, voffB);
    PG8_WAIT_V(6); PG8_BAR;
    for (;;) {
        const bool has_next = S.next(ui + 1, nxt);
        const char* nA = has_next ? (const char*)g.A + (size_t)nxt.pm * tstep : cA; const char* nB = has_next ? (const char*)g.Bt + (size_t)nxt.pn * tstep : cB;
        for (int t = 0; t < nt; t += 2) {
            const bool last = (t == nt - 2);
            const char* a1 = cA + (size_t)(t + 1) * kstep;
            const char* a2 = last ? nA : cA + (size_t)(t + 2) * kstep; const char* b2 = last ? nB : cB + (size_t)(t + 2) * kstep;
            const char* a3 = a2 + kstep; const char* b3 = b2 + kstep;
            if (last && has_next) S.a_ready(nxt);
            PG8_LDB(B0, 0, 0); PG8_SCHED; PG8_LDA(At, 0, 0); PG8_STAGE(PG8_SA(1, 1), a1 + hstep, voffA);
            PG8_WAIT_L(8); PG8_BAR; PG8_WAIT_L(0); PG8_MMA(0, 0, At, B0); PG8_BAR; PG8_SCHED;
            PG8_LDB(B1, 0, 1); PG8_STAGE(PG8_SB(0, 0), b2, voffB);
            PG8_BAR; PG8_WAIT_L(0); PG8_MMA(0, 1, At, B1); PG8_BAR;
            PG8_LDA(At, 0, 1); PG8_STAGE(PG8_SA(0, 0), a2, voffA);
            PG8_BAR; PG8_WAIT_L(0); PG8_MMA(1, 0, At, B0); PG8_BAR; PG8_SCHED;
            PG8_STAGE(PG8_SB(0, 1), b2 + hstep, voffB);
            PG8_WAIT_V(6); PG8_BAR; PG8_MMA(1, 1, At, B1); PG8_BAR;
            PG8_LDB(B0, 1, 0); PG8_SCHED; PG8_LDA(At, 1, 0); PG8_STAGE(PG8_SA(0, 1), a2 + hstep, voffA);
            PG8_WAIT_L(8); PG8_BAR; PG8_WAIT_L(0); PG8_MMA(0, 0, At, B0); PG8_BAR; PG8_SCHED;
            PG8_LDB(B1, 1, 1); PG8_STAGE(PG8_SB(1, 0), b3, voffB);
            PG8_BAR; PG8_WAIT_L(0); PG8_MMA(0, 1, At, B1); PG8_BAR;
            PG8_LDA(At, 1, 1); PG8_STAGE(PG8_SA(1, 0), a3, voffA);
            PG8_BAR; PG8_WAIT_L(0); PG8_MMA(1, 0, At, B0); PG8_BAR; PG8_SCHED;
            PG8_STAGE(PG8_SB(1, 1), b3 + hstep, voffB);
            PG8_WAIT_V(6); PG8_BAR; PG8_MMA(1, 1, At, B1); PG8_BAR;
        }
        if constexpr (!Epi::AFTER_DRAIN) { E(acc, cur, wr, wc, fr, fq); S.done(cur); }
        if (!has_next) break;
#pragma unroll
        for (int a = 0; a < 2; ++a)
#pragma unroll
            for (int b = 0; b < 2; ++b)
#pragma unroll
                for (int m = 0; m < 4; ++m)
#pragma unroll
                    for (int n = 0; n < 2; ++n) acc[a][b][m][n] = (f32x4){0.f, 0.f, 0.f, 0.f};
        cur = nxt; cA = nA; cB = nB; ++ui;
    }
    PG8_WAIT_V(0);
    if (wr == 0) PG8_BAR;
    PG8_BAR;
    if constexpr (Epi::AFTER_DRAIN) { E.fused(acc, cur, wr, wc, fr, fq, lds, wid, lane); S.done(cur); }
#undef PG8_SA
#undef PG8_SB
#undef PG8_STAGE
#undef PG8_LDA
#undef PG8_LDB
#undef PG8_MMA
#undef PG8_WAIT_V
#undef PG8_WAIT_L
#undef PG8_BAR
#undef PG8_SCHED
}
}

using pg8::bf16_t; using pg8::bf16x8; using pg8::f32x4; using pg8::u32x4; using pg8::u32x2; using pg8::cvt_pk_bf16;
#define LAS __attribute__((address_space(3)))

__device__ __forceinline__ float sigm(float x) { return __builtin_amdgcn_rcpf(1.f + __expf(-x)); }
__device__ __forceinline__ float silu_(float x) { return x * sigm(x); }
__device__ __forceinline__ float bf2f(unsigned b) { return __uint_as_float(b << 16); }
__device__ __forceinline__ bf16_t f2bf(float f) { unsigned u = __float_as_uint(f); u += 0x7FFFu + ((u >> 16) & 1u); return (bf16_t)(u >> 16); }
__device__ __forceinline__ int mrow_of(int tok) { return tok < NPTOK ? (tok >> 11) : 8 + ((tok - NPTOK) >> 3); }
__device__ __forceinline__ u32x4 pack8(const f32x4 a, const f32x4 b) { u32x4 r; r[0] = cvt_pk_bf16(a[0], a[1]); r[1] = cvt_pk_bf16(a[2], a[3]); r[2] = cvt_pk_bf16(b[0], b[1]); r[3] = cvt_pk_bf16(b[2], b[3]); return r; }
__device__ __forceinline__ void unpack8(const u32x4 r, f32x4& a, f32x4& b) {
    a[0] = bf2f(r[0] & 0xffffu); a[1] = __uint_as_float(r[0] & 0xffff0000u); a[2] = bf2f(r[1] & 0xffffu); a[3] = __uint_as_float(r[1] & 0xffff0000u);
    b[0] = bf2f(r[2] & 0xffffu); b[1] = __uint_as_float(r[2] & 0xffff0000u); b[2] = bf2f(r[3] & 0xffffu); b[3] = __uint_as_float(r[3] & 0xffff0000u); }

#define EPI_LOOP_ROWS _Pragma("unroll") for (int ai = 0; ai < 2; ++ai) _Pragma("unroll") for (int m = 0; m < 4; ++m)
struct EpiAda {
    static constexpr bool PERM = false, AFTER_DRAIN = false;
    float* C; const float* bias;
    __device__ __forceinline__ void operator()(const f32x4 (&acc)[2][2][4][2], const pg8::Unit& u, int wr, int wc, int fr, int fq) const {
        const int row0 = u.pm * 256 + wr * 64 + fr, col0 = u.pn * 256 + wc * 32 + 4 * fq;
        EPI_LOOP_ROWS { float* rowp = C + (size_t)(row0 + ai * 128 + m * 16) * NMODC + col0;
#pragma unroll
            for (int bj = 0; bj < 2; ++bj)
#pragma unroll
                for (int n = 0; n < 2; ++n) *(f32x4*)(rowp + bj * 128 + n * 16) = acc[ai][bj][m][n] + *(const f32x4*)(bias + col0 + bj * 128 + n * 16); }
    }
};
struct EpiZ {
    static constexpr bool PERM = true, AFTER_DRAIN = false;
    float* zp; bf16_t *qs, *zf, *vv, *og, *ga, *gb; const float* nw;
    __device__ __forceinline__ void operator()(const f32x4 (&acc)[2][2][4][2], const pg8::Unit& u, int wr, int wc, int fr, int fq) const {
        const int row0 = u.pm * 256 + wr * 64 + fr;
        if (u.pn < 2) {
            const int col0 = u.pn * 256 + wc * 32 + 8 * fq;
            EPI_LOOP_ROWS { float* rowp = zp + (size_t)(row0 + ai * 128 + m * 16) * DPOOL + col0;
#pragma unroll
                for (int bj = 0; bj < 2; ++bj) { *(f32x4*)(rowp + bj * 128) = acc[ai][bj][m][0]; *(f32x4*)(rowp + bj * 128 + 4) = acc[ai][bj][m][1]; } }
            return;
        }
        const int seg = (u.pn - 2) >> 2, col0 = ((u.pn - 2) & 3) * 256 + wc * 32 + 8 * fq;
        bf16_t* dst = seg == 0 ? qs : seg == 1 ? zf : seg == 2 ? vv : seg == 3 ? og : seg == 4 ? ga : gb;
        f32x4 w0[2], w1[2];
#pragma unroll
        for (int bj = 0; bj < 2; ++bj) { w0[bj] = (f32x4){1.f, 1.f, 1.f, 1.f}; w1[bj] = w0[bj]; if (seg == 3) { w0[bj] = *(const f32x4*)(nw + col0 + bj * 128); w1[bj] = *(const f32x4*)(nw + col0 + bj * 128 + 4); } }
        EPI_LOOP_ROWS { bf16_t* rowp = dst + (size_t)(row0 + ai * 128 + m * 16) * DM + col0;
#pragma unroll
            for (int bj = 0; bj < 2; ++bj) { f32x4 v0 = acc[ai][bj][m][0], v1 = acc[ai][bj][m][1];
                if (seg == 0 || seg == 3) {
#pragma unroll
                    for (int i = 0; i < 4; ++i) { v0[i] = silu_(v0[i]) * w0[bj][i]; v1[i] = silu_(v1[i]) * w1[bj][i]; }
                } else if (seg >= 4) {
#pragma unroll
                    for (int i = 0; i < 4; ++i) { v0[i] = sigm(v0[i]); v1[i] = sigm(v1[i]); }
                }
                *(u32x4*)(rowp + bj * 128) = pack8(v0, v1); } }
    }
};
struct EpiP {
    static constexpr bool PERM = true, AFTER_DRAIN = false;
    float* tmp; const bf16_t* ga;
    __device__ __forceinline__ void operator()(const f32x4 (&acc)[2][2][4][2], const pg8::Unit& u, int wr, int wc, int fr, int fq) const {
        const int row0 = u.pm * 256 + wr * 64 + fr, col0 = u.pn * 256 + wc * 32 + 8 * fq;
        EPI_LOOP_ROWS { const size_t ro = (size_t)(row0 + ai * 128 + m * 16) * DM + col0;
#pragma unroll
            for (int bj = 0; bj < 2; ++bj) { f32x4 g0, g1; unpack8(*(const u32x4*)(ga + ro + bj * 128), g0, g1);
                *(f32x4*)(tmp + ro + bj * 128) = acc[ai][bj][m][0] * g0; *(f32x4*)(tmp + ro + bj * 128 + 4) = acc[ai][bj][m][1] * g1; } }
    }
};
struct EpiM {
    static constexpr bool PERM = true, AFTER_DRAIN = false;
    const float* tmp; const bf16_t* gb; bf16_t* mrg;
    __device__ __forceinline__ void operator()(const f32x4 (&acc)[2][2][4][2], const pg8::Unit& u, int wr, int wc, int fr, int fq) const {
        const int row0 = u.pm * 256 + wr * 64 + fr, col0 = u.pn * 256 + wc * 32 + 8 * fq;
        EPI_LOOP_ROWS { const size_t ro = (size_t)(row0 + ai * 128 + m * 16) * DM + col0;
#pragma unroll
            for (int bj = 0; bj < 2; ++bj) { f32x4 g0, g1; unpack8(*(const u32x4*)(gb + ro + bj * 128), g0, g1);
                const f32x4 t0 = *(const f32x4*)(tmp + ro + bj * 128), t1 = *(const f32x4*)(tmp + ro + bj * 128 + 4);
                *(u32x4*)(mrg + ro + bj * 128) = pack8(t0 + acc[ai][bj][m][0] * g0, t1 + acc[ai][bj][m][1] * g1); } }
    }
};
struct EpiRes {
    static constexpr bool PERM = false, AFTER_DRAIN = false;
    const float* resp; const float* ress; const float* mod; int goff; float* r;
    __device__ __forceinline__ void operator()(const f32x4 (&acc)[2][2][4][2], const pg8::Unit& u, int wr, int wc, int fr, int fq) const {
        const int row0 = u.pm * 256 + wr * 64 + fr, col0 = u.pn * 256 + wc * 32 + 4 * fq;
        EPI_LOOP_ROWS { const int row = row0 + ai * 128 + m * 16; const float* xr = row < NPTOK ? resp + (size_t)row * DM : ress + (size_t)(row - NPTOK) * DM;
            const float* gr = mod + (size_t)mrow_of(row) * NMODC + goff + col0; float* rr = r + (size_t)row * DM + col0;
#pragma unroll
            for (int bj = 0; bj < 2; ++bj)
#pragma unroll
                for (int n = 0; n < 2; ++n) { const int o = bj * 128 + n * 16; *(f32x4*)(rr + o) = *(const f32x4*)(xr + col0 + o) * ALPHA + *(const f32x4*)(gr + o) * acc[ai][bj][m][n]; } }
    }
};
struct EpiGU {
    static constexpr bool PERM = true, AFTER_DRAIN = false;
    bf16_t* act;
    __device__ __forceinline__ void operator()(const f32x4 (&acc)[2][2][4][2], const pg8::Unit& u, int wr, int wc, int fr, int fq) const {
        const int row0 = u.pm * 256 + wr * 64 + fr, col0 = (u.pn * 256 + wc * 32 + 8 * fq) >> 1;
        EPI_LOOP_ROWS { bf16_t* rowp = act + (size_t)(row0 + ai * 128 + m * 16) * DFF + col0;
#pragma unroll
            for (int bj = 0; bj < 2; ++bj) { const f32x4 g = acc[ai][bj][m][0], up = acc[ai][bj][m][1]; u32x2 o;
                o[0] = cvt_pk_bf16(silu_(g[0]) * up[0], silu_(g[1]) * up[1]); o[1] = cvt_pk_bf16(silu_(g[2]) * up[2], silu_(g[3]) * up[3]);
                *(u32x2*)(rowp + bj * 64) = o; } }
    }
};
__device__ void transpose_job(const float* __restrict__ src, int K, int N, bf16_t* __restrict__ dst, int mode, LAS float* tile, int& job, int G) {
    const int tid = threadIdx.x, ntn = N / 256, ntiles = (K / 64) * ntn;
    for (int t = 0; t < ntiles; ++t, ++job) {
        if ((job % G) != (int)blockIdx.x) continue;
        const int k0 = (t / ntn) * 64, n0 = (t % ntn) * 256;
        { const int r = tid >> 4, c4 = tid & 15; f32x4 v[2][4];
#pragma unroll
          for (int rr = 0; rr < 2; ++rr)
#pragma unroll
              for (int q = 0; q < 4; ++q) v[rr][q] = *(const f32x4*)(src + (size_t)(k0 + r + rr * 32) * N + n0 + q * 64 + c4 * 4);
#pragma unroll
          for (int rr = 0; rr < 2; ++rr)
#pragma unroll
              for (int q = 0; q < 4; ++q)
#pragma unroll
                  for (int i = 0; i < 4; ++i) tile[(r + rr * 32) * 257 + q * 64 + c4 * 4 + i] = v[rr][q][i]; }
        __syncthreads();
        { const int k8 = tid & 7;
#pragma unroll
          for (int q = 0; q < 4; ++q) { const int nr = (tid >> 3) + 64 * q; float v[8];
#pragma unroll
              for (int i = 0; i < 8; ++i) v[i] = tile[(k8 * 8 + i) * 257 + nr];
              const int n = n0 + nr; const int nd = mode == 0 ? n : ((n >> 2) * 8 + (n & 3) + (mode == 2 ? 4 : 0));
              u32x4 o; o[0] = cvt_pk_bf16(v[0], v[1]); o[1] = cvt_pk_bf16(v[2], v[3]); o[2] = cvt_pk_bf16(v[4], v[5]); o[3] = cvt_pk_bf16(v[6], v[7]);
              *(u32x4*)(dst + (size_t)nd * K + k0 + k8 * 8) = o; } }
        __syncthreads();
    }
}
__device__ void phase_prep(const Params& p, LAS unsigned char* lds) {
    const int G = gridDim.x, tid = threadIdx.x; unsigned char* ws = p.ws;
    LAS float* tile = (LAS float*)lds;
    int job = 0;
    transpose_job(p.in[6], DM, NMODC, (bf16_t*)(ws + WS_WADA), 0, tile, job, G);
    transpose_job(p.in[8], DM, DIN, (bf16_t*)(ws + WS_WIN), 0, tile, job, G);
    transpose_job(p.in[14], DM, DM, (bf16_t*)(ws + WS_WB), 0, tile, job, G);
    transpose_job(p.in[15], DM, DM, (bf16_t*)(ws + WS_WOUT), 0, tile, job, G);
    transpose_job(p.in[18], DM, DFF, (bf16_t*)(ws + WS_WGU), 1, tile, job, G);
    transpose_job(p.in[19], DM, DFF, (bf16_t*)(ws + WS_WGU), 2, tile, job, G);
    transpose_job(p.in[20], DFF, DM, (bf16_t*)(ws + WS_WDN), 0, tile, job, G);
    { const float* wg = p.in[9]; const float* ps = p.in[10]; const float* wa = p.in[13]; bf16_t* weff = (bf16_t*)(ws + WS_WEFF);
      for (int it = 0; it < 256; ++it, ++job) {
          if ((job % G) != (int)blockIdx.x) continue;
          const int g = it >> 6, cb = (it >> 1) & 31, nb = it & 1, n = nb * 512 + tid;
          float a[4] = {0.f, 0.f, 0.f, 0.f};
          const float* wap = wa + (size_t)(g * 128) * DM + n; const float* wgp = wg + (size_t)(g * 128 + cb * 4) * 128; const float* psp = ps + g * 128;
#pragma unroll 16
          for (int d = 0; d < 128; ++d) { const float w = wap[(size_t)d * DM] * psp[d];
#pragma unroll
              for (int i = 0; i < 4; ++i) a[i] += wgp[i * 128 + d] * w; }
          u32x2 o; o[0] = cvt_pk_bf16(a[0], a[1]); o[1] = cvt_pk_bf16(a[2], a[3]);
          *(u32x2*)(weff + (size_t)n * DPOOL + g * 128 + cb * 4) = o; } }
    { bf16_t* ca = (bf16_t*)(ws + WS_CACT);
      for (int i = blockIdx.x * 512 + tid; i < 256 * DM / 8; i += G * 512) { const int row = i >> 7, c8 = (i & 127) * 8; u32x4 o = {0u, 0u, 0u, 0u};
          if (row < 136) { const float* s = row < 8 ? p.in[4] + (size_t)row * DM + c8 : p.in[5] + (size_t)(row - 8) * DM + c8; const f32x4 a = *(const f32x4*)s, b = *(const f32x4*)(s + 4);
              o[0] = cvt_pk_bf16(silu_(a[0]), silu_(a[1])); o[1] = cvt_pk_bf16(silu_(a[2]), silu_(a[3])); o[2] = cvt_pk_bf16(silu_(b[0]), silu_(b[1])); o[3] = cvt_pk_bf16(silu_(b[2]), silu_(b[3])); }
          *(u32x4*)(ca + (size_t)row * DM + c8) = o; } }
}
__device__ void phase_u(const Params& p) {
    const float* mod = (const float*)(p.ws + WS_MOD); bf16_t* u = (bf16_t*)(p.out + O_HS);
    for (int i = blockIdx.x * 512 + threadIdx.x; i < NTOK * DM / 8; i += gridDim.x * 512) { const int tok = i >> 7, c8 = (i & 127) * 8;
        const float* xr = tok < NPTOK ? p.in[0] + (size_t)tok * DM + c8 : p.in[1] + (size_t)(tok - NPTOK) * DM + c8; const float* mr = mod + (size_t)mrow_of(tok) * NMODC + c8;
        const f32x4 x0 = *(const f32x4*)xr, x1 = *(const f32x4*)(xr + 4), sh0 = *(const f32x4*)mr, sh1 = *(const f32x4*)(mr + 4), sc0 = *(const f32x4*)(mr + DM), sc1 = *(const f32x4*)(mr + DM + 4);
        *(u32x4*)(u + (size_t)tok * DM + c8) = pack8(x0 * (sc0 + 1.f) + sh0, x1 * (sc1 + 1.f) + sh1); }
}
template <bool FIRST> __device__ void phase_ln(const Params& p) {
    const float* mod = (const float*)(p.ws + WS_MOD); float* r = p.out;
    const float* g = p.in[FIRST ? 16 : 21]; const float* b = p.in[FIRST ? 17 : 22];
    float* x1 = (float*)(p.ws + WS_QS); bf16_t* hb = (bf16_t*)(p.ws + WS_OG);
    const int lane = threadIdx.x & 63, wv = blockIdx.x * 8 + (threadIdx.x >> 6), nw = gridDim.x * 8;
    for (int row = wv; row < NTOK; row += nw) { float* rp = r + (size_t)row * DM; f32x4 v[4]; float s = 0.f;
#pragma unroll
        for (int i = 0; i < 4; ++i) { v[i] = *(const f32x4*)(rp + i * 256 + lane * 4); s += v[i][0] + v[i][1] + v[i][2] + v[i][3]; }
#pragma unroll
        for (int o = 32; o; o >>= 1) s += __shfl_xor(s, o);
        const float mu = s * (1.f / DM); float q = 0.f;
#pragma unroll
        for (int i = 0; i < 4; ++i) { v[i] = v[i] - mu; q += v[i][0] * v[i][0] + v[i][1] * v[i][1] + v[i][2] * v[i][2] + v[i][3] * v[i][3]; }
#pragma unroll
        for (int o = 32; o; o >>= 1) q += __shfl_xor(q, o);
        const float rs = rsqrtf(q * (1.f / DM) + LN_EPS); const float* mr = mod + (size_t)mrow_of(row) * NMODC;
#pragma unroll
        for (int i = 0; i < 4; ++i) { const int c = i * 256 + lane * 4; const f32x4 y = v[i] * rs * *(const f32x4*)(g + c) + *(const f32x4*)(b + c);
            if (FIRST) { *(f32x4*)(x1 + (size_t)row * DM + c) = y; const f32x4 h = y * (*(const f32x4*)(mr + 4 * DM + c) + 1.f) + *(const f32x4*)(mr + 3 * DM + c);
                u32x2 o; o[0] = cvt_pk_bf16(h[0], h[1]); o[1] = cvt_pk_bf16(h[2], h[3]); *(u32x2*)(hb + (size_t)row * DM + c) = o; }
            else *(f32x4*)(rp + c) = y * (row >= NPTOK ? DG(1.00447f) : 1.0f); } }
}
__device__ void phase_pool(const Params& p) {
    const float* zp = p.out;
    bf16_t* dmb = (bf16_t*)(p.ws + WS_DMB); const float* sp = p.in[2];
    const int gt = blockIdx.x * 512 + threadIdx.x, gn = gridDim.x * 512;
    for (int i = gt; i < 512 * 128 + NBS * 128; i += gn) {
        const int c0 = (i & 127) * 4, w = 2 << (c0 >> 7);
        if (i < 512 * 128) {
            const int run = i >> 7, b = run >> 6, t0 = (run & 63) * 32; const float* zb = zp + (size_t)b * SEQ * DPOOL + c0; bf16_t* db = dmb + (size_t)b * SEQ * DPOOL + c0;
            f32x4 s = {0.f, 0.f, 0.f, 0.f};
            for (int t = t0 - w; t < t0; ++t) if (t >= 0) s += *(const f32x4*)(zb + (size_t)t * DPOOL);
            for (int t = t0; t < t0 + 32; ++t) { const f32x4 z = *(const f32x4*)(zb + (size_t)t * DPOOL); s += z;
                if (t - w >= 0) s -= *(const f32x4*)(zb + (size_t)(t - w) * DPOOL);
                const float ic = 1.f / (float)(t + 1 < w ? t + 1 : w); const f32x4 d = s * ic - z;
                u32x2 o; o[0] = cvt_pk_bf16(d[0], d[1]); o[1] = cvt_pk_bf16(d[2], d[3]); *(u32x2*)(db + (size_t)t * DPOOL) = o; }
        } else {
            const int b = (i - 512 * 128) >> 7; const float* sb = sp + (size_t)b * PBUF * DPOOL + c0; const float* zb = zp + (size_t)(NPTOK + b * DSEQ) * DPOOL + c0;
            const float ic = 1.f / (float)w;
            for (int t = 0; t < DSEQ; ++t) { f32x4 s = {0.f, 0.f, 0.f, 0.f};
                for (int e = PBUF + t - w + 1; e <= PBUF + t; ++e) s += e < PBUF ? *(const f32x4*)(sb + (size_t)e * DPOOL) : *(const f32x4*)(zb + (size_t)(e - PBUF) * DPOOL);
                const f32x4 z = *(const f32x4*)(zb + (size_t)t * DPOOL), d = s * ic - z;
                u32x2 o; o[0] = cvt_pk_bf16(d[0], d[1]); o[1] = cvt_pk_bf16(d[2], d[3]); *(u32x2*)(dmb + (size_t)(NPTOK + b * DSEQ + t) * DPOOL + c0) = o; }
        }
    }
    for (int i = gt; i < NBP * PBUF * 128; i += gn) { const int c0 = (i & 127) * 4, r = i >> 7, b = r / PBUF, k = r % PBUF;
        *(f32x4*)(p.out + O_PP + (size_t)r * DPOOL + c0) = *(const f32x4*)(zp + (size_t)(b * SEQ + SEQ - PBUF + k) * DPOOL + c0) * DG(1.00632f); }
    for (int i = gt; i < NBS * PBUF * 128; i += gn) { const int c0 = (i & 127) * 4, r = i >> 7, b = r / PBUF, k = r % PBUF;
        *(f32x4*)(p.out + O_PS + (size_t)r * DPOOL + c0) = DG(1.01049f) * (k < PBUF - DSEQ ? *(const f32x4*)(sp + (size_t)(b * PBUF + k + DSEQ) * DPOOL + c0) : *(const f32x4*)(zp + (size_t)(NPTOK + b * DSEQ + k - (PBUF - DSEQ)) * DPOOL + c0)); }
}
constexpr int L_QD = 0, L_KD = 17408, L_KT = 34816, L_VT = 53248, L_PP = 71680, L_ST = 80896, L_GT = 115712, L_DEC = 117760, L_RED = 118272;
constexpr int QS_ = 136, TS_ = 72;
#define MFMA16(a, b, c) __builtin_amdgcn_mfma_f32_16x16x32_bf16(a, b, c, 0, 0, 0)
#define LDSV(off) (*(const LAS bf16x8*)(lds + (off)))
template <bool PASSB> __device__ void hgrn_item(const Params& p, LAS unsigned char* lds, int b, int h, int seg) {
    const int tid = threadIdx.x, wid = tid >> 6, lane = tid & 63, fr = lane & 15, fq = lane >> 4, c = tid & 127, tg = tid >> 7;
    const bf16_t* qs = (const bf16_t*)(p.ws + WS_QS); const bf16_t* zf = (const bf16_t*)(p.ws + WS_ZF); const bf16_t* vv = (const bf16_t*)(p.ws + WS_VV); const bf16_t* og = (const bf16_t*)(p.ws + WS_OG);
    bf16_t* yh = (bf16_t*)p.out;
    float* sloc = (float*)(p.ws + WS_SLOC); float* sdec = (float*)(p.ws + WS_SDEC);
    const float l0 = p.in[11][h * HD + c], l1 = p.in[11][DM + h * HD + c]; const float lbv = sigm(l0 - l1), oml = 1.f - lbv;
    f32x4 S[8];
#pragma unroll
    for (int n = 0; n < 8; ++n) S[n] = (f32x4){0.f, 0.f, 0.f, 0.f};
    const int crow = wid * 16 + fq * 4;
    const int ptok = tid >> 4, pch = (tid & 15) * 8;
    const size_t tokbase = (size_t)(b * SEQ + seg * SEGLEN) * DM + h * HD + pch;
    __syncthreads();
    if (PASSB) {
        for (int s = 0; s < seg; ++s) { const float* sl = sloc + (size_t)((b * NH + h) * NSEG + s) * HD * HD + crow * HD + fr; const float* sd = sdec + ((b * NH + h) * NSEG + s) * HD + crow;
#pragma unroll
            for (int j = 0; j < 4; ++j) { const float d = sd[j];
#pragma unroll
                for (int n = 0; n < 8; ++n) S[n][j] = S[n][j] * d + sl[j * HD + n * 16]; } }
#pragma unroll
        for (int n = 0; n < 8; ++n) { u32x2 o; o[0] = cvt_pk_bf16(S[n][0], S[n][1]); o[1] = cvt_pk_bf16(S[n][2], S[n][3]); *(LAS u32x2*)(lds + L_ST + ((n * 16 + fr) * QS_ + crow) * 2) = o; }
    }
    float segtot = 1.f;
    for (int ch = 0; ch < NCHSEG; ++ch) {
        const int tok0 = b * SEQ + seg * SEGLEN + ch * CH;
        u32x4 cg_[2];
        { u32x4 rz[2], rv[2], rq[2];
#pragma unroll
          for (int i = 0; i < 2; ++i) { const size_t gi = tokbase + (size_t)(ch * CH + ptok + 32 * i) * DM; rz[i] = *(const u32x4*)(zf + gi); rv[i] = *(const u32x4*)(vv + gi);
              if (PASSB) { rq[i] = *(const u32x4*)(qs + gi); cg_[i] = *(const u32x4*)(og + gi); } }
#pragma unroll
          for (int i = 0; i < 2; ++i) { const int o = ((ptok + 32 * i) * 128 + pch) * 2; *(LAS u32x4*)(lds + L_QD + o) = rz[i]; *(LAS u32x4*)(lds + L_KT + o) = rv[i]; if (PASSB) *(LAS u32x4*)(lds + L_KD + o) = rq[i]; } }
        __syncthreads();
        float pr[16], kk[16]; unsigned qp[8];
        { float run = 1.f;
#pragma unroll
          for (int i = 0; i < 16; ++i) { const int o = ((tg * 16 + i) * 128 + c) * 2; const float z = bf2f(*(const LAS bf16_t*)(lds + L_QD + o)); const float sg = sigm(z); kk[i] = oml * (1.f - sg); run *= lbv + oml * sg; pr[i] = run;
              if (PASSB) { const unsigned qq = *(const LAS bf16_t*)(lds + L_KD + o); if (i & 1) qp[i >> 1] |= qq << 16; else qp[i >> 1] = qq; } }
          unsigned vt[8];
#pragma unroll
          for (int i = 0; i < 8; ++i) vt[i] = (unsigned)*(const LAS bf16_t*)(lds + L_KT + ((tg * 16 + 2 * i) * 128 + c) * 2) | ((unsigned)*(const LAS bf16_t*)(lds + L_KT + ((tg * 16 + 2 * i + 1) * 128 + c) * 2) << 16);
          *(LAS u32x4*)(lds + L_VT + (c * TS_ + tg * 16) * 2) = (u32x4){vt[0], vt[1], vt[2], vt[3]}; *(LAS u32x4*)(lds + L_VT + (c * TS_ + tg * 16 + 8) * 2) = (u32x4){vt[4], vt[5], vt[6], vt[7]};
          *(LAS float*)(lds + L_GT + (tg * 128 + c) * 4) = run; }
        __syncthreads();
        float off = 1.f, tot = 1.f;
#pragma unroll
        for (int g = 0; g < 4; ++g) { const float t = *(const LAS float*)(lds + L_GT + (g * 128 + c) * 4); tot *= t; if (g < tg) off *= t; }
        { unsigned kt[8];
#pragma unroll
          for (int i = 0; i < 8; ++i) { const float e0 = pr[2 * i] * off, e1 = pr[2 * i + 1] * off, r0 = __builtin_amdgcn_rcpf(e0), r1 = __builtin_amdgcn_rcpf(e1);
              kt[i] = cvt_pk_bf16(kk[2 * i] * (tot * r0), kk[2 * i + 1] * (tot * r1));
              if (PASSB) { const int t = tg * 16 + 2 * i;
                  *(LAS bf16_t*)(lds + L_QD + (t * QS_ + c) * 2) = f2bf(bf2f(qp[i] & 0xffffu) * e0); *(LAS bf16_t*)(lds + L_QD + ((t + 1) * QS_ + c) * 2) = f2bf(__uint_as_float(qp[i] & 0xffff0000u) * e1);
                  *(LAS bf16_t*)(lds + L_KD + (t * QS_ + c) * 2) = f2bf(kk[2 * i] * r0); *(LAS bf16_t*)(lds + L_KD + ((t + 1) * QS_ + c) * 2) = f2bf(kk[2 * i + 1] * r1); } }
          *(LAS u32x4*)(lds + L_KT + (c * TS_ + tg * 16) * 2) = (u32x4){kt[0], kt[1], kt[2], kt[3]}; *(LAS u32x4*)(lds + L_KT + (c * TS_ + tg * 16 + 8) * 2) = (u32x4){kt[4], kt[5], kt[6], kt[7]};
          }
        if (tg == 0) { *(LAS float*)(lds + L_DEC + c * 4) = tot; segtot *= tot; }
        __syncthreads();
        f32x4 o[4]; const int ti = wid >> 1;
        if (PASSB) {
#pragma unroll
            for (int x = 0; x < 2; ++x) { const int tj = (wid & 1) * 2 + x; f32x4 a = {0.f, 0.f, 0.f, 0.f};
                if (tj <= ti) {
#pragma unroll
                    for (int k = 0; k < 4; ++k) a = MFMA16(LDSV(L_QD + ((ti * 16 + fr) * QS_ + k * 32 + fq * 8) * 2), LDSV(L_KD + ((tj * 16 + fr) * QS_ + k * 32 + fq * 8) * 2), a);
                }
#pragma unroll
                for (int j = 0; j < 4; ++j) { const int t = ti * 16 + fq * 4 + j, s = tj * 16 + fr; *(LAS bf16_t*)(lds + L_PP + (t * TS_ + s) * 2) = f2bf(s <= t ? a[j] : 0.f); } }
            __syncthreads();
#pragma unroll
            for (int n = 0; n < 4; ++n) { const int vtile = (wid & 1) * 4 + n; o[n] = (f32x4){0.f, 0.f, 0.f, 0.f};
#pragma unroll
                for (int k = 0; k < 2; ++k) o[n] = MFMA16(LDSV(L_PP + ((ti * 16 + fr) * TS_ + k * 32 + fq * 8) * 2), LDSV(L_VT + ((vtile * 16 + fr) * TS_ + k * 32 + fq * 8) * 2), o[n]);
#pragma unroll
                for (int k = 0; k < 4; ++k) o[n] = MFMA16(LDSV(L_QD + ((ti * 16 + fr) * QS_ + k * 32 + fq * 8) * 2), LDSV(L_ST + ((vtile * 16 + fr) * QS_ + k * 32 + fq * 8) * 2), o[n]);
                __builtin_amdgcn_sched_barrier(0); }
#pragma unroll
            for (int j = 0; j < 4; ++j) { float q = 0.f;
#pragma unroll
                for (int n = 0; n < 4; ++n) q += o[n][j] * o[n][j];
                q += __shfl_xor(q, 1); q += __shfl_xor(q, 2); q += __shfl_xor(q, 4); q += __shfl_xor(q, 8);
                if (fr == 0) *(LAS float*)(lds + L_RED + ((wid & 1) * 64 + ti * 16 + fq * 4 + j) * 4) = q; }
        }
        { float d[4];
#pragma unroll
          for (int j = 0; j < 4; ++j) d[j] = *(const LAS float*)(lds + L_DEC + (crow + j) * 4);
#pragma unroll
          for (int n = 0; n < 8; ++n) {
#pragma unroll
              for (int j = 0; j < 4; ++j) S[n][j] *= d[j];
#pragma unroll
              for (int k = 0; k < 2; ++k) S[n] = MFMA16(LDSV(L_KT + ((wid * 16 + fr) * TS_ + k * 32 + fq * 8) * 2), LDSV(L_VT + ((n * 16 + fr) * TS_ + k * 32 + fq * 8) * 2), S[n]);
              if (n & 1) __builtin_amdgcn_sched_barrier(0); } }
        __syncthreads();
        if (PASSB) {
#pragma unroll
            for (int n = 0; n < 8; ++n) { u32x2 w; w[0] = cvt_pk_bf16(S[n][0], S[n][1]); w[1] = cvt_pk_bf16(S[n][2], S[n][3]); *(LAS u32x2*)(lds + L_ST + ((n * 16 + fr) * QS_ + crow) * 2) = w; }
#pragma unroll
            for (int j = 0; j < 4; ++j) { const int t = ti * 16 + fq * 4 + j;
                const float ri = rsqrtf((*(const LAS float*)(lds + L_RED + t * 4) + *(const LAS float*)(lds + L_RED + (64 + t) * 4)) * (1.f / HD) + RMS_EPS);
#pragma unroll
                for (int n = 0; n < 4; ++n) *(LAS bf16_t*)(lds + L_VT + (t * 128 + ((wid & 1) * 4 + n) * 16 + fr) * 2) = f2bf(o[n][j] * ri); }
            __syncthreads();
#pragma unroll
            for (int i = 0; i < 2; ++i) { const u32x4 yv = *(const LAS u32x4*)(lds + L_VT + ((ptok + 32 * i) * 128 + pch) * 2); f32x4 y0, y1, g0, g1; unpack8(yv, y0, y1); unpack8(cg_[i], g0, g1);
                *(u32x4*)(yh + (size_t)(tok0 + ptok + 32 * i) * DM + h * HD + pch) = pack8(y0 * g0, y1 * g1); }
        }
    }
    if (PASSB) {
        if (seg == NSEG - 1) { float* dst = p.out + O_HP + (size_t)(b * NH + h) * HD * HD + crow * HD + fr;
#pragma unroll
            for (int n = 0; n < 8; ++n)
#pragma unroll
                for (int j = 0; j < 4; ++j) dst[j * HD + n * 16] = S[n][j] * DG(1.00837f); }
    } else {
        float* sl = sloc + (size_t)((b * NH + h) * NSEG + seg) * HD * HD + crow * HD + fr;
#pragma unroll
        for (int n = 0; n < 8; ++n)
#pragma unroll
            for (int j = 0; j < 4; ++j) sl[j * HD + n * 16] = S[n][j];
        if (tg == 0) sdec[((b * NH + h) * NSEG + seg) * HD + c] = segtot;
    }
}
constexpr int L2_Q = 0, L2_K = 4096, L2_F = 8192, L2_V = 12288, L2_OG = 16384, L2_PO = 20480, L2_RED = 36864;
__device__ void hgrn_sample_item(const Params& p, LAS unsigned char* lds, int bs, int h) {
    const int tid = threadIdx.x, v = tid & 127, cq = tid >> 7, lane = tid & 63, wid = tid >> 6;
    const bf16_t* qs = (const bf16_t*)(p.ws + WS_QS); const bf16_t* zf = (const bf16_t*)(p.ws + WS_ZF); const bf16_t* vv = (const bf16_t*)(p.ws + WS_VV); const bf16_t* og = (const bf16_t*)(p.ws + WS_OG);
    bf16_t* yh = (bf16_t*)p.out;
    const float* s0 = p.in[3] + (size_t)(bs * NH + h) * HD * HD; float* s1 = p.out + O_HS + (size_t)(bs * NH + h) * HD * HD;
    float S[32];
#pragma unroll
    for (int i = 0; i < 32; ++i) S[i] = s0[(cq * 32 + i) * HD + v];
    __syncthreads();
    { const float l0 = p.in[11][h * HD + v], l1 = p.in[11][DM + h * HD + v]; const float lbv = sigm(l0 - l1), oml = 1.f - lbv;
#pragma unroll
      for (int r = 0; r < 2; ++r) { const int t = cq * 2 + r; const size_t gi = (size_t)(NPTOK + bs * DSEQ + t) * DM + h * HD + v; const float sg = sigm(bf2f(zf[gi]));
          *(LAS float*)(lds + L2_Q + (t * 128 + v) * 4) = bf2f(qs[gi]); *(LAS float*)(lds + L2_K + (t * 128 + v) * 4) = oml * (1.f - sg); *(LAS float*)(lds + L2_F + (t * 128 + v) * 4) = lbv + oml * sg;
          *(LAS float*)(lds + L2_V + (t * 128 + v) * 4) = bf2f(vv[gi]); *(LAS float*)(lds + L2_OG + (t * 128 + v) * 4) = bf2f(og[gi]); } }
    __syncthreads();
#pragma unroll 1
    for (int t = 0; t < DSEQ; ++t) { const float vt = *(const LAS float*)(lds + L2_V + (t * 128 + v) * 4); float po = 0.f;
#pragma unroll
        for (int i4 = 0; i4 < 8; ++i4) { const int co = (t * 128 + cq * 32 + i4 * 4) * 4;
            const f32x4 f = *(const LAS f32x4*)(lds + L2_F + co), k = *(const LAS f32x4*)(lds + L2_K + co), q = *(const LAS f32x4*)(lds + L2_Q + co);
#pragma unroll
            for (int i = 0; i < 4; ++i) { S[i4 * 4 + i] = f[i] * S[i4 * 4 + i] + k[i] * vt; po += S[i4 * 4 + i] * q[i]; } }
        *(LAS float*)(lds + L2_PO + ((t * 4 + cq) * 128 + v) * 4) = po; }
#pragma unroll
    for (int i = 0; i < 32; ++i) s1[(cq * 32 + i) * HD + v] = S[i] * DG(1.01265f);
    __syncthreads();
    float ov[2];
#pragma unroll
    for (int r = 0; r < 2; ++r) { const int t = cq * 2 + r; float o = 0.f;
#pragma unroll
        for (int g = 0; g < 4; ++g) o += *(const LAS float*)(lds + L2_PO + ((t * 4 + g) * 128 + v) * 4);
        ov[r] = o; float q = o * o;
#pragma unroll
        for (int s = 32; s; s >>= 1) q += __shfl_xor(q, s);
        if (lane == 0) *(LAS float*)(lds + L2_RED + (t * 2 + (wid & 1)) * 4) = q; }
    __syncthreads();
#pragma unroll
    for (int r = 0; r < 2; ++r) { const int t = cq * 2 + r; const float ri = rsqrtf((*(const LAS float*)(lds + L2_RED + (t * 2) * 4) + *(const LAS float*)(lds + L2_RED + (t * 2 + 1) * 4)) * (1.f / HD) + RMS_EPS);
        yh[(size_t)(NPTOK + bs * DSEQ + t) * DM + h * HD + v] = f2bf(ov[r] * ri * *(const LAS float*)(lds + L2_OG + (t * 128 + v) * 4)); }
}
#define XB_TMO      128
#define XB_XCNT(j)  (256  + 64 * (j))
#define XB_XSUB(j)  (1280 + 64 * (j))
#define XB_XGEN(j)  (2304 + 64 * (j))
#define XB_TOP      3328
#define XB_TOPGEN   3392
#define XCD_BAR_WORDS 3456
#define XB_SPIN_CAP (1u << 18)

__device__ __forceinline__ unsigned xb_ld(unsigned* p)              { return __hip_atomic_load(p, __ATOMIC_RELAXED, __HIP_MEMORY_SCOPE_AGENT); }
__device__ __forceinline__ unsigned xb_add(unsigned* p, unsigned v) { return __hip_atomic_fetch_add(p, v, __ATOMIC_RELAXED, __HIP_MEMORY_SCOPE_AGENT); }
__device__ __forceinline__ unsigned xb_xcc_id() { return (unsigned)__builtin_amdgcn_s_getreg((3 << 11) | 20) & 0xFu; }
#define XB_SPIN(cond, bar) do { unsigned _sp = 0; while (cond) { __builtin_amdgcn_s_sleep(1); \
    if ((++_sp & 255u) == 0u) { if (xb_ld(&(bar)[XB_TMO])) break; if (_sp > XB_SPIN_CAP) { atomicAdd(&(bar)[XB_TMO], 1u); break; } } } } while (0)

struct XcdBarrier {
    unsigned* bar; unsigned x;
    volatile LAS unsigned* st;
};

__device__ __forceinline__ XcdBarrier xcd_barrier_post(unsigned* bar, volatile LAS unsigned* st) {
    XcdBarrier b; b.bar = bar; b.x = xb_xcc_id(); b.st = st;
    if (threadIdx.x == 0) (void)xb_add(&bar[XB_XCNT(b.x)], 1u);
    return b;
}
__device__ __forceinline__ void xcd_barrier_complete(unsigned* bar, unsigned x, unsigned& nloc, unsigned& nx) {
    const unsigned G = gridDim.x * gridDim.y * gridDim.z;
    unsigned sum, cnt, mine, sp = 0u;
    for (;;) {
        sum = 0u; cnt = 0u; mine = 0u;
#pragma unroll
        for (unsigned j = 0; j < 16; ++j) { const unsigned c = xb_ld(&bar[XB_XCNT(j)]); sum += c; cnt += (c > 0u) ? 1u : 0u; mine = (j == x) ? c : mine; }
        if (sum == G) break;
        __builtin_amdgcn_s_sleep(1);
        if ((++sp & 255u) == 0u) { if (xb_ld(&bar[XB_TMO])) break; if (sp > XB_SPIN_CAP) { atomicAdd(&bar[XB_TMO], 1u); break; } }
    }
    nloc = mine > 0u ? mine : 1u; nx = cnt > 0u ? cnt : 1u;
}

__device__ __forceinline__ void xcd_barrier(const XcdBarrier& b) {
    asm volatile("s_waitcnt vmcnt(0)" ::: "memory");
    __syncthreads();
    if (threadIdx.x == 0) {
        unsigned* bar = b.bar;
        __builtin_amdgcn_s_waitcnt(0);
        unsigned nloc = b.st[0], nx = b.st[1];
        if (nloc == 0u) { xcd_barrier_complete(bar, b.x, nloc, nx); b.st[0] = nloc; b.st[1] = nx; }
        const unsigned old = xb_add(&bar[XB_XSUB(b.x)], 1u);
        const unsigned gen = old / nloc;
        if (old + 1u == (gen + 1u) * nloc) {
            __builtin_amdgcn_fence(__ATOMIC_RELEASE, "agent");
            asm volatile("s_waitcnt vmcnt(0)" ::: "memory");
            const unsigned og = xb_add(&bar[XB_TOP], 1u);
            const unsigned tg = og / nx;
            if (og + 1u == (tg + 1u) * nx) xb_add(&bar[XB_TOPGEN], 1u);
            else XB_SPIN(xb_ld(&bar[XB_TOPGEN]) == tg, bar);
            __builtin_amdgcn_fence(__ATOMIC_ACQUIRE, "agent");
            xb_add(&bar[XB_XGEN(b.x)], 1u);
            asm volatile("s_waitcnt vmcnt(0)" ::: "memory");
        } else {
            XB_SPIN(xb_ld(&bar[XB_XGEN(b.x)]) == gen, bar);
            __builtin_amdgcn_fence(__ATOMIC_ACQUIRE, "agent");
            asm volatile("s_waitcnt vmcnt(0)" ::: "memory");
        }
    }

    __syncthreads();
}
constexpr int N_PHASES = 12;
template <int PH> __device__ __forceinline__ void run_phase(const Params& p, LAS unsigned char* lds) {
    unsigned char* ws = p.ws; const int G = gridDim.x, bid = blockIdx.x;
    float* mod = (float*)(ws + WS_MOD);
    if constexpr (PH == 0) phase_prep(p, lds);
    else if constexpr (PH == 1) { pg8::Gemm g{(const bf16_t*)(ws + WS_CACT), (const bf16_t*)(ws + WS_WADA), 256, NMODC, DM}; pg8::StaticOrder S; S.init(256, NMODC, G, bid);
        EpiAda E{mod, p.in[7]}; pg8::gemm_phase(lds, g, S, E); }
    else if constexpr (PH == 2) phase_u(p);
    else if constexpr (PH == 3) { pg8::Gemm g{(const bf16_t*)(p.out + O_HS), (const bf16_t*)(ws + WS_WIN), NTOK, DIN, DM}; pg8::StaticOrder S; S.init(NTOK, DIN, G, bid);
        EpiZ E{p.out, (bf16_t*)(ws + WS_QS), (bf16_t*)(ws + WS_ZF), (bf16_t*)(ws + WS_VV), (bf16_t*)(ws + WS_OG), (bf16_t*)((unsigned char*)p.out + S35), (bf16_t*)(ws + WS_GB), p.in[12]};
        pg8::gemm_phase(lds, g, S, E); }
    else if constexpr (PH == 4) { phase_pool(p);
        for (int it = bid; it < NBP * NH * (NSEG - 1); it += G) hgrn_item<false>(p, lds, it / (NH * (NSEG - 1)), (it / (NSEG - 1)) % NH, it % (NSEG - 1)); }
    else if constexpr (PH == 5) {
        for (int it = bid; it < NBP * NH * NSEG + NBS * NH; it += G) {
            if (it < NBP * NH * NSEG) hgrn_item<true>(p, lds, it / (NH * NSEG), (it / NSEG) % NH, it % NSEG);
            else { const int s = it - NBP * NH * NSEG; hgrn_sample_item(p, lds, s >> 3, s & 7); } } }
    else if constexpr (PH == 6) { pg8::StaticOrder S; S.init(NTOK, DM, G, bid);
#if !defined(P6) || P6 == 0
        { pg8::Gemm g{(const bf16_t*)(ws + WS_DMB), (const bf16_t*)(ws + WS_WEFF), NTOK, DM, DPOOL}; EpiP E{(float*)(ws + WS_QS), (const bf16_t*)((unsigned char*)p.out + S35)}; pg8::gemm_phase(lds, g, S, E); }
#endif
#if !defined(P6) || P6 == 1
        { pg8::Gemm g{(const bf16_t*)p.out, (const bf16_t*)(ws + WS_WB), NTOK, DM, DM}; EpiM E{(const float*)(ws + WS_QS), (const bf16_t*)(ws + WS_GB), (bf16_t*)(ws + WS_VV)}; pg8::gemm_phase(lds, g, S, E); }
#endif
    }
    else if constexpr (PH == 7) { pg8::Gemm g{(const bf16_t*)(ws + WS_VV), (const bf16_t*)(ws + WS_WOUT), NTOK, DM, DM}; pg8::StaticOrder S; S.init(NTOK, DM, G, bid);
        EpiRes E{p.in[0], p.in[1], mod, 2 * DM, p.out}; pg8::gemm_phase(lds, g, S, E); }
    else if constexpr (PH == 8) phase_ln<true>(p);
    else if constexpr (PH == 9) { pg8::Gemm g{(const bf16_t*)(ws + WS_OG), (const bf16_t*)(ws + WS_WGU), NTOK, 2 * DFF, DM}; pg8::StaticOrder S; S.init(NTOK, 2 * DFF, G, bid);
        EpiGU E{(bf16_t*)(ws + WS_VV)}; pg8::gemm_phase(lds, g, S, E); }
    else if constexpr (PH == 10) { pg8::Gemm g{(const bf16_t*)(ws + WS_VV), (const bf16_t*)(ws + WS_WDN), NTOK, DM, DFF}; pg8::StaticOrder S; S.init(NTOK, DM, G, bid);
        const float* x1 = (const float*)(ws + WS_QS); EpiRes E{x1, x1 + (size_t)NPTOK * DM, mod, 5 * DM, p.out}; pg8::gemm_phase(lds, g, S, E); }
    else phase_ln<false>(p);
}
#if N_LAUNCH_MODE == 0
#define RUN_PHASE(PH) { const __attribute__((address_space(4))) Params* q_ = kp; asm volatile("" : "+s"(q_)); const Params lp_ = *(const Params*)q_; run_phase<PH>(lp_, lds); }
#define PHASE_SYNC(PH) RUN_PHASE(PH) xcd_barrier(xb);
__global__ __launch_bounds__(512, 2) void mega(Params p) {
    extern __shared__ __attribute__((aligned(16))) unsigned char shm[];
    LAS unsigned char* lds = (LAS unsigned char*)shm;
#if defined(__HIP_DEVICE_COMPILE__)
    cg::grid_group grid = cg::this_grid();
    const __attribute__((address_space(4))) Params* kp = (const __attribute__((address_space(4))) Params*)__builtin_amdgcn_kernarg_segment_ptr();
    LAS unsigned* stw = (LAS unsigned*)(lds + 131072);
    if (threadIdx.x == 0) { stw[0] = 0u; stw[1] = 0u; stw[2] = 0u; stw[3] = 0u; }
    __syncthreads();
    const XcdBarrier xb = xcd_barrier_post((unsigned*)(p.ws + WS_BAR), (volatile LAS unsigned*)stw);
    RUN_PHASE(0) grid.sync();
    PHASE_SYNC(1) PHASE_SYNC(2) PHASE_SYNC(3) PHASE_SYNC(4) PHASE_SYNC(5) PHASE_SYNC(6) PHASE_SYNC(7) PHASE_SYNC(8) PHASE_SYNC(9) PHASE_SYNC(10)
    RUN_PHASE(11)
#endif
}
#else
template <int PH> __global__ __launch_bounds__(512, 2) void mega(Params p) {
    extern __shared__ __attribute__((aligned(16))) unsigned char shm[];
    run_phase<PH>(p, (LAS unsigned char*)shm);
}
template <int PH> static void launch_phase(const Params& p, int grid, hipStream_t stream) {
    static bool attr = false;
    if (!attr) { (void)hipFuncSetAttribute((const void*)mega<PH>, hipFuncAttributeMaxDynamicSharedMemorySize, LDS_BYTES); attr = true; }
    hipLaunchKernelGGL(mega<PH>, dim3(grid), dim3(512), LDS_BYTES, stream, p);
}
#endif

extern "C" void kernel_launch(void* const* d_in, const int* in_sizes, int n_in, void* d_out, int out_size, void* d_ws, size_t ws_size, hipStream_t stream) {
    static int grid_blocks = 0;
    if (!grid_blocks) {
        int dev = 0, cus = 0, per_cu = 0;
        (void)hipGetDevice(&dev); (void)hipDeviceGetAttribute(&cus, hipDeviceAttributeMultiprocessorCount, dev);
#if N_LAUNCH_MODE == 0
        if (hipFuncSetAttribute((const void*)mega, hipFuncAttributeMaxDynamicSharedMemorySize, LDS_BYTES) != hipSuccess) fprintf(stderr, "hipFuncSetAttribute failed\n");
        if (hipOccupancyMaxActiveBlocksPerMultiprocessor(&per_cu, (const void*)mega, 512, LDS_BYTES) != hipSuccess || per_cu < 1) { fprintf(stderr, "occupancy query: %d\n", per_cu); per_cu = 1; }
        (void)hipGetLastError();
#else
        per_cu = 1;
#endif
        grid_blocks = cus * per_cu;
        if (ws_size < WS_BAR + 16384 || n_in != 23) fprintf(stderr, "kernel_launch: ws_size %zu < %zu or n_in %d != 23\n", ws_size, (size_t)WS_NEED, n_in);
    }
    Params p{};
    for (int i = 0; i < 23; ++i) p.in[i] = (const float*)d_in[i];
    p.out = (float*)d_out; p.ws = (unsigned char*)d_ws;
#if N_LAUNCH_MODE == 0
    (void)hipMemsetAsync((unsigned char*)d_ws + WS_BAR, 0, XCD_BAR_WORDS * sizeof(unsigned), stream);
    void* args[] = {&p};
    hipError_t e = hipLaunchCooperativeKernel((const void*)mega, dim3(grid_blocks), dim3(512), args, LDS_BYTES, stream);
    if (e != hipSuccess) fprintf(stderr, "cooperative launch failed: %s (grid %d)\n", hipGetErrorString(e), grid_blocks);
#else
    launch_phase<0>(p, grid_blocks, stream); launch_phase<1>(p, grid_blocks, stream); launch_phase<2>(p, grid_blocks, stream); launch_phase<3>(p, grid_blocks, stream);
    launch_phase<4>(p, grid_blocks, stream); launch_phase<5>(p, grid_blocks, stream); launch_phase<6>(p, grid_blocks, stream); launch_phase<7>(p, grid_blocks, stream);
    launch_phase<8>(p, grid_blocks, stream); launch_phase<9>(p, grid_blocks, stream); launch_phase<10>(p, grid_blocks, stream); launch_phase<11>(p, grid_blocks, stream);
#endif
}
```

```cpp
#include <hip/hip_runtime.h>
#include <hip/hip_cooperative_groups.h>
#include <cstdio>
namespace cg = cooperative_groups;

#ifndef N_LAUNCH_MODE
#define N_LAUNCH_MODE 0
#endif

constexpr int DM = 1024, NTOK = 17408, NPTOK = 16384, SEQ = 2048, NBP = 8, NBS = 128, DSEQ = 8;
constexpr int DIN = 6656, DFF = 2816, DPOOL = 512, NH = 8, HD = 128, PBUF = 15, NMODC = 6144;
constexpr float ALPHA = 1.1892071150027210f;
constexpr float LN_EPS = 1e-5f, RMS_EPS = 1e-6f;
constexpr int NSEG = 4, SEGLEN = SEQ / NSEG, CH = 64, NCHSEG = SEGLEN / CH;
constexpr size_t O_YP = 0, O_YS = 16777216, O_PP = 17825792, O_HP = 17887232, O_PS = 18935808, O_HS = 19918848;
constexpr size_t S35 = 35651584;
constexpr size_t WS_WIN = 0, WS_WADA = 13631488, WS_WEFF = 26214400, WS_WB = 27262976, WS_WOUT = 29360128, WS_WGU = 31457280,
                 WS_WDN = 42991616, WS_CACT = 48758784, WS_MOD = 49283072, WS_QS = 55574528, WS_ZF = WS_QS + S35, WS_OG = WS_ZF + S35,
                 WS_VV = WS_OG + S35, WS_GB = WS_VV + S35, WS_DMB = WS_GB + S35, WS_NEED = WS_VV + 98041856;
constexpr size_t WS_SLOC = 0, WS_SDEC = 16777216;
constexpr int LDS_BYTES = 131072 + 16;
constexpr size_t WS_BAR = 260571136;
#define DIAG 0
#if DIAG
#define DG(x) (x)
#else
#define DG(x) 1.0f
#endif

struct Params {
    const float* in[23];
    float* out;
    unsigned char* ws;
};
namespace pg8 {
#define PG8_LAS __attribute__((address_space(3)))
typedef unsigned short bf16_t;
typedef short bf16x8 __attribute__((ext_vector_type(8)));
typedef float f32x4 __attribute__((ext_vector_type(4)));
typedef unsigned u32x4 __attribute__((ext_vector_type(4)));
typedef unsigned u32x2 __attribute__((ext_vector_type(2)));
constexpr int BM = 256, BK = 64, HALF = 128, HTB = HALF * BK * 2, STAGE_BYTES = 8 * HTB, NXCD = 8, WGM = 8;
__host__ __device__ __forceinline__ int lds_byte(int r, int c) { const int st = (r >> 4) * 2 + (c >> 5), rr = r & 15, cc = c & 31, ob = rr * 64 + cc * 2; return st * 1024 + (ob ^ (((ob >> 9) & 1) << 5)); }
__host__ __device__ __forceinline__ void stage_rc(int b, int& R, int& C) { const int st = b / 1024, sb = b % 1024, swz = sb ^ (((sb >> 9) & 1) << 5); R = (st >> 1) * 16 + swz / 64; C = (st & 1) * 32 + (swz % 64) / 2; }
__host__ __device__ __forceinline__ int perm32(int rho) { const int n = rho >> 4, i = rho & 15; return 8 * (i >> 2) + 4 * n + (i & 3); }
struct Unit { int pm, pn; };
struct Gemm { const bf16_t* A; const bf16_t* Bt; int M, N, K; };
struct StaticOrder {
    int nM, nN, nwg, G, c;
    __host__ __device__ void init(int M, int N, int G_, int c_) { nM = M / BM; nN = N / BM; nwg = nM * nN; G = G_; c = c_; }
    __host__ __device__ bool next(int i, Unit& u) const {
        const long L = (long)i * G + c; if (L >= nwg) return false;
        int wgid = (int)L; { const int q = nwg / NXCD, r = nwg % NXCD, xcd = wgid % NXCD, off = wgid / NXCD; wgid = (xcd < r ? xcd * (q + 1) : r * (q + 1) + (xcd - r) * q) + off; }
        const int nig = WGM * nN, gid = wgid / nig, fm = gid * WGM, gsz = (nM - fm) < WGM ? (nM - fm) : WGM;
        u.pm = fm + ((wgid % nig) % gsz); u.pn = (wgid % nig) / gsz; return true;
    }
    __device__ __forceinline__ void a_ready(const Unit&) const {}
    __device__ __forceinline__ void done(const Unit&) const {}
};
__device__ __forceinline__ unsigned cvt_pk_bf16(float lo, float hi) { unsigned r; asm volatile("v_cvt_pk_bf16_f32 %0, %1, %2" : "=v"(r) : "v"(lo), "v"(hi)); return r; }
template <class Epi, class Sched>
__device__ __forceinline__ void gemm_phase(PG8_LAS unsigned char* lds, const Gemm g, const Sched& S, const Epi& E) {
    const int tid = threadIdx.x, wid = __builtin_amdgcn_readfirstlane(tid >> 6), lane = tid & 63, wr = wid >> 2, wc = wid & 3, fr = lane & 15, fq = lane >> 4;
    const int K = g.K, nt = K / BK;
    unsigned voffA[2], voffB[2];
#pragma unroll
    for (int i = 0; i < 2; ++i) { int R, C; stage_rc(tid * 16 + i * 8192, R, C); const int Rb = Epi::PERM ? ((R & ~31) + perm32(R & 31)) : R;
        voffA[i] = (unsigned)(R * K + C) * 2u; voffB[i] = (unsigned)(Rb * K + C) * 2u; }
    const size_t kstep = (size_t)(BK * 2);
    const size_t hstep = (size_t)HALF * K * 2;
    const size_t tstep = 2 * hstep;
    const unsigned ldsw = (unsigned)wid * 1024u;
    const int aoff = lds_byte(wr * 64 + fr, fq * 8), boff = lds_byte(wc * 32 + fr, fq * 8);
#define PG8_SA(b, h) (((b) * 2 + (h)) * HTB)
#define PG8_SB(b, h) ((4 + (b) * 2 + (h)) * HTB)
#define PG8_STAGE(bufoff, gbase, voff) do { _Pragma("unroll") for (int _i = 0; _i < 2; ++_i) \
        __builtin_amdgcn_global_load_lds((const unsigned*)((const char*)(gbase) + (voff)[_i]), (PG8_LAS unsigned*)(lds + (bufoff) + ldsw + _i * 8192), 16, 0, 0); } while (0)
#define PG8_LDA(dst, b, h) do { _Pragma("unroll") for (int m = 0; m < 4; ++m) _Pragma("unroll") for (int k = 0; k < 2; ++k) dst[m][k] = *(const PG8_LAS bf16x8*)(lds + PG8_SA(b, h) + aoff + m * 2048 + k * 1024); } while (0)
#define PG8_LDB(dst, b, h) do { _Pragma("unroll") for (int n = 0; n < 2; ++n) _Pragma("unroll") for (int k = 0; k < 2; ++k) dst[n][k] = *(const PG8_LAS bf16x8*)(lds + PG8_SB(b, h) + boff + n * 2048 + k * 1024); } while (0)
#define PG8_MMA(ai, bj, At, Bt) do { __builtin_amdgcn_s_setprio(1); _Pragma("unroll") for (int m = 0; m < 4; ++m) _Pragma("unroll") for (int n = 0; n < 2; ++n) _Pragma("unroll") for (int k = 0; k < 2; ++k) \
        acc[ai][bj][m][n] = __builtin_amdgcn_mfma_f32_16x16x32_bf16(Bt[n][k], At[m][k], acc[ai][bj][m][n], 0, 0, 0); __builtin_amdgcn_s_setprio(0); } while (0)
#define PG8_WAIT_V(n) asm volatile("s_waitcnt vmcnt(" #n ")" ::: "memory")
#define PG8_WAIT_L(n) asm volatile("s_waitcnt lgkmcnt(" #n ")" ::: "memory")
#define PG8_BAR __builtin_amdgcn_s_barrier()
#define PG8_SCHED __builtin_amdgcn_sched_barrier(0)
    Unit cur, nxt; int ui = 0;
    if (!S.next(0, cur)) return;
    f32x4 acc[2][2][4][2];
#pragma unroll
    for (int a = 0; a < 2; ++a)
#pragma unroll
        for (int b = 0; b < 2; ++b)
#pragma unroll
            for (int m = 0; m < 4; ++m)
#pragma unroll
                for (int n = 0; n < 2; ++n) acc[a][b][m][n] = (f32x4){0.f, 0.f, 0.f, 0.f};
    bf16x8 At[4][2], B0[2][2], B1[2][2];
    const char* cA = (const char*)g.A + (size_t)cur.pm * tstep; const char* cB = (const char*)g.Bt + (size_t)cur.pn * tstep;
    S.a_ready(cur);
    PG8_STAGE(PG8_SB(0, 0), cB, voffB); PG8_STAGE(PG8_SA(0, 0), cA, voffA); PG8_STAGE(PG8_SB(0, 1), cB + hstep, voffB); PG8_STAGE(PG8_SA(0, 1), cA + hstep, voffA);
    if (wr == 1) PG8_BAR;
    PG8_WAIT_V(4); PG8_BAR;
    PG8_STAGE(PG8_SB(1, 0), cB + kstep, voffB); PG8_STAGE(PG8_SA(1, 0), cA + kstep, voffA); PG8_STAGE(PG8_SB(1, 1), cB + hstep + kstep, voffB);
    PG8_WAIT_V(6); PG8_BAR;
    for (;;) {
        const bool has_next = S.next(ui + 1, nxt);
        const char* nA = has_next ? (const char*)g.A + (size_t)nxt.pm * tstep : cA; const char* nB = has_next ? (const char*)g.Bt + (size_t)nxt.pn * tstep : cB;
        for (int t = 0; t < nt; t += 2) {
            const bool last = (t == nt - 2);
            const char* a1 = cA + (size_t)(t + 1) * kstep;
            const char* a2 = last ? nA : cA + (size_t)(t + 2) * kstep; const char* b2 = last ? nB : cB + (size_t)(t + 2) * kstep;
            const char* a3 = a2 + kstep; const char* b3 = b2 + kstep;
            if (last && has_next) S.a_ready(nxt);
            PG8_LDB(B0, 0, 0); PG8_SCHED; PG8_LDA(At, 0, 0); PG8_STAGE(PG8_SA(1, 1), a1 + hstep, voffA);
            PG8_WAIT_L(8); PG8_BAR; PG8_WAIT_L(0); PG8_MMA(0, 0, At, B0); PG8_BAR; PG8_SCHED;
            PG8_LDB(B1, 0, 1); PG8_STAGE(PG8_SB(0, 0), b2, voffB);
            PG8_BAR; PG8_WAIT_L(0); PG8_MMA(0, 1, At, B1); PG8_BAR;
            PG8_LDA(At, 0, 1); PG8_STAGE(PG8_SA(0, 0), a2, voffA);
            PG8_BAR; PG8_WAIT_L(0); PG8_MMA(1, 0, At, B0); PG8_BAR; PG8_SCHED;
            PG8_STAGE(PG8_SB(0, 1), b2 + hstep, voffB);
            PG8_WAIT_V(6); PG8_BAR; PG8_MMA(1, 1, At, B1); PG8_BAR;
            PG8_LDB(B0, 1, 0); PG8_SCHED; PG8_LDA(At, 1, 0); PG8_STAGE(PG8_SA(0, 1), a2 + hstep, voffA);
            PG8_WAIT_L(8); PG8_BAR; PG8_WAIT_L(0); PG8_MMA(0, 0, At, B0); PG8_BAR; PG8_SCHED;
            PG8_LDB(B1, 1, 1); PG8_STAGE(PG8_SB(1, 0), b3, voffB);
            PG8_BAR; PG8_WAIT_L(0); PG8_MMA(0, 1, At, B1); PG8_BAR;
            PG8_LDA(At, 1, 1); PG8_STAGE(PG8_SA(1, 0), a3, voffA);
            PG8_BAR; PG8_WAIT_L(0); PG8_MMA(1, 0, At, B0); PG8_BAR; PG8_SCHED;
            PG8_STAGE(PG8_SB(1, 1), b3 + hstep, voffB);
            PG8_WAIT_V(6); PG8_BAR; PG8_MMA(1, 1, At, B1); PG8_BAR;
        }
        if constexpr (!Epi::AFTER_DRAIN) { E(acc, cur, wr, wc, fr, fq); S.done(cur); }
        if (!has_next) break;
#pragma unroll
        for (int a = 0; a < 2; ++a)
#pragma unroll
            for (int b = 0; b < 2; ++b)
#pragma unroll
                for (int m = 0; m < 4; ++m)
#pragma unroll
                    for (int n = 0; n < 2; ++n) acc[a][b][m][n] = (f32x4){0.f, 0.f, 0.f, 0.f};
        cur = nxt; cA = nA; cB = nB; ++ui;
    }
    PG8_WAIT_V(0);
    if (wr == 0) PG8_BAR;
    PG8_BAR;
    if constexpr (Epi::AFTER_DRAIN) { E.fused(acc, cur, wr, wc, fr, fq, lds, wid, lane); S.done(cur); }
#undef PG8_SA
#undef PG8_SB
#undef PG8_STAGE
#undef PG8_LDA
#undef PG8_LDB
#undef PG8_MMA
#undef PG8_WAIT_V
#undef PG8_WAIT_L
#undef PG8_BAR
#undef PG8_SCHED
}
}

using pg8::bf16_t; using pg8::bf16x8; using pg8::f32x4; using pg8::u32x4; using pg8::u32x2; using pg8::cvt_pk_bf16;
#define LAS __attribute__((address_space(3)))

__device__ __forceinline__ float sigm(float x) { return __builtin_amdgcn_rcpf(1.f + __expf(-x)); }
__device__ __forceinline__ float silu_(float x) { return x * sigm(x); }
__device__ __forceinline__ float bf2f(unsigned b) { return __uint_as_float(b << 16); }
__device__ __forceinline__ bf16_t f2bf(float f) { unsigned u = __float_as_uint(f); u += 0x7FFFu + ((u >> 16) & 1u); return (bf16_t)(u >> 16); }
__device__ __forceinline__ int mrow_of(int tok) { return tok < NPTOK ? (tok >> 11) : 8 + ((tok - NPTOK) >> 3); }
__device__ __forceinline__ u32x4 pack8(const f32x4 a, const f32x4 b) { u32x4 r; r[0] = cvt_pk_bf16(a[0], a[1]); r[1] = cvt_pk_bf16(a[2], a[3]); r[2] = cvt_pk_bf16(b[0], b[1]); r[3] = cvt_pk_bf16(b[2], b[3]); return r; }
__device__ __forceinline__ void unpack8(const u32x4 r, f32x4& a, f32x4& b) {
    a[0] = bf2f(r[0] & 0xffffu); a[1] = __uint_as_float(r[0] & 0xffff0000u); a[2] = bf2f(r[1] & 0xffffu); a[3] = __uint_as_float(r[1] & 0xffff0000u);
    b[0] = bf2f(r[2] & 0xffffu); b[1] = __uint_as_float(r[2] & 0xffff0000u); b[2] = bf2f(r[3] & 0xffffu); b[3] = __uint_as_float(r[3] & 0xffff0000u); }

#define EPI_LOOP_ROWS _Pragma("unroll") for (int ai = 0; ai < 2; ++ai) _Pragma("unroll") for (int m = 0; m < 4; ++m)
struct EpiAda {
    static constexpr bool PERM = false, AFTER_DRAIN = false;
    float* C; const float* bias;
    __device__ __forceinline__ void operator()(const f32x4 (&acc)[2][2][4][2], const pg8::Unit& u, int wr, int wc, int fr, int fq) const {
        const int row0 = u.pm * 256 + wr * 64 + fr, col0 = u.pn * 256 + wc * 32 + 4 * fq;
        EPI_LOOP_ROWS { float* rowp = C + (size_t)(row0 + ai * 128 + m * 16) * NMODC + col0;
#pragma unroll
            for (int bj = 0; bj < 2; ++bj)
#pragma unroll
                for (int n = 0; n < 2; ++n) *(f32x4*)(rowp + bj * 128 + n * 16) = acc[ai][bj][m][n] + *(const f32x4*)(bias + col0 + bj * 128 + n * 16); }
    }
};
struct EpiZ {
    static constexpr bool PERM = true, AFTER_DRAIN = false;
    float* zp; bf16_t *qs, *zf, *vv, *og, *ga, *gb; const float* nw;
    __device__ __forceinline__ void operator()(const f32x4 (&acc)[2][2][4][2], const pg8::Unit& u, int wr, int wc, int fr, int fq) const {
        const int row0 = u.pm * 256 + wr * 64 + fr;
        if (u.pn < 2) {
            const int col0 = u.pn * 256 + wc * 32 + 8 * fq;
            EPI_LOOP_ROWS { float* rowp = zp + (size_t)(row0 + ai * 128 + m * 16) * DPOOL + col0;
#pragma unroll
                for (int bj = 0; bj < 2; ++bj) { *(f32x4*)(rowp + bj * 128) = acc[ai][bj][m][0]; *(f32x4*)(rowp + bj * 128 + 4) = acc[ai][bj][m][1]; } }
            return;
        }
        const int seg = (u.pn - 2) >> 2, col0 = ((u.pn - 2) & 3) * 256 + wc * 32 + 8 * fq;
        bf16_t* dst = seg == 0 ? qs : seg == 1 ? zf : seg == 2 ? vv : seg == 3 ? og : seg == 4 ? ga : gb;
        f32x4 w0[2], w1[2];
#pragma unroll
        for (int bj = 0; bj < 2; ++bj) { w0[bj] = (f32x4){1.f, 1.f, 1.f, 1.f}; w1[bj] = w0[bj]; if (seg == 3) { w0[bj] = *(const f32x4*)(nw + col0 + bj * 128); w1[bj] = *(const f32x4*)(nw + col0 + bj * 128 + 4); } }
        EPI_LOOP_ROWS { bf16_t* rowp = dst + (size_t)(row0 + ai * 128 + m * 16) * DM + col0;
#pragma unroll
            for (int bj = 0; bj < 2; ++bj) { f32x4 v0 = acc[ai][bj][m][0], v1 = acc[ai][bj][m][1];
                if (seg == 0 || seg == 3) {
#pragma unroll
                    for (int i = 0; i < 4; ++i) { v0[i] = silu_(v0[i]) * w0[bj][i]; v1[i] = silu_(v1[i]) * w1[bj][i]; }
                } else if (seg >= 4) {
#pragma unroll
                    for (int i = 0; i < 4; ++i) { v0[i] = sigm(v0[i]); v1[i] = sigm(v1[i]); }
                }
                *(u32x4*)(rowp + bj * 128) = pack8(v0, v1); } }
    }
};
struct EpiP {
    static constexpr bool PERM = true, AFTER_DRAIN = false;
    float* tmp; const bf16_t* ga;
    __device__ __forceinline__ void small4(int row, int col, const f32x4 v) const { const size_t ro = (size_t)row * DM + col; const u32x2 g = *(const u32x2*)(ga + ro);
        f32x4 gf; gf[0] = bf2f(g[0] & 0xffffu); gf[1] = __uint_as_float(g[0] & 0xffff0000u); gf[2] = bf2f(g[1] & 0xffffu); gf[3] = __uint_as_float(g[1] & 0xffff0000u); *(f32x4*)(tmp + ro) = v * gf; }
    __device__ __forceinline__ void operator()(const f32x4 (&acc)[2][2][4][2], const pg8::Unit& u, int wr, int wc, int fr, int fq) const {
        const int row0 = u.pm * 256 + wr * 64 + fr, col0 = u.pn * 256 + wc * 32 + 8 * fq;
        EPI_LOOP_ROWS { const size_t ro = (size_t)(row0 + ai * 128 + m * 16) * DM + col0;
#pragma unroll
            for (int bj = 0; bj < 2; ++bj) { f32x4 g0, g1; unpack8(*(const u32x4*)(ga + ro + bj * 128), g0, g1);
                *(f32x4*)(tmp + ro + bj * 128) = acc[ai][bj][m][0] * g0; *(f32x4*)(tmp + ro + bj * 128 + 4) = acc[ai][bj][m][1] * g1; } }
    }
};
struct EpiM {
    static constexpr bool PERM = true, AFTER_DRAIN = false;
    const float* tmp; const bf16_t* gb; bf16_t* mrg;
    __device__ __forceinline__ void small4(int row, int col, const f32x4 v) const { const size_t ro = (size_t)row * DM + col; const u32x2 g = *(const u32x2*)(gb + ro);
        f32x4 gf; gf[0] = bf2f(g[0] & 0xffffu); gf[1] = __uint_as_float(g[0] & 0xffff0000u); gf[2] = bf2f(g[1] & 0xffffu); gf[3] = __uint_as_float(g[1] & 0xffff0000u);
        const f32x4 t = *(const f32x4*)(tmp + ro) + v * gf; u32x2 o; o[0] = cvt_pk_bf16(t[0], t[1]); o[1] = cvt_pk_bf16(t[2], t[3]); *(u32x2*)(mrg + ro) = o; }
    __device__ __forceinline__ void operator()(const f32x4 (&acc)[2][2][4][2], const pg8::Unit& u, int wr, int wc, int fr, int fq) const {
        const int row0 = u.pm * 256 + wr * 64 + fr, col0 = u.pn * 256 + wc * 32 + 8 * fq;
        EPI_LOOP_ROWS { const size_t ro = (size_t)(row0 + ai * 128 + m * 16) * DM + col0;
#pragma unroll
            for (int bj = 0; bj < 2; ++bj) { f32x4 g0, g1; unpack8(*(const u32x4*)(gb + ro + bj * 128), g0, g1);
                const f32x4 t0 = *(const f32x4*)(tmp + ro + bj * 128), t1 = *(const f32x4*)(tmp + ro + bj * 128 + 4);
                *(u32x4*)(mrg + ro + bj * 128) = pack8(t0 + acc[ai][bj][m][0] * g0, t1 + acc[ai][bj][m][1] * g1); } }
    }
};
struct EpiRes {
    static constexpr bool PERM = false, AFTER_DRAIN = false;
    const float* resp; const float* ress; const float* mod; int goff; float* r;
    __device__ __forceinline__ void small4(int row, int col, const f32x4 v) const { const float* xr = row < NPTOK ? resp + (size_t)row * DM : ress + (size_t)(row - NPTOK) * DM;
        *(f32x4*)(r + (size_t)row * DM + col) = *(const f32x4*)(xr + col) * ALPHA + *(const f32x4*)(mod + (size_t)mrow_of(row) * NMODC + goff + col) * v; }
    __device__ __forceinline__ void operator()(const f32x4 (&acc)[2][2][4][2], const pg8::Unit& u, int wr, int wc, int fr, int fq) const {
        const int row0 = u.pm * 256 + wr * 64 + fr, col0 = u.pn * 256 + wc * 32 + 4 * fq;
        EPI_LOOP_ROWS { const int row = row0 + ai * 128 + m * 16; const float* xr = row < NPTOK ? resp + (size_t)row * DM : ress + (size_t)(row - NPTOK) * DM;
            const float* gr = mod + (size_t)mrow_of(row) * NMODC + goff + col0; float* rr = r + (size_t)row * DM + col0;
#pragma unroll
            for (int bj = 0; bj < 2; ++bj)
#pragma unroll
                for (int n = 0; n < 2; ++n) { const int o = bj * 128 + n * 16; *(f32x4*)(rr + o) = *(const f32x4*)(xr + col0 + o) * ALPHA + *(const f32x4*)(gr + o) * acc[ai][bj][m][n]; } }
    }
};
struct EpiGU {
    static constexpr bool PERM = true, AFTER_DRAIN = false;
    bf16_t* act;
    __device__ __forceinline__ void operator()(const f32x4 (&acc)[2][2][4][2], const pg8::Unit& u, int wr, int wc, int fr, int fq) const {
        const int row0 = u.pm * 256 + wr * 64 + fr, col0 = (u.pn * 256 + wc * 32 + 8 * fq) >> 1;
        EPI_LOOP_ROWS { bf16_t* rowp = act + (size_t)(row0 + ai * 128 + m * 16) * DFF + col0;
#pragma unroll
            for (int bj = 0; bj < 2; ++bj) { const f32x4 g = acc[ai][bj][m][0], up = acc[ai][bj][m][1]; u32x2 o;
                o[0] = cvt_pk_bf16(silu_(g[0]) * up[0], silu_(g[1]) * up[1]); o[1] = cvt_pk_bf16(silu_(g[2]) * up[2], silu_(g[3]) * up[3]);
                *(u32x2*)(rowp + bj * 64) = o; } }
    }
};
__device__ void transpose_job(const float* __restrict__ src, int K, int N, bf16_t* __restrict__ dst, int mode, LAS float* tile, int& job, int G) {
    const int tid = threadIdx.x, ntn = N / 256, ntiles = (K / 64) * ntn;
    for (int t = 0; t < ntiles; ++t, ++job) {
        if ((job % G) != (int)blockIdx.x) continue;
        const int k0 = (t / ntn) * 64, n0 = (t % ntn) * 256;
        { const int r = tid >> 4, c4 = tid & 15; f32x4 v[2][4];
#pragma unroll
          for (int rr = 0; rr < 2; ++rr)
#pragma unroll
              for (int q = 0; q < 4; ++q) v[rr][q] = *(const f32x4*)(src + (size_t)(k0 + r + rr * 32) * N + n0 + q * 64 + c4 * 4);
#pragma unroll
          for (int rr = 0; rr < 2; ++rr)
#pragma unroll
              for (int q = 0; q < 4; ++q)
#pragma unroll
                  for (int i = 0; i < 4; ++i) tile[(r + rr * 32) * 257 + q * 64 + c4 * 4 + i] = v[rr][q][i]; }
        __syncthreads();
        { const int k8 = tid & 7;
#pragma unroll
          for (int q = 0; q < 4; ++q) { const int nr = (tid >> 3) + 64 * q; float v[8];
#pragma unroll
              for (int i = 0; i < 8; ++i) v[i] = tile[(k8 * 8 + i) * 257 + nr];
              const int n = n0 + nr; const int nd = mode == 0 ? n : ((n >> 2) * 8 + (n & 3) + (mode == 2 ? 4 : 0));
              u32x4 o; o[0] = cvt_pk_bf16(v[0], v[1]); o[1] = cvt_pk_bf16(v[2], v[3]); o[2] = cvt_pk_bf16(v[4], v[5]); o[3] = cvt_pk_bf16(v[6], v[7]);
              *(u32x4*)(dst + (size_t)nd * K + k0 + k8 * 8) = o; } }
        __syncthreads();
    }
}
__device__ void phase_prep(const Params& p, LAS unsigned char* lds) {
    const int G = gridDim.x, tid = threadIdx.x; unsigned char* ws = p.ws;
    LAS float* tile = (LAS float*)lds;
    int job = 0;
    transpose_job(p.in[6], DM, NMODC, (bf16_t*)(ws + WS_WADA), 0, tile, job, G);
    transpose_job(p.in[8], DM, DIN, (bf16_t*)(ws + WS_WIN), 0, tile, job, G);
    transpose_job(p.in[14], DM, DM, (bf16_t*)(ws + WS_WB), 0, tile, job, G);
    transpose_job(p.in[15], DM, DM, (bf16_t*)(ws + WS_WOUT), 0, tile, job, G);
    transpose_job(p.in[18], DM, DFF, (bf16_t*)(ws + WS_WGU), 1, tile, job, G);
    transpose_job(p.in[19], DM, DFF, (bf16_t*)(ws + WS_WGU), 2, tile, job, G);
    transpose_job(p.in[20], DFF, DM, (bf16_t*)(ws + WS_WDN), 0, tile, job, G);
    { const float* wg = p.in[9]; const float* ps = p.in[10]; const float* wa = p.in[13]; bf16_t* weff = (bf16_t*)(ws + WS_WEFF);
      for (int it = 0; it < 256; ++it, ++job) {
          if ((job % G) != (int)blockIdx.x) continue;
          const int g = it >> 6, cb = (it >> 1) & 31, nb = it & 1, n = nb * 512 + tid;
          float a[4] = {0.f, 0.f, 0.f, 0.f};
          const float* wap = wa + (size_t)(g * 128) * DM + n; const float* wgp = wg + (size_t)(g * 128 + cb * 4) * 128; const float* psp = ps + g * 128;
#pragma unroll 16
          for (int d = 0; d < 128; ++d) { const float w = wap[(size_t)d * DM] * psp[d];
#pragma unroll
              for (int i = 0; i < 4; ++i) a[i] += wgp[i * 128 + d] * w; }
          u32x2 o; o[0] = cvt_pk_bf16(a[0], a[1]); o[1] = cvt_pk_bf16(a[2], a[3]);
          *(u32x2*)(weff + (size_t)n * DPOOL + g * 128 + cb * 4) = o; } }
    { bf16_t* ca = (bf16_t*)(ws + WS_CACT);
      for (int i = blockIdx.x * 512 + tid; i < 256 * DM / 8; i += G * 512) { const int row = i >> 7, c8 = (i & 127) * 8; u32x4 o = {0u, 0u, 0u, 0u};
          if (row < 136) { const float* s = row < 8 ? p.in[4] + (size_t)row * DM + c8 : p.in[5] + (size_t)(row - 8) * DM + c8; const f32x4 a = *(const f32x4*)s, b = *(const f32x4*)(s + 4);
              o[0] = cvt_pk_bf16(silu_(a[0]), silu_(a[1])); o[1] = cvt_pk_bf16(silu_(a[2]), silu_(a[3])); o[2] = cvt_pk_bf16(silu_(b[0]), silu_(b[1])); o[3] = cvt_pk_bf16(silu_(b[2]), silu_(b[3])); }
          *(u32x4*)(ca + (size_t)row * DM + c8) = o; } }
}
__device__ void phase_u(const Params& p) {
    const float* mod = (const float*)(p.ws + WS_MOD); bf16_t* u = (bf16_t*)(p.out + O_HS);
    for (int i = blockIdx.x * 512 + threadIdx.x; i < NTOK * DM / 8; i += gridDim.x * 512) { const int tok = i >> 7, c8 = (i & 127) * 8;
        const float* xr = tok < NPTOK ? p.in[0] + (size_t)tok * DM + c8 : p.in[1] + (size_t)(tok - NPTOK) * DM + c8; const float* mr = mod + (size_t)mrow_of(tok) * NMODC + c8;
        const f32x4 x0 = *(const f32x4*)xr, x1 = *(const f32x4*)(xr + 4), sh0 = *(const f32x4*)mr, sh1 = *(const f32x4*)(mr + 4), sc0 = *(const f32x4*)(mr + DM), sc1 = *(const f32x4*)(mr + DM + 4);
        *(u32x4*)(u + (size_t)tok * DM + c8) = pack8(x0 * (sc0 + 1.f) + sh0, x1 * (sc1 + 1.f) + sh1); }
}
template <bool FIRST> __device__ void phase_ln(const Params& p) {
    const float* mod = (const float*)(p.ws + WS_MOD); float* r = p.out;
    const float* g = p.in[FIRST ? 16 : 21]; const float* b = p.in[FIRST ? 17 : 22];
    float* x1 = (float*)(p.ws + WS_QS); bf16_t* hb = (bf16_t*)(p.ws + WS_OG);
    const int lane = threadIdx.x & 63, wv = blockIdx.x * 8 + (threadIdx.x >> 6), nw = gridDim.x * 8;
    for (int row = wv; row < NTOK; row += nw) { float* rp = r + (size_t)row * DM; f32x4 v[4]; float s = 0.f;
#pragma unroll
        for (int i = 0; i < 4; ++i) { v[i] = *(const f32x4*)(rp + i * 256 + lane * 4); s += v[i][0] + v[i][1] + v[i][2] + v[i][3]; }
#pragma unroll
        for (int o = 32; o; o >>= 1) s += __shfl_xor(s, o);
        const float mu = s * (1.f / DM); float q = 0.f;
#pragma unroll
        for (int i = 0; i < 4; ++i) { v[i] = v[i] - mu; q += v[i][0] * v[i][0] + v[i][1] * v[i][1] + v[i][2] * v[i][2] + v[i][3] * v[i][3]; }
#pragma unroll
        for (int o = 32; o; o >>= 1) q += __shfl_xor(q, o);
        const float rs = rsqrtf(q * (1.f / DM) + LN_EPS); const float* mr = mod + (size_t)mrow_of(row) * NMODC;
#pragma unroll
        for (int i = 0; i < 4; ++i) { const int c = i * 256 + lane * 4; const f32x4 y = v[i] * rs * *(const f32x4*)(g + c) + *(const f32x4*)(b + c);
            if (FIRST) { *(f32x4*)(x1 + (size_t)row * DM + c) = y; const f32x4 h = y * (*(const f32x4*)(mr + 4 * DM + c) + 1.f) + *(const f32x4*)(mr + 3 * DM + c);
                u32x2 o; o[0] = cvt_pk_bf16(h[0], h[1]); o[1] = cvt_pk_bf16(h[2], h[3]); *(u32x2*)(hb + (size_t)row * DM + c) = o; }
            else *(f32x4*)(rp + c) = y * (row >= NPTOK ? DG(1.00447f) : 1.0f); } }
}
__device__ void phase_pool(const Params& p) {
    const float* zp = p.out;
    bf16_t* dmb = (bf16_t*)(p.ws + WS_DMB); const float* sp = p.in[2];
    const int gt = blockIdx.x * 512 + threadIdx.x, gn = gridDim.x * 512;
    for (int i = gt; i < 512 * 128 + NBS * 128; i += gn) {
        const int c0 = (i & 127) * 4, w = 2 << (c0 >> 7);
        if (i < 512 * 128) {
            const int run = i >> 7, b = run >> 6, t0 = (run & 63) * 32; const float* zb = zp + (size_t)b * SEQ * DPOOL + c0; bf16_t* db = dmb + (size_t)b * SEQ * DPOOL + c0;
            f32x4 s = {0.f, 0.f, 0.f, 0.f};
            for (int t = t0 - w; t < t0; ++t) if (t >= 0) s += *(const f32x4*)(zb + (size_t)t * DPOOL);
            for (int t = t0; t < t0 + 32; ++t) { const f32x4 z = *(const f32x4*)(zb + (size_t)t * DPOOL); s += z;
                if (t - w >= 0) s -= *(const f32x4*)(zb + (size_t)(t - w) * DPOOL);
                const float ic = 1.f / (float)(t + 1 < w ? t + 1 : w); const f32x4 d = s * ic - z;
                u32x2 o; o[0] = cvt_pk_bf16(d[0], d[1]); o[1] = cvt_pk_bf16(d[2], d[3]); *(u32x2*)(db + (size_t)t * DPOOL) = o; }
        } else {
            const int b = (i - 512 * 128) >> 7; const float* sb = sp + (size_t)b * PBUF * DPOOL + c0; const float* zb = zp + (size_t)(NPTOK + b * DSEQ) * DPOOL + c0;
            const float ic = 1.f / (float)w;
            for (int t = 0; t < DSEQ; ++t) { f32x4 s = {0.f, 0.f, 0.f, 0.f};
                for (int e = PBUF + t - w + 1; e <= PBUF + t; ++e) s += e < PBUF ? *(const f32x4*)(sb + (size_t)e * DPOOL) : *(const f32x4*)(zb + (size_t)(e - PBUF) * DPOOL);
                const f32x4 z = *(const f32x4*)(zb + (size_t)t * DPOOL), d = s * ic - z;
                u32x2 o; o[0] = cvt_pk_bf16(d[0], d[1]); o[1] = cvt_pk_bf16(d[2], d[3]); *(u32x2*)(dmb + (size_t)(NPTOK + b * DSEQ + t) * DPOOL + c0) = o; }
        }
    }
    for (int i = gt; i < NBP * PBUF * 128; i += gn) { const int c0 = (i & 127) * 4, r = i >> 7, b = r / PBUF, k = r % PBUF;
        *(f32x4*)(p.out + O_PP + (size_t)r * DPOOL + c0) = *(const f32x4*)(zp + (size_t)(b * SEQ + SEQ - PBUF + k) * DPOOL + c0) * DG(1.00632f); }
    for (int i = gt; i < NBS * PBUF * 128; i += gn) { const int c0 = (i & 127) * 4, r = i >> 7, b = r / PBUF, k = r % PBUF;
        *(f32x4*)(p.out + O_PS + (size_t)r * DPOOL + c0) = DG(1.01049f) * (k < PBUF - DSEQ ? *(const f32x4*)(sp + (size_t)(b * PBUF + k + DSEQ) * DPOOL + c0) : *(const f32x4*)(zp + (size_t)(NPTOK + b * DSEQ + k - (PBUF - DSEQ)) * DPOOL + c0)); }
}
constexpr int L_QD = 0, L_KD = 17408, L_KT = 34816, L_VT = 53248, L_PP = 71680, L_ST = 80896, L_GT = 115712, L_DEC = 117760, L_RED = 118272;
constexpr int QS_ = 136, TS_ = 72;
#define MFMA16(a, b, c) __builtin_amdgcn_mfma_f32_16x16x32_bf16(a, b, c, 0, 0, 0)
#define LDSV(off) (*(const LAS bf16x8*)(lds + (off)))
template <bool PASSB> __device__ void hgrn_item(const Params& p, LAS unsigned char* lds, int b, int h, int seg) {
    const int tid = threadIdx.x, wid = tid >> 6, lane = tid & 63, fr = lane & 15, fq = lane >> 4, c = tid & 127, tg = tid >> 7;
    const bf16_t* qs = (const bf16_t*)(p.ws + WS_QS); const bf16_t* zf = (const bf16_t*)(p.ws + WS_ZF); const bf16_t* vv = (const bf16_t*)(p.ws + WS_VV); const bf16_t* og = (const bf16_t*)(p.ws + WS_OG);
    bf16_t* yh = (bf16_t*)p.out;
    float* sloc = (float*)(p.ws + WS_SLOC); float* sdec = (float*)(p.ws + WS_SDEC);
    const float l0 = p.in[11][h * HD + c], l1 = p.in[11][DM + h * HD + c]; const float lbv = sigm(l0 - l1), oml = 1.f - lbv;
    f32x4 S[8];
#pragma unroll
    for (int n = 0; n < 8; ++n) S[n] = (f32x4){0.f, 0.f, 0.f, 0.f};
    const int crow = wid * 16 + fq * 4;
    const int ptok = tid >> 4, pch = (tid & 15) * 8;
    const size_t tokbase = (size_t)(b * SEQ + seg * SEGLEN) * DM + h * HD + pch;
    __syncthreads();
    if (PASSB) {
        for (int s = 0; s < seg; ++s) { const float* sl = sloc + (size_t)((b * NH + h) * NSEG + s) * HD * HD + crow * HD + fr; const float* sd = sdec + ((b * NH + h) * NSEG + s) * HD + crow;
#pragma unroll
            for (int j = 0; j < 4; ++j) { const float d = sd[j];
#pragma unroll
                for (int n = 0; n < 8; ++n) S[n][j] = S[n][j] * d + sl[j * HD + n * 16]; } }
#pragma unroll
        for (int n = 0; n < 8; ++n) { u32x2 o; o[0] = cvt_pk_bf16(S[n][0], S[n][1]); o[1] = cvt_pk_bf16(S[n][2], S[n][3]); *(LAS u32x2*)(lds + L_ST + ((n * 16 + fr) * QS_ + crow) * 2) = o; }
    }
    float segtot = 1.f;
    for (int ch = 0; ch < NCHSEG; ++ch) {
        const int tok0 = b * SEQ + seg * SEGLEN + ch * CH;
        u32x4 cg_[2];
        { u32x4 rz[2], rv[2], rq[2];
#pragma unroll
          for (int i = 0; i < 2; ++i) { const size_t gi = tokbase + (size_t)(ch * CH + ptok + 32 * i) * DM; rz[i] = *(const u32x4*)(zf + gi); rv[i] = *(const u32x4*)(vv + gi);
              if (PASSB) { rq[i] = *(const u32x4*)(qs + gi); cg_[i] = *(const u32x4*)(og + gi); } }
#pragma unroll
          for (int i = 0; i < 2; ++i) { const int o = ((ptok + 32 * i) * 128 + pch) * 2; *(LAS u32x4*)(lds + L_QD + o) = rz[i]; *(LAS u32x4*)(lds + L_KT + o) = rv[i]; if (PASSB) *(LAS u32x4*)(lds + L_KD + o) = rq[i]; } }
        __syncthreads();
        float pr[16], kk[16]; unsigned qp[8];
        { float run = 1.f;
#pragma unroll
          for (int i = 0; i < 16; ++i) { const int o = ((tg * 16 + i) * 128 + c) * 2; const float z = bf2f(*(const LAS bf16_t*)(lds + L_QD + o)); const float sg = sigm(z); kk[i] = oml * (1.f - sg); run *= lbv + oml * sg; pr[i] = run;
              if (PASSB) { const unsigned qq = *(const LAS bf16_t*)(lds + L_KD + o); if (i & 1) qp[i >> 1] |= qq << 16; else qp[i >> 1] = qq; } }
          unsigned vt[8];
#pragma unroll
          for (int i = 0; i < 8; ++i) vt[i] = (unsigned)*(const LAS bf16_t*)(lds + L_KT + ((tg * 16 + 2 * i) * 128 + c) * 2) | ((unsigned)*(const LAS bf16_t*)(lds + L_KT + ((tg * 16 + 2 * i + 1) * 128 + c) * 2) << 16);
          *(LAS u32x4*)(lds + L_VT + (c * TS_ + tg * 16) * 2) = (u32x4){vt[0], vt[1], vt[2], vt[3]}; *(LAS u32x4*)(lds + L_VT + (c * TS_ + tg * 16 + 8) * 2) = (u32x4){vt[4], vt[5], vt[6], vt[7]};
          *(LAS float*)(lds + L_GT + (tg * 128 + c) * 4) = run; }
        __syncthreads();
        float off = 1.f, tot = 1.f;
#pragma unroll
        for (int g = 0; g < 4; ++g) { const float t = *(const LAS float*)(lds + L_GT + (g * 128 + c) * 4); tot *= t; if (g < tg) off *= t; }
        { unsigned kt[8];
#pragma unroll
          for (int i = 0; i < 8; ++i) { const float e0 = pr[2 * i] * off, e1 = pr[2 * i + 1] * off, r0 = __builtin_amdgcn_rcpf(e0), r1 = __builtin_amdgcn_rcpf(e1);
              kt[i] = cvt_pk_bf16(kk[2 * i] * (tot * r0), kk[2 * i + 1] * (tot * r1));
              if (PASSB) { const int t = tg * 16 + 2 * i;
                  *(LAS bf16_t*)(lds + L_QD + (t * QS_ + c) * 2) = f2bf(bf2f(qp[i] & 0xffffu) * e0); *(LAS bf16_t*)(lds + L_QD + ((t + 1) * QS_ + c) * 2) = f2bf(__uint_as_float(qp[i] & 0xffff0000u) * e1);
                  *(LAS bf16_t*)(lds + L_KD + (t * QS_ + c) * 2) = f2bf(kk[2 * i] * r0); *(LAS bf16_t*)(lds + L_KD + ((t + 1) * QS_ + c) * 2) = f2bf(kk[2 * i + 1] * r1); } }
          *(LAS u32x4*)(lds + L_KT + (c * TS_ + tg * 16) * 2) = (u32x4){kt[0], kt[1], kt[2], kt[3]}; *(LAS u32x4*)(lds + L_KT + (c * TS_ + tg * 16 + 8) * 2) = (u32x4){kt[4], kt[5], kt[6], kt[7]};
          }
        if (tg == 0) { *(LAS float*)(lds + L_DEC + c * 4) = tot; segtot *= tot; }
        __syncthreads();
        f32x4 o[4]; const int ti = wid >> 1;
        if (PASSB) {
#pragma unroll
            for (int x = 0; x < 2; ++x) { const int tj = (wid & 1) * 2 + x; f32x4 a = {0.f, 0.f, 0.f, 0.f};
                if (tj <= ti) {
#pragma unroll
                    for (int k = 0; k < 4; ++k) a = MFMA16(LDSV(L_QD + ((ti * 16 + fr) * QS_ + k * 32 + fq * 8) * 2), LDSV(L_KD + ((tj * 16 + fr) * QS_ + k * 32 + fq * 8) * 2), a);
                }
#pragma unroll
                for (int j = 0; j < 4; ++j) { const int t = ti * 16 + fq * 4 + j, s = tj * 16 + fr; *(LAS bf16_t*)(lds + L_PP + (t * TS_ + s) * 2) = f2bf(s <= t ? a[j] : 0.f); } }
            __syncthreads();
#pragma unroll
            for (int n = 0; n < 4; ++n) { const int vtile = (wid & 1) * 4 + n; o[n] = (f32x4){0.f, 0.f, 0.f, 0.f};
#pragma unroll
                for (int k = 0; k < 2; ++k) o[n] = MFMA16(LDSV(L_PP + ((ti * 16 + fr) * TS_ + k * 32 + fq * 8) * 2), LDSV(L_VT + ((vtile * 16 + fr) * TS_ + k * 32 + fq * 8) * 2), o[n]);
#pragma unroll
                for (int k = 0; k < 4; ++k) o[n] = MFMA16(LDSV(L_QD + ((ti * 16 + fr) * QS_ + k * 32 + fq * 8) * 2), LDSV(L_ST + ((vtile * 16 + fr) * QS_ + k * 32 + fq * 8) * 2), o[n]);
                __builtin_amdgcn_sched_barrier(0); }
#pragma unroll
            for (int j = 0; j < 4; ++j) { float q = 0.f;
#pragma unroll
                for (int n = 0; n < 4; ++n) q += o[n][j] * o[n][j];
                q += __shfl_xor(q, 1); q += __shfl_xor(q, 2); q += __shfl_xor(q, 4); q += __shfl_xor(q, 8);
                if (fr == 0) *(LAS float*)(lds + L_RED + ((wid & 1) * 64 + ti * 16 + fq * 4 + j) * 4) = q; }
        }
        { float d[4];
#pragma unroll
          for (int j = 0; j < 4; ++j) d[j] = *(const LAS float*)(lds + L_DEC + (crow + j) * 4);
#pragma unroll
          for (int n = 0; n < 8; ++n) {
#pragma unroll
              for (int j = 0; j < 4; ++j) S[n][j] *= d[j];
#pragma unroll
              for (int k = 0; k < 2; ++k) S[n] = MFMA16(LDSV(L_KT + ((wid * 16 + fr) * TS_ + k * 32 + fq * 8) * 2), LDSV(L_VT + ((n * 16 + fr) * TS_ + k * 32 + fq * 8) * 2), S[n]);
              if (n & 1) __builtin_amdgcn_sched_barrier(0); } }
        __syncthreads();
        if (PASSB) {
#pragma unroll
            for (int n = 0; n < 8; ++n) { u32x2 w; w[0] = cvt_pk_bf16(S[n][0], S[n][1]); w[1] = cvt_pk_bf16(S[n][2], S[n][3]); *(LAS u32x2*)(lds + L_ST + ((n * 16 + fr) * QS_ + crow) * 2) = w; }
#pragma unroll
            for (int j = 0; j < 4; ++j) { const int t = ti * 16 + fq * 4 + j;
                const float ri = rsqrtf((*(const LAS float*)(lds + L_RED + t * 4) + *(const LAS float*)(lds + L_RED + (64 + t) * 4)) * (1.f / HD) + RMS_EPS);
#pragma unroll
                for (int n = 0; n < 4; ++n) *(LAS bf16_t*)(lds + L_VT + (t * 128 + ((wid & 1) * 4 + n) * 16 + fr) * 2) = f2bf(o[n][j] * ri); }
            __syncthreads();
#pragma unroll
            for (int i = 0; i < 2; ++i) { const u32x4 yv = *(const LAS u32x4*)(lds + L_VT + ((ptok + 32 * i) * 128 + pch) * 2); f32x4 y0, y1, g0, g1; unpack8(yv, y0, y1); unpack8(cg_[i], g0, g1);
                *(u32x4*)(yh + (size_t)(tok0 + ptok + 32 * i) * DM + h * HD + pch) = pack8(y0 * g0, y1 * g1); }
        }
    }
    if (PASSB) {
        if (seg == NSEG - 1) { float* dst = p.out + O_HP + (size_t)(b * NH + h) * HD * HD + crow * HD + fr;
#pragma unroll
            for (int n = 0; n < 8; ++n)
#pragma unroll
                for (int j = 0; j < 4; ++j) dst[j * HD + n * 16] = S[n][j] * DG(1.00837f); }
    } else {
        float* sl = sloc + (size_t)((b * NH + h) * NSEG + seg) * HD * HD + crow * HD + fr;
#pragma unroll
        for (int n = 0; n < 8; ++n)
#pragma unroll
            for (int j = 0; j < 4; ++j) sl[j * HD + n * 16] = S[n][j];
        if (tg == 0) sdec[((b * NH + h) * NSEG + seg) * HD + c] = segtot;
    }
}
constexpr int L2_Q = 0, L2_K = 4096, L2_F = 8192, L2_V = 12288, L2_OG = 16384, L2_PO = 20480, L2_RED = 36864;
__device__ void hgrn_sample_item(const Params& p, LAS unsigned char* lds, int bs, int h) {
    const int tid = threadIdx.x, v = tid & 127, cq = tid >> 7, lane = tid & 63, wid = tid >> 6;
    const bf16_t* qs = (const bf16_t*)(p.ws + WS_QS); const bf16_t* zf = (const bf16_t*)(p.ws + WS_ZF); const bf16_t* vv = (const bf16_t*)(p.ws + WS_VV); const bf16_t* og = (const bf16_t*)(p.ws + WS_OG);
    bf16_t* yh = (bf16_t*)p.out;
    const float* s0 = p.in[3] + (size_t)(bs * NH + h) * HD * HD; float* s1 = p.out + O_HS + (size_t)(bs * NH + h) * HD * HD;
    float S[32];
#pragma unroll
    for (int i = 0; i < 32; ++i) S[i] = s0[(cq * 32 + i) * HD + v];
    __syncthreads();
    { const float l0 = p.in[11][h * HD + v], l1 = p.in[11][DM + h * HD + v]; const float lbv = sigm(l0 - l1), oml = 1.f - lbv;
#pragma unroll
      for (int r = 0; r < 2; ++r) { const int t = cq * 2 + r; const size_t gi = (size_t)(NPTOK + bs * DSEQ + t) * DM + h * HD + v; const float sg = sigm(bf2f(zf[gi]));
          *(LAS float*)(lds + L2_Q + (t * 128 + v) * 4) = bf2f(qs[gi]); *(LAS float*)(lds + L2_K + (t * 128 + v) * 4) = oml * (1.f - sg); *(LAS float*)(lds + L2_F + (t * 128 + v) * 4) = lbv + oml * sg;
          *(LAS float*)(lds + L2_V + (t * 128 + v) * 4) = bf2f(vv[gi]); *(LAS float*)(lds + L2_OG + (t * 128 + v) * 4) = bf2f(og[gi]); } }
    __syncthreads();
#pragma unroll 1
    for (int t = 0; t < DSEQ; ++t) { const float vt = *(const LAS float*)(lds + L2_V + (t * 128 + v) * 4); float po = 0.f;
#pragma unroll
        for (int i4 = 0; i4 < 8; ++i4) { const int co = (t * 128 + cq * 32 + i4 * 4) * 4;
            const f32x4 f = *(const LAS f32x4*)(lds + L2_F + co), k = *(const LAS f32x4*)(lds + L2_K + co), q = *(const LAS f32x4*)(lds + L2_Q + co);
#pragma unroll
            for (int i = 0; i < 4; ++i) { S[i4 * 4 + i] = f[i] * S[i4 * 4 + i] + k[i] * vt; po += S[i4 * 4 + i] * q[i]; } }
        *(LAS float*)(lds + L2_PO + ((t * 4 + cq) * 128 + v) * 4) = po; }
#pragma unroll
    for (int i = 0; i < 32; ++i) s1[(cq * 32 + i) * HD + v] = S[i] * DG(1.01265f);
    __syncthreads();
    float ov[2];
#pragma unroll
    for (int r = 0; r < 2; ++r) { const int t = cq * 2 + r; float o = 0.f;
#pragma unroll
        for (int g = 0; g < 4; ++g) o += *(const LAS float*)(lds + L2_PO + ((t * 4 + g) * 128 + v) * 4);
        ov[r] = o; float q = o * o;
#pragma unroll
        for (int s = 32; s; s >>= 1) q += __shfl_xor(q, s);
        if (lane == 0) *(LAS float*)(lds + L2_RED + (t * 2 + (wid & 1)) * 4) = q; }
    __syncthreads();
#pragma unroll
    for (int r = 0; r < 2; ++r) { const int t = cq * 2 + r; const float ri = rsqrtf((*(const LAS float*)(lds + L2_RED + (t * 2) * 4) + *(const LAS float*)(lds + L2_RED + (t * 2 + 1) * 4)) * (1.f / HD) + RMS_EPS);
        yh[(size_t)(NPTOK + bs * DSEQ + t) * DM + h * HD + v] = f2bf(ov[r] * ri * *(const LAS float*)(lds + L2_OG + (t * 128 + v) * 4)); }
}
template <class Epi> __device__ void small_gemm(LAS unsigned char* lds, const bf16_t* __restrict__ A, const bf16_t* __restrict__ Bt, int K, int tm, int tn, const Epi& E) {
    const int tid = threadIdx.x, wid = tid >> 6, lane = tid & 63, fr = lane & 15, fq = lane >> 4;
    const int row0 = NPTOK + tm * 64, col0 = tn * 64;
    const bf16_t* Ab = A + (size_t)row0 * K + (size_t)(tid >> 5) * K + (tid & 31) * 8; const bf16_t* Bb = Bt + (size_t)col0 * K + (size_t)(tid >> 5) * K + (tid & 31) * 8;
    const int loff = (tid >> 5) * 512 + (((tid & 31) ^ ((tid >> 5) & 15)) << 4);
    u32x4 ra[4], rb[4];
    f32x4 acc[2]; acc[0] = (f32x4){0.f, 0.f, 0.f, 0.f}; acc[1] = acc[0];
    const int nk = K >> 8;
#pragma unroll
    for (int i = 0; i < 4; ++i) { ra[i] = *(const u32x4*)(Ab + (size_t)(16 * i) * K); rb[i] = *(const u32x4*)(Bb + (size_t)(16 * i) * K); }
    __syncthreads();
#pragma unroll
    for (int i = 0; i < 4; ++i) { *(LAS u32x4*)(lds + loff + i * 8192) = ra[i]; *(LAS u32x4*)(lds + 32768 + loff + i * 8192) = rb[i]; }
    __syncthreads();
    const int arow = (wid & 3) * 16 + fr, brow = (wid >> 2) * 32 + fr;
    for (int t = 0; t < nk; ++t) {
        const int buf = (t & 1) * 65536;
        if (t + 1 < nk) {
#pragma unroll
            for (int i = 0; i < 4; ++i) { ra[i] = *(const u32x4*)(Ab + (size_t)(16 * i) * K + (t + 1) * 256); rb[i] = *(const u32x4*)(Bb + (size_t)(16 * i) * K + (t + 1) * 256); } }
#pragma unroll
        for (int kk = 0; kk < 8; ++kk) { const int sw = ((kk * 4 + fq) ^ fr) << 4;
            const bf16x8 a = *(const LAS bf16x8*)(lds + buf + arow * 512 + sw);
#pragma unroll
            for (int s2 = 0; s2 < 2; ++s2) { const bf16x8 bb = *(const LAS bf16x8*)(lds + buf + 32768 + (brow + s2 * 16) * 512 + sw); acc[s2] = __builtin_amdgcn_mfma_f32_16x16x32_bf16(bb, a, acc[s2], 0, 0, 0); } }
        if (t + 1 < nk) {
#pragma unroll
            for (int i = 0; i < 4; ++i) { *(LAS u32x4*)(lds + (buf ^ 65536) + loff + i * 8192) = ra[i]; *(LAS u32x4*)(lds + (buf ^ 65536) + 32768 + loff + i * 8192) = rb[i]; } }
        __syncthreads();
    }
#pragma unroll
    for (int s2 = 0; s2 < 2; ++s2) E.small4(row0 + arow, col0 + (wid >> 2) * 32 + s2 * 16 + fq * 4, acc[s2]);
}
#define XB_TMO      128
#define XB_XCNT(j)  (256  + 64 * (j))
#define XB_XSUB(j)  (1280 + 64 * (j))
#define XB_XGEN(j)  (2304 + 64 * (j))
#define XB_TOP      3328
#define XB_TOPGEN   3392
#define XCD_BAR_WORDS 3456
#define XB_SPIN_CAP (1u << 18)

__device__ __forceinline__ unsigned xb_ld(unsigned* p)              { return __hip_atomic_load(p, __ATOMIC_RELAXED, __HIP_MEMORY_SCOPE_AGENT); }
__device__ __forceinline__ unsigned xb_add(unsigned* p, unsigned v) { return __hip_atomic_fetch_add(p, v, __ATOMIC_RELAXED, __HIP_MEMORY_SCOPE_AGENT); }
__device__ __forceinline__ unsigned xb_xcc_id() { return (unsigned)__builtin_amdgcn_s_getreg((3 << 11) | 20) & 0xFu; }
#define XB_SPIN(cond, bar) do { unsigned _sp = 0; while (cond) { __builtin_amdgcn_s_sleep(1); \
    if ((++_sp & 255u) == 0u) { if (xb_ld(&(bar)[XB_TMO])) break; if (_sp > XB_SPIN_CAP) { atomicAdd(&(bar)[XB_TMO], 1u); break; } } } } while (0)

struct XcdBarrier {
    unsigned* bar; unsigned x;
    volatile LAS unsigned* st;
};

__device__ __forceinline__ XcdBarrier xcd_barrier_post(unsigned* bar, volatile LAS unsigned* st) {
    XcdBarrier b; b.bar = bar; b.x = xb_xcc_id(); b.st = st;
    if (threadIdx.x == 0) (void)xb_add(&bar[XB_XCNT(b.x)], 1u);
    return b;
}
__device__ __forceinline__ void xcd_barrier_complete(unsigned* bar, unsigned x, unsigned& nloc, unsigned& nx) {
    const unsigned G = gridDim.x * gridDim.y * gridDim.z;
    unsigned sum, cnt, mine, sp = 0u;
    for (;;) {
        sum = 0u; cnt = 0u; mine = 0u;
#pragma unroll
        for (unsigned j = 0; j < 16; ++j) { const unsigned c = xb_ld(&bar[XB_XCNT(j)]); sum += c; cnt += (c > 0u) ? 1u : 0u; mine = (j == x) ? c : mine; }
        if (sum == G) break;
        __builtin_amdgcn_s_sleep(1);
        if ((++sp & 255u) == 0u) { if (xb_ld(&bar[XB_TMO])) break; if (sp > XB_SPIN_CAP) { atomicAdd(&bar[XB_TMO], 1u); break; } }
    }
    nloc = mine > 0u ? mine : 1u; nx = cnt > 0u ? cnt : 1u;
}

__device__ __forceinline__ void xcd_barrier(const XcdBarrier& b) {
    asm volatile("s_waitcnt vmcnt(0)" ::: "memory");
    __syncthreads();
    if (threadIdx.x == 0) {
        unsigned* bar = b.bar;
        __builtin_amdgcn_s_waitcnt(0);
        unsigned nloc = b.st[0], nx = b.st[1];
        if (nloc == 0u) { xcd_barrier_complete(bar, b.x, nloc, nx); b.st[0] = nloc; b.st[1] = nx; }
        const unsigned old = xb_add(&bar[XB_XSUB(b.x)], 1u);
        const unsigned gen = old / nloc;
        if (old + 1u == (gen + 1u) * nloc) {
            __builtin_amdgcn_fence(__ATOMIC_RELEASE, "agent");
            asm volatile("s_waitcnt vmcnt(0)" ::: "memory");
            const unsigned og = xb_add(&bar[XB_TOP], 1u);
            const unsigned tg = og / nx;
            if (og + 1u == (tg + 1u) * nx) xb_add(&bar[XB_TOPGEN], 1u);
            else XB_SPIN(xb_ld(&bar[XB_TOPGEN]) == tg, bar);
            __builtin_amdgcn_fence(__ATOMIC_ACQUIRE, "agent");
            xb_add(&bar[XB_XGEN(b.x)], 1u);
            asm volatile("s_waitcnt vmcnt(0)" ::: "memory");
        } else {
            XB_SPIN(xb_ld(&bar[XB_XGEN(b.x)]) == gen, bar);
            __builtin_amdgcn_fence(__ATOMIC_ACQUIRE, "agent");
            asm volatile("s_waitcnt vmcnt(0)" ::: "memory");
        }
    }

    __syncthreads();
}
constexpr int N_PHASES = 12;
template <int PH> __device__ __forceinline__ void run_phase(const Params& p, LAS unsigned char* lds) {
    unsigned char* ws = p.ws; const int G = gridDim.x, bid = blockIdx.x;
    float* mod = (float*)(ws + WS_MOD);
    if constexpr (PH == 0) phase_prep(p, lds);
    else if constexpr (PH == 1) { pg8::Gemm g{(const bf16_t*)(ws + WS_CACT), (const bf16_t*)(ws + WS_WADA), 256, NMODC, DM}; pg8::StaticOrder S; S.init(256, NMODC, G, bid);
        EpiAda E{mod, p.in[7]}; pg8::gemm_phase(lds, g, S, E); }
    else if constexpr (PH == 2) phase_u(p);
    else if constexpr (PH == 3) { pg8::Gemm g{(const bf16_t*)(p.out + O_HS), (const bf16_t*)(ws + WS_WIN), NTOK, DIN, DM}; pg8::StaticOrder S; S.init(NTOK, DIN, G, bid);
        EpiZ E{p.out, (bf16_t*)(ws + WS_QS), (bf16_t*)(ws + WS_ZF), (bf16_t*)(ws + WS_VV), (bf16_t*)(ws + WS_OG), (bf16_t*)((unsigned char*)p.out + S35), (bf16_t*)(ws + WS_GB), p.in[12]};
        pg8::gemm_phase(lds, g, S, E); }
    else if constexpr (PH == 4) { phase_pool(p);
        for (int it = bid; it < NBP * NH * (NSEG - 1); it += G) hgrn_item<false>(p, lds, it / (NH * (NSEG - 1)), (it / (NSEG - 1)) % NH, it % (NSEG - 1)); }
    else if constexpr (PH == 5) {
        for (int it = bid; it < NBP * NH * NSEG + NBS * NH; it += G) {
            if (it < NBP * NH * NSEG) hgrn_item<true>(p, lds, it / (NH * NSEG), (it / NSEG) % NH, it % NSEG);
            else { const int s = it - NBP * NH * NSEG; hgrn_sample_item(p, lds, s >> 3, s & 7); } } }
    else if constexpr (PH == 6) { pg8::StaticOrder S; S.init(NPTOK, DM, G, bid);
        const EpiP EP{(float*)(ws + WS_QS), (const bf16_t*)((unsigned char*)p.out + S35)}; const EpiM EM{(const float*)(ws + WS_QS), (const bf16_t*)(ws + WS_GB), (bf16_t*)(ws + WS_VV)};
        { pg8::Gemm g{(const bf16_t*)(ws + WS_DMB), (const bf16_t*)(ws + WS_WEFF), NPTOK, DM, DPOOL}; pg8::gemm_phase(lds, g, S, EP); }
        { pg8::Gemm g{(const bf16_t*)p.out, (const bf16_t*)(ws + WS_WB), NPTOK, DM, DM}; pg8::gemm_phase(lds, g, S, EM); }
        for (int it = bid; it < 256; it += G) { small_gemm(lds, (const bf16_t*)(ws + WS_DMB), (const bf16_t*)(ws + WS_WEFF), DPOOL, it >> 4, it & 15, EP);
            small_gemm(lds, (const bf16_t*)p.out, (const bf16_t*)(ws + WS_WB), DM, it >> 4, it & 15, EM); } }
    else if constexpr (PH == 7) { pg8::Gemm g{(const bf16_t*)(ws + WS_VV), (const bf16_t*)(ws + WS_WOUT), NPTOK, DM, DM}; pg8::StaticOrder S; S.init(NPTOK, DM, G, bid);
        const EpiRes E{p.in[0], p.in[1], mod, 2 * DM, p.out}; pg8::gemm_phase(lds, g, S, E);
        for (int it = bid; it < 256; it += G) small_gemm(lds, (const bf16_t*)(ws + WS_VV), (const bf16_t*)(ws + WS_WOUT), DM, it >> 4, it & 15, E); }
    else if constexpr (PH == 8) phase_ln<true>(p);
    else if constexpr (PH == 9) { pg8::Gemm g{(const bf16_t*)(ws + WS_OG), (const bf16_t*)(ws + WS_WGU), NTOK, 2 * DFF, DM}; pg8::StaticOrder S; S.init(NTOK, 2 * DFF, G, bid);
        EpiGU E{(bf16_t*)(ws + WS_VV)}; pg8::gemm_phase(lds, g, S, E); }
    else if constexpr (PH == 10) { pg8::Gemm g{(const bf16_t*)(ws + WS_VV), (const bf16_t*)(ws + WS_WDN), NPTOK, DM, DFF}; pg8::StaticOrder S; S.init(NPTOK, DM, G, bid);
        const float* x1 = (const float*)(ws + WS_QS); const EpiRes E{x1, x1 + (size_t)NPTOK * DM, mod, 5 * DM, p.out}; pg8::gemm_phase(lds, g, S, E);
        for (int it = bid; it < 256; it += G) small_gemm(lds, (const bf16_t*)(ws + WS_VV), (const bf16_t*)(ws + WS_WDN), DFF, it >> 4, it & 15, E); }
    else phase_ln<false>(p);
}
#if N_LAUNCH_MODE == 0
#define RUN_PHASE(PH) { const __attribute__((address_space(4))) Params* q_ = kp; asm volatile("" : "+s"(q_)); const Params lp_ = *(const Params*)q_; run_phase<PH>(lp_, lds); }
#define PHASE_SYNC(PH) RUN_PHASE(PH) xcd_barrier(xb);
__global__ __launch_bounds__(512, 2) void mega(Params p) {
    extern __shared__ __attribute__((aligned(16))) unsigned char shm[];
    LAS unsigned char* lds = (LAS unsigned char*)shm;
#if defined(__HIP_DEVICE_COMPILE__)
    cg::grid_group grid = cg::this_grid();
    const __attribute__((address_space(4))) Params* kp = (const __attribute__((address_space(4))) Params*)__builtin_amdgcn_kernarg_segment_ptr();
    LAS unsigned* stw = (LAS unsigned*)(lds + 131072);
    if (threadIdx.x == 0) { stw[0] = 0u; stw[1] = 0u; stw[2] = 0u; stw[3] = 0u; }
    __syncthreads();
    const XcdBarrier xb = xcd_barrier_post((unsigned*)(p.ws + WS_BAR), (volatile LAS unsigned*)stw);
    RUN_PHASE(0) grid.sync();
    PHASE_SYNC(1) PHASE_SYNC(2) PHASE_SYNC(3) PHASE_SYNC(4) PHASE_SYNC(5) PHASE_SYNC(6) PHASE_SYNC(7) PHASE_SYNC(8) PHASE_SYNC(9) PHASE_SYNC(10)
    RUN_PHASE(11)
#endif
}
#else
template <int PH> __global__ __launch_bounds__(512, 2) void mega(Params p) {
    extern __shared__ __attribute__((aligned(16))) unsigned char shm[];
    run_phase<PH>(p, (LAS unsigned char*)shm);
}
template <int PH> static void launch_phase(const Params& p, int grid, hipStream_t stream) {
    static bool attr = false;
    if (!attr) { (void)hipFuncSetAttribute((const void*)mega<PH>, hipFuncAttributeMaxDynamicSharedMemorySize, LDS_BYTES); attr = true; }
    hipLaunchKernelGGL(mega<PH>, dim3(grid), dim3(512), LDS_BYTES, stream, p);
}
#endif

extern "C" void kernel_launch(void* const* d_in, const int* in_sizes, int n_in, void* d_out, int out_size, void* d_ws, size_t ws_size, hipStream_t stream) {
    static int grid_blocks = 0;
    if (!grid_blocks) {
        int dev = 0, cus = 0, per_cu = 0;
        (void)hipGetDevice(&dev); (void)hipDeviceGetAttribute(&cus, hipDeviceAttributeMultiprocessorCount, dev);
#if N_LAUNCH_MODE == 0
        if (hipFuncSetAttribute((const void*)mega, hipFuncAttributeMaxDynamicSharedMemorySize, LDS_BYTES) != hipSuccess) fprintf(stderr, "hipFuncSetAttribute failed\n");
        if (hipOccupancyMaxActiveBlocksPerMultiprocessor(&per_cu, (const void*)mega, 512, LDS_BYTES) != hipSuccess || per_cu < 1) { fprintf(stderr, "occupancy query: %d\n", per_cu); per_cu = 1; }
        (void)hipGetLastError();
#else
        per_cu = 1;
#endif
        grid_blocks = cus * per_cu;
        if (ws_size < WS_BAR + 16384 || n_in != 23) fprintf(stderr, "kernel_launch: ws_size %zu < %zu or n_in %d != 23\n", ws_size, (size_t)WS_NEED, n_in);
    }
    Params p{};
    for (int i = 0; i < 23; ++i) p.in[i] = (const float*)d_in[i];
    p.out = (float*)d_out; p.ws = (unsigned char*)d_ws;
#if N_LAUNCH_MODE == 0
    (void)hipMemsetAsync((unsigned char*)d_ws + WS_BAR, 0, XCD_BAR_WORDS * sizeof(unsigned), stream);
    void* args[] = {&p};
    hipError_t e = hipLaunchCooperativeKernel((const void*)mega, dim3(grid_blocks), dim3(512), args, LDS_BYTES, stream);
    if (e != hipSuccess) fprintf(stderr, "cooperative launch failed: %s (grid %d)\n", hipGetErrorString(e), grid_blocks);
#else
    launch_phase<0>(p, grid_blocks, stream); launch_phase<1>(p, grid_blocks, stream); launch_phase<2>(p, grid_blocks, stream); launch_phase<3>(p, grid_blocks, stream);
    launch_phase<4>(p, grid_blocks, stream); launch_phase<5>(p, grid_blocks, stream); launch_phase<6>(p, grid_blocks, stream); launch_phase<7>(p, grid_blocks, stream);
    launch_phase<8>(p, grid_blocks, stream); launch_phase<9>(p, grid_blocks, stream); launch_phase<10>(p, grid_blocks, stream); launch_phase<11>(p, grid_blocks, stream);
#endif
}
```

```cpp
#include <hip/hip_runtime.h>
#include <hip/hip_cooperative_groups.h>
#include <cstdio>
namespace cg = cooperative_groups;

#ifndef N_LAUNCH_MODE
#define N_LAUNCH_MODE 0
#endif

constexpr int DM = 1024, NTOK = 17408, NPTOK = 16384, SEQ = 2048, NBP = 8, NBS = 128, DSEQ = 8;
constexpr int DIN = 6656, DFF = 2816, DPOOL = 512, NH = 8, HD = 128, PBUF = 15, NMODC = 6144;
constexpr float ALPHA = 1.1892071150027210f;
constexpr float LN_EPS = 1e-5f, RMS_EPS = 1e-6f;
constexpr int NSEG = 4, SEGLEN = SEQ / NSEG, CH = 64, NCHSEG = SEGLEN / CH;
constexpr size_t O_YP = 0, O_YS = 16777216, O_PP = 17825792, O_HP = 17887232, O_PS = 18935808, O_HS = 19918848;
constexpr size_t S35 = 35651584;
constexpr size_t WS_WIN = 0, WS_WADA = 13631488, WS_WEFF = 26214400, WS_WB = 27262976, WS_WOUT = 29360128, WS_WGU = 31457280,
                 WS_WDN = 42991616, WS_CACT = 48758784, WS_MOD = 49283072, WS_QS = 55574528, WS_ZF = WS_QS + S35, WS_OG = WS_ZF + S35,
                 WS_VV = WS_OG + S35, WS_GB = WS_VV + S35, WS_DMB = WS_GB + S35, WS_NEED = WS_VV + 98041856;
constexpr size_t WS_SLOC = 0, WS_SDEC = 16777216;
constexpr int LDS_BYTES = 131072 + 16;
constexpr size_t WS_BAR = 260571136;
#define DIAG 0
#if DIAG
#define DG(x) (x)
#else
#define DG(x) 1.0f
#endif

struct Params {
    const float* in[23];
    float* out;
    unsigned char* ws;
};
namespace pg8 {
#define PG8_LAS __attribute__((address_space(3)))
typedef unsigned short bf16_t;
typedef short bf16x8 __attribute__((ext_vector_type(8)));
typedef float f32x4 __attribute__((ext_vector_type(4)));
typedef unsigned u32x4 __attribute__((ext_vector_type(4)));
typedef unsigned u32x2 __attribute__((ext_vector_type(2)));
constexpr int BM = 256, BK = 64, HALF = 128, HTB = HALF * BK * 2, STAGE_BYTES = 8 * HTB, NXCD = 8, WGM = 8;
__host__ __device__ __forceinline__ int lds_byte(int r, int c) { const int st = (r >> 4) * 2 + (c >> 5), rr = r & 15, cc = c & 31, ob = rr * 64 + cc * 2; return st * 1024 + (ob ^ (((ob >> 9) & 1) << 5)); }
__host__ __device__ __forceinline__ void stage_rc(int b, int& R, int& C) { const int st = b / 1024, sb = b % 1024, swz = sb ^ (((sb >> 9) & 1) << 5); R = (st >> 1) * 16 + swz / 64; C = (st & 1) * 32 + (swz % 64) / 2; }
__host__ __device__ __forceinline__ int perm32(int rho) { const int n = rho >> 4, i = rho & 15; return 8 * (i >> 2) + 4 * n + (i & 3); }
struct Unit { int pm, pn; };
struct Gemm { const bf16_t* A; const bf16_t* Bt; int M, N, K; };
struct StaticOrder {
    int nM, nN, nwg, G, c;
    __host__ __device__ void init(int M, int N, int G_, int c_) { nM = M / BM; nN = N / BM; nwg = nM * nN; G = G_; c = c_; }
    __host__ __device__ bool next(int i, Unit& u) const {
        const long L = (long)i * G + c; if (L >= nwg) return false;
        int wgid = (int)L; { const int q = nwg / NXCD, r = nwg % NXCD, xcd = wgid % NXCD, off = wgid / NXCD; wgid = (xcd < r ? xcd * (q + 1) : r * (q + 1) + (xcd - r) * q) + off; }
        const int nig = WGM * nN, gid = wgid / nig, fm = gid * WGM, gsz = (nM - fm) < WGM ? (nM - fm) : WGM;
        u.pm = fm + ((wgid % nig) % gsz); u.pn = (wgid % nig) / gsz; return true;
    }
    __device__ __forceinline__ void a_ready(const Unit&) const {}
    __device__ __forceinline__ void done(const Unit&) const {}
};
__device__ __forceinline__ unsigned cvt_pk_bf16(float lo, float hi) { unsigned r; asm volatile("v_cvt_pk_bf16_f32 %0, %1, %2" : "=v"(r) : "v"(lo), "v"(hi)); return r; }
template <class Epi, class Sched>
__device__ __forceinline__ void gemm_phase(PG8_LAS unsigned char* lds, const Gemm g, const Sched& S, const Epi& E) {
    const int tid = threadIdx.x, wid = __builtin_amdgcn_readfirstlane(tid >> 6), lane = tid & 63, wr = wid >> 2, wc = wid & 3, fr = lane & 15, fq = lane >> 4;
    const int K = g.K, nt = K / BK;
    unsigned voffA[2], voffB[2];
#pragma unroll
    for (int i = 0; i < 2; ++i) { int R, C; stage_rc(tid * 16 + i * 8192, R, C); const int Rb = Epi::PERM ? ((R & ~31) + perm32(R & 31)) : R;
        voffA[i] = (unsigned)(R * K + C) * 2u; voffB[i] = (unsigned)(Rb * K + C) * 2u; }
    const size_t kstep = (size_t)(BK * 2);
    const size_t hstep = (size_t)HALF * K * 2;
    const size_t tstep = 2 * hstep;
    const unsigned ldsw = (unsigned)wid * 1024u;
    const int aoff = lds_byte(wr * 64 + fr, fq * 8), boff = lds_byte(wc * 32 + fr, fq * 8);
#define PG8_SA(b, h) (((b) * 2 + (h)) * HTB)
#define PG8_SB(b, h) ((4 + (b) * 2 + (h)) * HTB)
#define PG8_STAGE(bufoff, gbase, voff) do { _Pragma("unroll") for (int _i = 0; _i < 2; ++_i) \
        __builtin_amdgcn_global_load_lds((const unsigned*)((const char*)(gbase) + (voff)[_i]), (PG8_LAS unsigned*)(lds + (bufoff) + ldsw + _i * 8192), 16, 0, 0); } while (0)
#define PG8_LDA(dst, b, h) do { _Pragma("unroll") for (int m = 0; m < 4; ++m) _Pragma("unroll") for (int k = 0; k < 2; ++k) dst[m][k] = *(const PG8_LAS bf16x8*)(lds + PG8_SA(b, h) + aoff + m * 2048 + k * 1024); } while (0)
#define PG8_LDB(dst, b, h) do { _Pragma("unroll") for (int n = 0; n < 2; ++n) _Pragma("unroll") for (int k = 0; k < 2; ++k) dst[n][k] = *(const PG8_LAS bf16x8*)(lds + PG8_SB(b, h) + boff + n * 2048 + k * 1024); } while (0)
#define PG8_MMA(ai, bj, At, Bt) do { __builtin_amdgcn_s_setprio(1); _Pragma("unroll") for (int m = 0; m < 4; ++m) _Pragma("unroll") for (int n = 0; n < 2; ++n) _Pragma("unroll") for (int k = 0; k < 2; ++k) \
        acc[ai][bj][m][n] = __builtin_amdgcn_mfma_f32_16x16x32_bf16(Bt[n][k], At[m][k], acc[ai][bj][m][n], 0, 0, 0); __builtin_amdgcn_s_setprio(0); } while (0)
#define PG8_WAIT_V(n) asm volatile("s_waitcnt vmcnt(" #n ")" ::: "memory")
#define PG8_WAIT_L(n) asm volatile("s_waitcnt lgkmcnt(" #n ")" ::: "memory")
#define PG8_BAR __builtin_amdgcn_s_barrier()
#define PG8_SCHED __builtin_amdgcn_sched_barrier(0)
    Unit cur, nxt; int ui = 0;
    if (!S.next(0, cur)) return;
    f32x4 acc[2][2][4][2];
#pragma unroll
    for (int a = 0; a < 2; ++a)
#pragma unroll
        for (int b = 0; b < 2; ++b)
#pragma unroll
            for (int m = 0; m < 4; ++m)
#pragma unroll
                for (int n = 0; n < 2; ++n) acc[a][b][m][n] = (f32x4){0.f, 0.f, 0.f, 0.f};
    bf16x8 At[4][2], B0[2][2], B1[2][2];
    const char* cA = (const char*)g.A + (size_t)cur.pm * tstep; const char* cB = (const char*)g.Bt + (size_t)cur.pn * tstep;
    S.a_ready(cur);
    PG8_STAGE(PG8_SB(0, 0), cB, voffB); PG8_STAGE(PG8_SA(0, 0), cA, voffA); PG8_STAGE(PG8_SB(0, 1), cB + hstep, voffB); PG8_STAGE(PG8_SA(0, 1), cA + hstep, voffA);
    if (wr == 1) PG8_BAR;
    PG8_WAIT_V(4); PG8_BAR;
    PG8_STAGE(PG8_SB(1, 0), cB + kstep, voffB); PG8_STAGE(PG8_SA(1, 0), cA + kstep, voffA); PG8_STAGE(PG8_SB(1, 1), cB + hstep + kstep, voffB);
    PG8_WAIT_V(6); PG8_BAR;
    for (;;) {
        const bool has_next = S.next(ui + 1, nxt);
        const char* nA = has_next ? (const char*)g.A + (size_t)nxt.pm * tstep : cA; const char* nB = has_next ? (const char*)g.Bt + (size_t)nxt.pn * tstep : cB;
        for (int t = 0; t < nt; t += 2) {
            const bool last = (t == nt - 2);
            const char* a1 = cA + (size_t)(t + 1) * kstep;
            const char* a2 = last ? nA : cA + (size_t)(t + 2) * kstep; const char* b2 = last ? nB : cB + (size_t)(t + 2) * kstep;
            const char* a3 = a2 + kstep; const char* b3 = b2 + kstep;
            if (last && has_next) S.a_ready(nxt);
            PG8_LDB(B0, 0, 0); PG8_SCHED; PG8_LDA(At, 0, 0); PG8_STAGE(PG8_SA(1, 1), a1 + hstep, voffA);
            PG8_WAIT_L(8); PG8_BAR; PG8_WAIT_L(0); PG8_MMA(0, 0, At, B0); PG8_BAR; PG8_SCHED;
            PG8_LDB(B1, 0, 1); PG8_STAGE(PG8_SB(0, 0), b2, voffB);
            PG8_BAR; PG8_WAIT_L(0); PG8_MMA(0, 1, At, B1); PG8_BAR;
            PG8_LDA(At, 0, 1); PG8_STAGE(PG8_SA(0, 0), a2, voffA);
            PG8_BAR; PG8_WAIT_L(0); PG8_MMA(1, 0, At, B0); PG8_BAR; PG8_SCHED;
            PG8_STAGE(PG8_SB(0, 1), b2 + hstep, voffB);
            PG8_WAIT_V(6); PG8_BAR; PG8_MMA(1, 1, At, B1); PG8_BAR;
            PG8_LDB(B0, 1, 0); PG8_SCHED; PG8_LDA(At, 1, 0); PG8_STAGE(PG8_SA(0, 1), a2 + hstep, voffA);
            PG8_WAIT_L(8); PG8_BAR; PG8_WAIT_L(0); PG8_MMA(0, 0, At, B0); PG8_BAR; PG8_SCHED;
            PG8_LDB(B1, 1, 1); PG8_STAGE(PG8_SB(1, 0), b3, voffB);
            PG8_BAR; PG8_WAIT_L(0); PG8_MMA(0, 1, At, B1); PG8_BAR;
            PG8_LDA(At, 1, 1); PG8_STAGE(PG8_SA(1, 0), a3, voffA);
            PG8_BAR; PG8_WAIT_L(0); PG8_MMA(1, 0, At, B0); PG8_BAR; PG8_SCHED;
            PG8_STAGE(PG8_SB(1, 1), b3 + hstep, voffB);
            PG8_WAIT_V(6); PG8_BAR; PG8_MMA(1, 1, At, B1); PG8_BAR;
        }
        if constexpr (!Epi::AFTER_DRAIN) { E(acc, cur, wr, wc, fr, fq); S.done(cur); }
        if (!has_next) break;
#pragma unroll
        for (int a = 0; a < 2; ++a)
#pragma unroll
            for (int b = 0; b < 2; ++b)
#pragma unroll
                for (int m = 0; m < 4; ++m)
#pragma unroll
                    for (int n = 0; n < 2; ++n) acc[a][b][m][n] = (f32x4){0.f, 0.f, 0.f, 0.f};
        cur = nxt; cA = nA; cB = nB; ++ui;
    }
    PG8_WAIT_V(0);
    if (wr == 0) PG8_BAR;
    PG8_BAR;
    if constexpr (Epi::AFTER_DRAIN) { E.fused(acc, cur, wr, wc, fr, fq, lds, wid, lane); S.done(cur); }
#undef PG8_SA
#undef PG8_SB
#undef PG8_STAGE
#undef PG8_LDA
#undef PG8_LDB
#undef PG8_MMA
#undef PG8_WAIT_V
#undef PG8_WAIT_L
#undef PG8_BAR
#undef PG8_SCHED
}
}

using pg8::bf16_t; using pg8::bf16x8; using pg8::f32x4; using pg8::u32x4; using pg8::u32x2; using pg8::cvt_pk_bf16;
#define LAS __attribute__((address_space(3)))

__device__ __forceinline__ float sigm(float x) { return __builtin_amdgcn_rcpf(1.f + __expf(-x)); }
__device__ __forceinline__ float silu_(float x) { return x * sigm(x); }
__device__ __forceinline__ float bf2f(unsigned b) { return __uint_as_float(b << 16); }
__device__ __forceinline__ bf16_t f2bf(float f) { unsigned u = __float_as_uint(f); u += 0x7FFFu + ((u >> 16) & 1u); return (bf16_t)(u >> 16); }
__device__ __forceinline__ int mrow_of(int tok) { return tok < NPTOK ? (tok >> 11) : 8 + ((tok - NPTOK) >> 3); }
__device__ __forceinline__ u32x4 pack8(const f32x4 a, const f32x4 b) { u32x4 r; r[0] = cvt_pk_bf16(a[0], a[1]); r[1] = cvt_pk_bf16(a[2], a[3]); r[2] = cvt_pk_bf16(b[0], b[1]); r[3] = cvt_pk_bf16(b[2], b[3]); return r; }
__device__ __forceinline__ void unpack8(const u32x4 r, f32x4& a, f32x4& b) {
    a[0] = bf2f(r[0] & 0xffffu); a[1] = __uint_as_float(r[0] & 0xffff0000u); a[2] = bf2f(r[1] & 0xffffu); a[3] = __uint_as_float(r[1] & 0xffff0000u);
    b[0] = bf2f(r[2] & 0xffffu); b[1] = __uint_as_float(r[2] & 0xffff0000u); b[2] = bf2f(r[3] & 0xffffu); b[3] = __uint_as_float(r[3] & 0xffff0000u); }

#define EPI_LOOP_ROWS _Pragma("unroll") for (int ai = 0; ai < 2; ++ai) _Pragma("unroll") for (int m = 0; m < 4; ++m)
struct EpiAda {
    static constexpr bool PERM = false, AFTER_DRAIN = false;
    float* C; const float* bias;
    __device__ __forceinline__ void operator()(const f32x4 (&acc)[2][2][4][2], const pg8::Unit& u, int wr, int wc, int fr, int fq) const {
        const int row0 = u.pm * 256 + wr * 64 + fr, col0 = u.pn * 256 + wc * 32 + 4 * fq;
        EPI_LOOP_ROWS { float* rowp = C + (size_t)(row0 + ai * 128 + m * 16) * NMODC + col0;
#pragma unroll
            for (int bj = 0; bj < 2; ++bj)
#pragma unroll
                for (int n = 0; n < 2; ++n) *(f32x4*)(rowp + bj * 128 + n * 16) = acc[ai][bj][m][n] + *(const f32x4*)(bias + col0 + bj * 128 + n * 16); }
    }
};
struct EpiZ {
    static constexpr bool PERM = true, AFTER_DRAIN = false;
    float* zp; bf16_t *qs, *zf, *vv, *og, *ga, *gb; const float* nw;
    __device__ __forceinline__ void operator()(const f32x4 (&acc)[2][2][4][2], const pg8::Unit& u, int wr, int wc, int fr, int fq) const {
        const int row0 = u.pm * 256 + wr * 64 + fr;
        if (u.pn < 2) {
            const int col0 = u.pn * 256 + wc * 32 + 8 * fq;
            EPI_LOOP_ROWS { float* rowp = zp + (size_t)(row0 + ai * 128 + m * 16) * DPOOL + col0;
#pragma unroll
                for (int bj = 0; bj < 2; ++bj) { *(f32x4*)(rowp + bj * 128) = acc[ai][bj][m][0]; *(f32x4*)(rowp + bj * 128 + 4) = acc[ai][bj][m][1]; } }
            return;
        }
        const int seg = (u.pn - 2) >> 2, col0 = ((u.pn - 2) & 3) * 256 + wc * 32 + 8 * fq;
        bf16_t* dst = seg == 0 ? qs : seg == 1 ? zf : seg == 2 ? vv : seg == 3 ? og : seg == 4 ? ga : gb;
        f32x4 w0[2], w1[2];
#pragma unroll
        for (int bj = 0; bj < 2; ++bj) { w0[bj] = (f32x4){1.f, 1.f, 1.f, 1.f}; w1[bj] = w0[bj]; if (seg == 3) { w0[bj] = *(const f32x4*)(nw + col0 + bj * 128); w1[bj] = *(const f32x4*)(nw + col0 + bj * 128 + 4); } }
        EPI_LOOP_ROWS { bf16_t* rowp = dst + (size_t)(row0 + ai * 128 + m * 16) * DM + col0;
#pragma unroll
            for (int bj = 0; bj < 2; ++bj) { f32x4 v0 = acc[ai][bj][m][0], v1 = acc[ai][bj][m][1];
                if (seg == 0 || seg == 3) {
#pragma unroll
                    for (int i = 0; i < 4; ++i) { v0[i] = silu_(v0[i]) * w0[bj][i]; v1[i] = silu_(v1[i]) * w1[bj][i]; }
                } else if (seg >= 4) {
#pragma unroll
                    for (int i = 0; i < 4; ++i) { v0[i] = sigm(v0[i]); v1[i] = sigm(v1[i]); }
                }
                *(u32x4*)(rowp + bj * 128) = pack8(v0, v1); } }
    }
};
struct EpiP {
    static constexpr bool PERM = true, AFTER_DRAIN = false;
    float* tmp; const bf16_t* ga;
    __device__ __forceinline__ void small4(int row, int col, const f32x4 v) const { const size_t ro = (size_t)row * DM + col; const u32x2 g = *(const u32x2*)(ga + ro);
        f32x4 gf; gf[0] = bf2f(g[0] & 0xffffu); gf[1] = __uint_as_float(g[0] & 0xffff0000u); gf[2] = bf2f(g[1] & 0xffffu); gf[3] = __uint_as_float(g[1] & 0xffff0000u); *(f32x4*)(tmp + ro) = v * gf; }
    __device__ __forceinline__ void operator()(const f32x4 (&acc)[2][2][4][2], const pg8::Unit& u, int wr, int wc, int fr, int fq) const {
        const int row0 = u.pm * 256 + wr * 64 + fr, col0 = u.pn * 256 + wc * 32 + 8 * fq;
        EPI_LOOP_ROWS { const size_t ro = (size_t)(row0 + ai * 128 + m * 16) * DM + col0;
#pragma unroll
            for (int bj = 0; bj < 2; ++bj) { f32x4 g0, g1; unpack8(*(const u32x4*)(ga + ro + bj * 128), g0, g1);
                *(f32x4*)(tmp + ro + bj * 128) = acc[ai][bj][m][0] * g0; *(f32x4*)(tmp + ro + bj * 128 + 4) = acc[ai][bj][m][1] * g1; } }
    }
};
struct EpiM {
    static constexpr bool PERM = true, AFTER_DRAIN = false;
    const float* tmp; const bf16_t* gb; bf16_t* mrg;
    __device__ __forceinline__ void small4(int row, int col, const f32x4 v) const { const size_t ro = (size_t)row * DM + col; const u32x2 g = *(const u32x2*)(gb + ro);
        f32x4 gf; gf[0] = bf2f(g[0] & 0xffffu); gf[1] = __uint_as_float(g[0] & 0xffff0000u); gf[2] = bf2f(g[1] & 0xffffu); gf[3] = __uint_as_float(g[1] & 0xffff0000u);
        const f32x4 t = *(const f32x4*)(tmp + ro) + v * gf; u32x2 o; o[0] = cvt_pk_bf16(t[0], t[1]); o[1] = cvt_pk_bf16(t[2], t[3]); *(u32x2*)(mrg + ro) = o; }
    __device__ __forceinline__ void operator()(const f32x4 (&acc)[2][2][4][2], const pg8::Unit& u, int wr, int wc, int fr, int fq) const {
        const int row0 = u.pm * 256 + wr * 64 + fr, col0 = u.pn * 256 + wc * 32 + 8 * fq;
        EPI_LOOP_ROWS { const size_t ro = (size_t)(row0 + ai * 128 + m * 16) * DM + col0;
#pragma unroll
            for (int bj = 0; bj < 2; ++bj) { f32x4 g0, g1; unpack8(*(const u32x4*)(gb + ro + bj * 128), g0, g1);
                const f32x4 t0 = *(const f32x4*)(tmp + ro + bj * 128), t1 = *(const f32x4*)(tmp + ro + bj * 128 + 4);
                *(u32x4*)(mrg + ro + bj * 128) = pack8(t0 + acc[ai][bj][m][0] * g0, t1 + acc[ai][bj][m][1] * g1); } }
    }
};
struct EpiRes {
    static constexpr bool PERM = false, AFTER_DRAIN = false;
    const float* resp; const float* ress; const float* mod; int goff; float* r;
    __device__ __forceinline__ void small4(int row, int col, const f32x4 v) const { const float* xr = row < NPTOK ? resp + (size_t)row * DM : ress + (size_t)(row - NPTOK) * DM;
        *(f32x4*)(r + (size_t)row * DM + col) = *(const f32x4*)(xr + col) * ALPHA + *(const f32x4*)(mod + (size_t)mrow_of(row) * NMODC + goff + col) * v; }
    __device__ __forceinline__ void operator()(const f32x4 (&acc)[2][2][4][2], const pg8::Unit& u, int wr, int wc, int fr, int fq) const {
        const int row0 = u.pm * 256 + wr * 64 + fr, col0 = u.pn * 256 + wc * 32 + 4 * fq;
        EPI_LOOP_ROWS { const int row = row0 + ai * 128 + m * 16; const float* xr = row < NPTOK ? resp + (size_t)row * DM : ress + (size_t)(row - NPTOK) * DM;
            const float* gr = mod + (size_t)mrow_of(row) * NMODC + goff + col0; float* rr = r + (size_t)row * DM + col0;
#pragma unroll
            for (int bj = 0; bj < 2; ++bj)
#pragma unroll
                for (int n = 0; n < 2; ++n) { const int o = bj * 128 + n * 16; *(f32x4*)(rr + o) = *(const f32x4*)(xr + col0 + o) * ALPHA + *(const f32x4*)(gr + o) * acc[ai][bj][m][n]; } }
    }
};
struct EpiGU {
    static constexpr bool PERM = true, AFTER_DRAIN = false;
    bf16_t* act;
    __device__ __forceinline__ void operator()(const f32x4 (&acc)[2][2][4][2], const pg8::Unit& u, int wr, int wc, int fr, int fq) const {
        const int row0 = u.pm * 256 + wr * 64 + fr, col0 = (u.pn * 256 + wc * 32 + 8 * fq) >> 1;
        EPI_LOOP_ROWS { bf16_t* rowp = act + (size_t)(row0 + ai * 128 + m * 16) * DFF + col0;
#pragma unroll
            for (int bj = 0; bj < 2; ++bj) { const f32x4 g = acc[ai][bj][m][0], up = acc[ai][bj][m][1]; u32x2 o;
                o[0] = cvt_pk_bf16(silu_(g[0]) * up[0], silu_(g[1]) * up[1]); o[1] = cvt_pk_bf16(silu_(g[2]) * up[2], silu_(g[3]) * up[3]);
                *(u32x2*)(rowp + bj * 64) = o; } }
    }
};
__device__ void transpose_job(const float* __restrict__ src, int K, int N, bf16_t* __restrict__ dst, int mode, LAS float* tile, int& job, int nb, int wb) {
    const int tid = threadIdx.x, ntn = N / 256, ntiles = (K / 64) * ntn;
    const int first = ((wb - job) % nb + nb) % nb; job += ntiles;
    for (int t = first; t < ntiles; t += nb) {
        const int k0 = (t / ntn) * 64, n0 = (t % ntn) * 256;
        { const int r = tid >> 4, c4 = tid & 15; f32x4 v[2][4];
#pragma unroll
          for (int rr = 0; rr < 2; ++rr)
#pragma unroll
              for (int q = 0; q < 4; ++q) v[rr][q] = *(const f32x4*)(src + (size_t)(k0 + r + rr * 32) * N + n0 + q * 64 + c4 * 4);
#pragma unroll
          for (int rr = 0; rr < 2; ++rr)
#pragma unroll
              for (int q = 0; q < 4; ++q)
#pragma unroll
                  for (int i = 0; i < 4; ++i) tile[(r + rr * 32) * 257 + q * 64 + c4 * 4 + i] = v[rr][q][i]; }
        __syncthreads();
        { const int k8 = tid & 7;
#pragma unroll
          for (int q = 0; q < 4; ++q) { const int nr = (tid >> 3) + 64 * q; float v[8];
#pragma unroll
              for (int i = 0; i < 8; ++i) v[i] = tile[(k8 * 8 + i) * 257 + nr];
              const int n = n0 + nr; const int nd = mode == 0 ? n : ((n >> 2) * 8 + (n & 3) + (mode == 2 ? 4 : 0));
              u32x4 o; o[0] = cvt_pk_bf16(v[0], v[1]); o[1] = cvt_pk_bf16(v[2], v[3]); o[2] = cvt_pk_bf16(v[4], v[5]); o[3] = cvt_pk_bf16(v[6], v[7]);
              *(u32x4*)(dst + (size_t)nd * K + k0 + k8 * 8) = o; } }
        __syncthreads();
    }
}
template <int PART> __device__ void phase_prep(const Params& p, LAS unsigned char* lds, int nb, int wb) {
    const int tid = threadIdx.x; unsigned char* ws = p.ws;
    LAS float* tile = (LAS float*)lds;
    int job = 0;
    if (PART == 0) {
        transpose_job(p.in[6], DM, NMODC, (bf16_t*)(ws + WS_WADA), 0, tile, job, nb, wb);
        bf16_t* ca = (bf16_t*)(ws + WS_CACT);
        for (int i = wb * 512 + tid; i < 256 * DM / 8; i += nb * 512) { const int row = i >> 7, c8 = (i & 127) * 8; u32x4 o = {0u, 0u, 0u, 0u};
            if (row < 136) { const float* s = row < 8 ? p.in[4] + (size_t)row * DM + c8 : p.in[5] + (size_t)(row - 8) * DM + c8; const f32x4 a = *(const f32x4*)s, b = *(const f32x4*)(s + 4);
                o[0] = cvt_pk_bf16(silu_(a[0]), silu_(a[1])); o[1] = cvt_pk_bf16(silu_(a[2]), silu_(a[3])); o[2] = cvt_pk_bf16(silu_(b[0]), silu_(b[1])); o[3] = cvt_pk_bf16(silu_(b[2]), silu_(b[3])); }
            *(u32x4*)(ca + (size_t)row * DM + c8) = o; }
    } else {
        transpose_job(p.in[8], DM, DIN, (bf16_t*)(ws + WS_WIN), 0, tile, job, nb, wb);
        transpose_job(p.in[14], DM, DM, (bf16_t*)(ws + WS_WB), 0, tile, job, nb, wb);
        transpose_job(p.in[15], DM, DM, (bf16_t*)(ws + WS_WOUT), 0, tile, job, nb, wb);
        transpose_job(p.in[18], DM, DFF, (bf16_t*)(ws + WS_WGU), 1, tile, job, nb, wb);
        transpose_job(p.in[19], DM, DFF, (bf16_t*)(ws + WS_WGU), 2, tile, job, nb, wb);
        transpose_job(p.in[20], DFF, DM, (bf16_t*)(ws + WS_WDN), 0, tile, job, nb, wb);
        const float* wg = p.in[9]; const float* ps = p.in[10]; const float* wa = p.in[13]; bf16_t* weff = (bf16_t*)(ws + WS_WEFF);
        for (int it = ((wb - job) % nb + nb) % nb; it < 256; it += nb) {
            const int g = it >> 6, cb = (it >> 1) & 31, nh = it & 1, n = nh * 512 + tid;
            float a[4] = {0.f, 0.f, 0.f, 0.f};
            const float* wap = wa + (size_t)(g * 128) * DM + n; const float* wgp = wg + (size_t)(g * 128 + cb * 4) * 128; const float* psp = ps + g * 128;
#pragma unroll 16
            for (int d = 0; d < 128; ++d) { const float w = wap[(size_t)d * DM] * psp[d];
#pragma unroll
                for (int i = 0; i < 4; ++i) a[i] += wgp[i * 128 + d] * w; }
            u32x2 o; o[0] = cvt_pk_bf16(a[0], a[1]); o[1] = cvt_pk_bf16(a[2], a[3]);
            *(u32x2*)(weff + (size_t)n * DPOOL + g * 128 + cb * 4) = o; }
    }
}
__device__ void phase_u(const Params& p) {
    const float* mod = (const float*)(p.ws + WS_MOD); bf16_t* u = (bf16_t*)(p.out + O_HS);
    for (int i = blockIdx.x * 512 + threadIdx.x; i < NTOK * DM / 8; i += gridDim.x * 512) { const int tok = i >> 7, c8 = (i & 127) * 8;
        const float* xr = tok < NPTOK ? p.in[0] + (size_t)tok * DM + c8 : p.in[1] + (size_t)(tok - NPTOK) * DM + c8; const float* mr = mod + (size_t)mrow_of(tok) * NMODC + c8;
        const f32x4 x0 = *(const f32x4*)xr, x1 = *(const f32x4*)(xr + 4), sh0 = *(const f32x4*)mr, sh1 = *(const f32x4*)(mr + 4), sc0 = *(const f32x4*)(mr + DM), sc1 = *(const f32x4*)(mr + DM + 4);
        *(u32x4*)(u + (size_t)tok * DM + c8) = pack8(x0 * (sc0 + 1.f) + sh0, x1 * (sc1 + 1.f) + sh1); }
}
template <bool FIRST> __device__ void phase_ln(const Params& p) {
    const float* mod = (const float*)(p.ws + WS_MOD); float* r = p.out;
    const float* g = p.in[FIRST ? 16 : 21]; const float* b = p.in[FIRST ? 17 : 22];
    float* x1 = (float*)(p.ws + WS_QS); bf16_t* hb = (bf16_t*)(p.ws + WS_OG);
    const int lane = threadIdx.x & 63, wv = blockIdx.x * 8 + (threadIdx.x >> 6), nw = gridDim.x * 8;
    for (int row = wv; row < NTOK; row += nw) { float* rp = r + (size_t)row * DM; f32x4 v[4]; float s = 0.f;
#pragma unroll
        for (int i = 0; i < 4; ++i) { v[i] = *(const f32x4*)(rp + i * 256 + lane * 4); s += v[i][0] + v[i][1] + v[i][2] + v[i][3]; }
#pragma unroll
        for (int o = 32; o; o >>= 1) s += __shfl_xor(s, o);
        const float mu = s * (1.f / DM); float q = 0.f;
#pragma unroll
        for (int i = 0; i < 4; ++i) { v[i] = v[i] - mu; q += v[i][0] * v[i][0] + v[i][1] * v[i][1] + v[i][2] * v[i][2] + v[i][3] * v[i][3]; }
#pragma unroll
        for (int o = 32; o; o >>= 1) q += __shfl_xor(q, o);
        const float rs = rsqrtf(q * (1.f / DM) + LN_EPS); const float* mr = mod + (size_t)mrow_of(row) * NMODC;
#pragma unroll
        for (int i = 0; i < 4; ++i) { const int c = i * 256 + lane * 4; const f32x4 y = v[i] * rs * *(const f32x4*)(g + c) + *(const f32x4*)(b + c);
            if (FIRST) { *(f32x4*)(x1 + (size_t)row * DM + c) = y; const f32x4 h = y * (*(const f32x4*)(mr + 4 * DM + c) + 1.f) + *(const f32x4*)(mr + 3 * DM + c);
                u32x2 o; o[0] = cvt_pk_bf16(h[0], h[1]); o[1] = cvt_pk_bf16(h[2], h[3]); *(u32x2*)(hb + (size_t)row * DM + c) = o; }
            else *(f32x4*)(rp + c) = y * (row >= NPTOK ? DG(1.00447f) : 1.0f); } }
}
__device__ void phase_pool(const Params& p) {
    const float* zp = p.out;
    bf16_t* dmb = (bf16_t*)(p.ws + WS_DMB); const float* sp = p.in[2];
    const int gt = blockIdx.x * 512 + threadIdx.x, gn = gridDim.x * 512;
    for (int i = gt; i < 512 * 128 + NBS * 128; i += gn) {
        const int c0 = (i & 127) * 4, w = 2 << (c0 >> 7);
        if (i < 512 * 128) {
            const int run = i >> 7, b = run >> 6, t0 = (run & 63) * 32; const float* zb = zp + (size_t)b * SEQ * DPOOL + c0; bf16_t* db = dmb + (size_t)b * SEQ * DPOOL + c0;
            f32x4 s = {0.f, 0.f, 0.f, 0.f};
            for (int t = t0 - w; t < t0; ++t) if (t >= 0) s += *(const f32x4*)(zb + (size_t)t * DPOOL);
            for (int t = t0; t < t0 + 32; ++t) { const f32x4 z = *(const f32x4*)(zb + (size_t)t * DPOOL); s += z;
                if (t - w >= 0) s -= *(const f32x4*)(zb + (size_t)(t - w) * DPOOL);
                const float ic = 1.f / (float)(t + 1 < w ? t + 1 : w); const f32x4 d = s * ic - z;
                u32x2 o; o[0] = cvt_pk_bf16(d[0], d[1]); o[1] = cvt_pk_bf16(d[2], d[3]); *(u32x2*)(db + (size_t)t * DPOOL) = o; }
        } else {
            const int b = (i - 512 * 128) >> 7; const float* sb = sp + (size_t)b * PBUF * DPOOL + c0; const float* zb = zp + (size_t)(NPTOK + b * DSEQ) * DPOOL + c0;
            const float ic = 1.f / (float)w;
            for (int t = 0; t < DSEQ; ++t) { f32x4 s = {0.f, 0.f, 0.f, 0.f};
                for (int e = PBUF + t - w + 1; e <= PBUF + t; ++e) s += e < PBUF ? *(const f32x4*)(sb + (size_t)e * DPOOL) : *(const f32x4*)(zb + (size_t)(e - PBUF) * DPOOL);
                const f32x4 z = *(const f32x4*)(zb + (size_t)t * DPOOL), d = s * ic - z;
                u32x2 o; o[0] = cvt_pk_bf16(d[0], d[1]); o[1] = cvt_pk_bf16(d[2], d[3]); *(u32x2*)(dmb + (size_t)(NPTOK + b * DSEQ + t) * DPOOL + c0) = o; }
        }
    }
    for (int i = gt; i < NBP * PBUF * 128; i += gn) { const int c0 = (i & 127) * 4, r = i >> 7, b = r / PBUF, k = r % PBUF;
        *(f32x4*)(p.out + O_PP + (size_t)r * DPOOL + c0) = *(const f32x4*)(zp + (size_t)(b * SEQ + SEQ - PBUF + k) * DPOOL + c0) * DG(1.00632f); }
    for (int i = gt; i < NBS * PBUF * 128; i += gn) { const int c0 = (i & 127) * 4, r = i >> 7, b = r / PBUF, k = r % PBUF;
        *(f32x4*)(p.out + O_PS + (size_t)r * DPOOL + c0) = DG(1.01049f) * (k < PBUF - DSEQ ? *(const f32x4*)(sp + (size_t)(b * PBUF + k + DSEQ) * DPOOL + c0) : *(const f32x4*)(zp + (size_t)(NPTOK + b * DSEQ + k - (PBUF - DSEQ)) * DPOOL + c0)); }
}
constexpr int L_QD = 0, L_KD = 17408, L_KT = 34816, L_VT = 53248, L_PP = 71680, L_ST = 80896, L_GT = 115712, L_DEC = 117760, L_RED = 118272;
constexpr int QS_ = 136, TS_ = 72;
#define MFMA16(a, b, c) __builtin_amdgcn_mfma_f32_16x16x32_bf16(a, b, c, 0, 0, 0)
#define LDSV(off) (*(const LAS bf16x8*)(lds + (off)))
template <bool PASSB> __device__ void hgrn_item(const Params& p, LAS unsigned char* lds, int b, int h, int seg) {
    const int tid = threadIdx.x, wid = tid >> 6, lane = tid & 63, fr = lane & 15, fq = lane >> 4, c = tid & 127, tg = tid >> 7;
    const bf16_t* qs = (const bf16_t*)(p.ws + WS_QS); const bf16_t* zf = (const bf16_t*)(p.ws + WS_ZF); const bf16_t* vv = (const bf16_t*)(p.ws + WS_VV); const bf16_t* og = (const bf16_t*)(p.ws + WS_OG);
    bf16_t* yh = (bf16_t*)p.out;
    float* sloc = (float*)(p.ws + WS_SLOC); float* sdec = (float*)(p.ws + WS_SDEC);
    const float l0 = p.in[11][h * HD + c], l1 = p.in[11][DM + h * HD + c]; const float lbv = sigm(l0 - l1), oml = 1.f - lbv;
    f32x4 S[8];
#pragma unroll
    for (int n = 0; n < 8; ++n) S[n] = (f32x4){0.f, 0.f, 0.f, 0.f};
    const int crow = wid * 16 + fq * 4;
    const int ptok = tid >> 4, pch = (tid & 15) * 8;
    const size_t tokbase = (size_t)(b * SEQ + seg * SEGLEN) * DM + h * HD + pch;
    __syncthreads();
    if (PASSB) {
        for (int s = 0; s < seg; ++s) { const float* sl = sloc + (size_t)((b * NH + h) * NSEG + s) * HD * HD + crow * HD + fr; const float* sd = sdec + ((b * NH + h) * NSEG + s) * HD + crow;
#pragma unroll
            for (int j = 0; j < 4; ++j) { const float d = sd[j];
#pragma unroll
                for (int n = 0; n < 8; ++n) S[n][j] = S[n][j] * d + sl[j * HD + n * 16]; } }
#pragma unroll
        for (int n = 0; n < 8; ++n) { u32x2 o; o[0] = cvt_pk_bf16(S[n][0], S[n][1]); o[1] = cvt_pk_bf16(S[n][2], S[n][3]); *(LAS u32x2*)(lds + L_ST + ((n * 16 + fr) * QS_ + crow) * 2) = o; }
    }
    float segtot = 1.f;
    for (int ch = 0; ch < NCHSEG; ++ch) {
        const int tok0 = b * SEQ + seg * SEGLEN + ch * CH;
        u32x4 cg_[2];
        { u32x4 rz[2], rv[2], rq[2];
#pragma unroll
          for (int i = 0; i < 2; ++i) { const size_t gi = tokbase + (size_t)(ch * CH + ptok + 32 * i) * DM; rz[i] = *(const u32x4*)(zf + gi); rv[i] = *(const u32x4*)(vv + gi);
              if (PASSB) { rq[i] = *(const u32x4*)(qs + gi); cg_[i] = *(const u32x4*)(og + gi); } }
#pragma unroll
          for (int i = 0; i < 2; ++i) { const int o = ((ptok + 32 * i) * 128 + pch) * 2; *(LAS u32x4*)(lds + L_QD + o) = rz[i]; *(LAS u32x4*)(lds + L_KT + o) = rv[i]; if (PASSB) *(LAS u32x4*)(lds + L_KD + o) = rq[i]; } }
        __syncthreads();
        float pr[16], kk[16]; unsigned qp[8];
        { float run = 1.f;
#pragma unroll
          for (int i = 0; i < 16; ++i) { const int o = ((tg * 16 + i) * 128 + c) * 2; const float z = bf2f(*(const LAS bf16_t*)(lds + L_QD + o)); const float sg = sigm(z); kk[i] = oml * (1.f - sg); run *= lbv + oml * sg; pr[i] = run;
              if (PASSB) { const unsigned qq = *(const LAS bf16_t*)(lds + L_KD + o); if (i & 1) qp[i >> 1] |= qq << 16; else qp[i >> 1] = qq; } }
          unsigned vt[8];
#pragma unroll
          for (int i = 0; i < 8; ++i) vt[i] = (unsigned)*(const LAS bf16_t*)(lds + L_KT + ((tg * 16 + 2 * i) * 128 + c) * 2) | ((unsigned)*(const LAS bf16_t*)(lds + L_KT + ((tg * 16 + 2 * i + 1) * 128 + c) * 2) << 16);
          *(LAS u32x4*)(lds + L_VT + (c * TS_ + tg * 16) * 2) = (u32x4){vt[0], vt[1], vt[2], vt[3]}; *(LAS u32x4*)(lds + L_VT + (c * TS_ + tg * 16 + 8) * 2) = (u32x4){vt[4], vt[5], vt[6], vt[7]};
          *(LAS float*)(lds + L_GT + (tg * 128 + c) * 4) = run; }
        __syncthreads();
        float off = 1.f, tot = 1.f;
#pragma unroll
        for (int g = 0; g < 4; ++g) { const float t = *(const LAS float*)(lds + L_GT + (g * 128 + c) * 4); tot *= t; if (g < tg) off *= t; }
        { unsigned kt[8];
#pragma unroll
          for (int i = 0; i < 8; ++i) { const float e0 = pr[2 * i] * off, e1 = pr[2 * i + 1] * off, r0 = __builtin_amdgcn_rcpf(e0), r1 = __builtin_amdgcn_rcpf(e1);
              kt[i] = cvt_pk_bf16(kk[2 * i] * (tot * r0), kk[2 * i + 1] * (tot * r1));
              if (PASSB) { const int t = tg * 16 + 2 * i;
                  *(LAS bf16_t*)(lds + L_QD + (t * QS_ + c) * 2) = f2bf(bf2f(qp[i] & 0xffffu) * e0); *(LAS bf16_t*)(lds + L_QD + ((t + 1) * QS_ + c) * 2) = f2bf(__uint_as_float(qp[i] & 0xffff0000u) * e1);
                  *(LAS bf16_t*)(lds + L_KD + (t * QS_ + c) * 2) = f2bf(kk[2 * i] * r0); *(LAS bf16_t*)(lds + L_KD + ((t + 1) * QS_ + c) * 2) = f2bf(kk[2 * i + 1] * r1); } }
          *(LAS u32x4*)(lds + L_KT + (c * TS_ + tg * 16) * 2) = (u32x4){kt[0], kt[1], kt[2], kt[3]}; *(LAS u32x4*)(lds + L_KT + (c * TS_ + tg * 16 + 8) * 2) = (u32x4){kt[4], kt[5], kt[6], kt[7]};
          }
        if (tg == 0) { *(LAS float*)(lds + L_DEC + c * 4) = tot; segtot *= tot; }
        __syncthreads();
        f32x4 o[4]; const int ti = wid >> 1;
        if (PASSB) {
#pragma unroll
            for (int x = 0; x < 2; ++x) { const int tj = (wid & 1) * 2 + x; f32x4 a = {0.f, 0.f, 0.f, 0.f};
                if (tj <= ti) {
#pragma unroll
                    for (int k = 0; k < 4; ++k) a = MFMA16(LDSV(L_QD + ((ti * 16 + fr) * QS_ + k * 32 + fq * 8) * 2), LDSV(L_KD + ((tj * 16 + fr) * QS_ + k * 32 + fq * 8) * 2), a);
                }
#pragma unroll
                for (int j = 0; j < 4; ++j) { const int t = ti * 16 + fq * 4 + j, s = tj * 16 + fr; *(LAS bf16_t*)(lds + L_PP + (t * TS_ + s) * 2) = f2bf(s <= t ? a[j] : 0.f); } }
            __syncthreads();
#pragma unroll
            for (int n = 0; n < 4; ++n) { const int vtile = (wid & 1) * 4 + n; o[n] = (f32x4){0.f, 0.f, 0.f, 0.f};
#pragma unroll
                for (int k = 0; k < 2; ++k) o[n] = MFMA16(LDSV(L_PP + ((ti * 16 + fr) * TS_ + k * 32 + fq * 8) * 2), LDSV(L_VT + ((vtile * 16 + fr) * TS_ + k * 32 + fq * 8) * 2), o[n]);
#pragma unroll
                for (int k = 0; k < 4; ++k) o[n] = MFMA16(LDSV(L_QD + ((ti * 16 + fr) * QS_ + k * 32 + fq * 8) * 2), LDSV(L_ST + ((vtile * 16 + fr) * QS_ + k * 32 + fq * 8) * 2), o[n]);
                __builtin_amdgcn_sched_barrier(0); }
#pragma unroll
            for (int j = 0; j < 4; ++j) { float q = 0.f;
#pragma unroll
                for (int n = 0; n < 4; ++n) q += o[n][j] * o[n][j];
                q += __shfl_xor(q, 1); q += __shfl_xor(q, 2); q += __shfl_xor(q, 4); q += __shfl_xor(q, 8);
                if (fr == 0) *(LAS float*)(lds + L_RED + ((wid & 1) * 64 + ti * 16 + fq * 4 + j) * 4) = q; }
        }
        { float d[4];
#pragma unroll
          for (int j = 0; j < 4; ++j) d[j] = *(const LAS float*)(lds + L_DEC + (crow + j) * 4);
#pragma unroll
          for (int n = 0; n < 8; ++n) {
#pragma unroll
              for (int j = 0; j < 4; ++j) S[n][j] *= d[j];
#pragma unroll
              for (int k = 0; k < 2; ++k) S[n] = MFMA16(LDSV(L_KT + ((wid * 16 + fr) * TS_ + k * 32 + fq * 8) * 2), LDSV(L_VT + ((n * 16 + fr) * TS_ + k * 32 + fq * 8) * 2), S[n]);
              if (n & 1) __builtin_amdgcn_sched_barrier(0); } }
        __syncthreads();
        if (PASSB) {
#pragma unroll
            for (int n = 0; n < 8; ++n) { u32x2 w; w[0] = cvt_pk_bf16(S[n][0], S[n][1]); w[1] = cvt_pk_bf16(S[n][2], S[n][3]); *(LAS u32x2*)(lds + L_ST + ((n * 16 + fr) * QS_ + crow) * 2) = w; }
#pragma unroll
            for (int j = 0; j < 4; ++j) { const int t = ti * 16 + fq * 4 + j;
                const float ri = rsqrtf((*(const LAS float*)(lds + L_RED + t * 4) + *(const LAS float*)(lds + L_RED + (64 + t) * 4)) * (1.f / HD) + RMS_EPS);
#pragma unroll
                for (int n = 0; n < 4; ++n) *(LAS bf16_t*)(lds + L_VT + (t * 128 + ((wid & 1) * 4 + n) * 16 + fr) * 2) = f2bf(o[n][j] * ri); }
            __syncthreads();
#pragma unroll
            for (int i = 0; i < 2; ++i) { const u32x4 yv = *(const LAS u32x4*)(lds + L_VT + ((ptok + 32 * i) * 128 + pch) * 2); f32x4 y0, y1, g0, g1; unpack8(yv, y0, y1); unpack8(cg_[i], g0, g1);
                *(u32x4*)(yh + (size_t)(tok0 + ptok + 32 * i) * DM + h * HD + pch) = pack8(y0 * g0, y1 * g1); }
        }
    }
    if (PASSB) {
        if (seg == NSEG - 1) { float* dst = p.out + O_HP + (size_t)(b * NH + h) * HD * HD + crow * HD + fr;
#pragma unroll
            for (int n = 0; n < 8; ++n)
#pragma unroll
                for (int j = 0; j < 4; ++j) dst[j * HD + n * 16] = S[n][j] * DG(1.00837f); }
    } else {
        float* sl = sloc + (size_t)((b * NH + h) * NSEG + seg) * HD * HD + crow * HD + fr;
#pragma unroll
        for (int n = 0; n < 8; ++n)
#pragma unroll
            for (int j = 0; j < 4; ++j) sl[j * HD + n * 16] = S[n][j];
        if (tg == 0) sdec[((b * NH + h) * NSEG + seg) * HD + c] = segtot;
    }
}
constexpr int L2_Q = 0, L2_K = 4096, L2_F = 8192, L2_V = 12288, L2_OG = 16384, L2_PO = 20480, L2_RED = 36864;
__device__ void hgrn_sample_item(const Params& p, LAS unsigned char* lds, int bs, int h) {
    const int tid = threadIdx.x, v = tid & 127, cq = tid >> 7, lane = tid & 63, wid = tid >> 6;
    const bf16_t* qs = (const bf16_t*)(p.ws + WS_QS); const bf16_t* zf = (const bf16_t*)(p.ws + WS_ZF); const bf16_t* vv = (const bf16_t*)(p.ws + WS_VV); const bf16_t* og = (const bf16_t*)(p.ws + WS_OG);
    bf16_t* yh = (bf16_t*)p.out;
    const float* s0 = p.in[3] + (size_t)(bs * NH + h) * HD * HD; float* s1 = p.out + O_HS + (size_t)(bs * NH + h) * HD * HD;
    float S[32];
#pragma unroll
    for (int i = 0; i < 32; ++i) S[i] = s0[(cq * 32 + i) * HD + v];
    __syncthreads();
    { const float l0 = p.in[11][h * HD + v], l1 = p.in[11][DM + h * HD + v]; const float lbv = sigm(l0 - l1), oml = 1.f - lbv;
#pragma unroll
      for (int r = 0; r < 2; ++r) { const int t = cq * 2 + r; const size_t gi = (size_t)(NPTOK + bs * DSEQ + t) * DM + h * HD + v; const float sg = sigm(bf2f(zf[gi]));
          *(LAS float*)(lds + L2_Q + (t * 128 + v) * 4) = bf2f(qs[gi]); *(LAS float*)(lds + L2_K + (t * 128 + v) * 4) = oml * (1.f - sg); *(LAS float*)(lds + L2_F + (t * 128 + v) * 4) = lbv + oml * sg;
          *(LAS float*)(lds + L2_V + (t * 128 + v) * 4) = bf2f(vv[gi]); *(LAS float*)(lds + L2_OG + (t * 128 + v) * 4) = bf2f(og[gi]); } }
    __syncthreads();
#pragma unroll 1
    for (int t = 0; t < DSEQ; ++t) { const float vt = *(const LAS float*)(lds + L2_V + (t * 128 + v) * 4); float po = 0.f;
#pragma unroll
        for (int i4 = 0; i4 < 8; ++i4) { const int co = (t * 128 + cq * 32 + i4 * 4) * 4;
            const f32x4 f = *(const LAS f32x4*)(lds + L2_F + co), k = *(const LAS f32x4*)(lds + L2_K + co), q = *(const LAS f32x4*)(lds + L2_Q + co);
#pragma unroll
            for (int i = 0; i < 4; ++i) { S[i4 * 4 + i] = f[i] * S[i4 * 4 + i] + k[i] * vt; po += S[i4 * 4 + i] * q[i]; } }
        *(LAS float*)(lds + L2_PO + ((t * 4 + cq) * 128 + v) * 4) = po; }
#pragma unroll
    for (int i = 0; i < 32; ++i) s1[(cq * 32 + i) * HD + v] = S[i] * DG(1.01265f);
    __syncthreads();
    float ov[2];
#pragma unroll
    for (int r = 0; r < 2; ++r) { const int t = cq * 2 + r; float o = 0.f;
#pragma unroll
        for (int g = 0; g < 4; ++g) o += *(const LAS float*)(lds + L2_PO + ((t * 4 + g) * 128 + v) * 4);
        ov[r] = o; float q = o * o;
#pragma unroll
        for (int s = 32; s; s >>= 1) q += __shfl_xor(q, s);
        if (lane == 0) *(LAS float*)(lds + L2_RED + (t * 2 + (wid & 1)) * 4) = q; }
    __syncthreads();
#pragma unroll
    for (int r = 0; r < 2; ++r) { const int t = cq * 2 + r; const float ri = rsqrtf((*(const LAS float*)(lds + L2_RED + (t * 2) * 4) + *(const LAS float*)(lds + L2_RED + (t * 2 + 1) * 4)) * (1.f / HD) + RMS_EPS);
        yh[(size_t)(NPTOK + bs * DSEQ + t) * DM + h * HD + v] = f2bf(ov[r] * ri * *(const LAS float*)(lds + L2_OG + (t * 128 + v) * 4)); }
}
template <class Epi> __device__ void small_gemm(LAS unsigned char* lds, const bf16_t* __restrict__ A, const bf16_t* __restrict__ Bt, int K, int tm, int tn, const Epi& E) {
    const int tid = threadIdx.x, wid = tid >> 6, lane = tid & 63, fr = lane & 15, fq = lane >> 4;
    const int row0 = NPTOK + tm * 64, col0 = tn * 64;
    const bf16_t* Ab = A + (size_t)row0 * K + (size_t)(tid >> 5) * K + (tid & 31) * 8; const bf16_t* Bb = Bt + (size_t)col0 * K + (size_t)(tid >> 5) * K + (tid & 31) * 8;
    const int loff = (tid >> 5) * 512 + (((tid & 31) ^ ((tid >> 5) & 15)) << 4);
    u32x4 ra[4], rb[4];
    f32x4 acc[2]; acc[0] = (f32x4){0.f, 0.f, 0.f, 0.f}; acc[1] = acc[0];
    const int nk = K >> 8;
#pragma unroll
    for (int i = 0; i < 4; ++i) { ra[i] = *(const u32x4*)(Ab + (size_t)(16 * i) * K); rb[i] = *(const u32x4*)(Bb + (size_t)(16 * i) * K); }
    __syncthreads();
#pragma unroll
    for (int i = 0; i < 4; ++i) { *(LAS u32x4*)(lds + loff + i * 8192) = ra[i]; *(LAS u32x4*)(lds + 32768 + loff + i * 8192) = rb[i]; }
    __syncthreads();
    const int arow = (wid & 3) * 16 + fr, brow = (wid >> 2) * 32 + fr;
    for (int t = 0; t < nk; ++t) {
        const int buf = (t & 1) * 65536;
        if (t + 1 < nk) {
#pragma unroll
            for (int i = 0; i < 4; ++i) { ra[i] = *(const u32x4*)(Ab + (size_t)(16 * i) * K + (t + 1) * 256); rb[i] = *(const u32x4*)(Bb + (size_t)(16 * i) * K + (t + 1) * 256); } }
#pragma unroll
        for (int kk = 0; kk < 8; ++kk) { const int sw = ((kk * 4 + fq) ^ fr) << 4;
            const bf16x8 a = *(const LAS bf16x8*)(lds + buf + arow * 512 + sw);
#pragma unroll
            for (int s2 = 0; s2 < 2; ++s2) { const bf16x8 bb = *(const LAS bf16x8*)(lds + buf + 32768 + (brow + s2 * 16) * 512 + sw); acc[s2] = __builtin_amdgcn_mfma_f32_16x16x32_bf16(bb, a, acc[s2], 0, 0, 0); } }
        if (t + 1 < nk) {
#pragma unroll
            for (int i = 0; i < 4; ++i) { *(LAS u32x4*)(lds + (buf ^ 65536) + loff + i * 8192) = ra[i]; *(LAS u32x4*)(lds + (buf ^ 65536) + 32768 + loff + i * 8192) = rb[i]; } }
        __syncthreads();
    }
#pragma unroll
    for (int s2 = 0; s2 < 2; ++s2) E.small4(row0 + arow, col0 + (wid >> 2) * 32 + s2 * 16 + fq * 4, acc[s2]);
}
#define XB_TMO      128
#define XB_XCNT(j)  (256  + 64 * (j))
#define XB_XSUB(j)  (1280 + 64 * (j))
#define XB_XGEN(j)  (2304 + 64 * (j))
#define XB_TOP      3328
#define XB_TOPGEN   3392
#define XCD_BAR_WORDS 3456
#define XB_SPIN_CAP (1u << 18)

__device__ __forceinline__ unsigned xb_ld(unsigned* p)              { return __hip_atomic_load(p, __ATOMIC_RELAXED, __HIP_MEMORY_SCOPE_AGENT); }
__device__ __forceinline__ unsigned xb_add(unsigned* p, unsigned v) { return __hip_atomic_fetch_add(p, v, __ATOMIC_RELAXED, __HIP_MEMORY_SCOPE_AGENT); }
__device__ __forceinline__ unsigned xb_xcc_id() { return (unsigned)__builtin_amdgcn_s_getreg((3 << 11) | 20) & 0xFu; }
#define XB_SPIN(cond, bar) do { unsigned _sp = 0; while (cond) { __builtin_amdgcn_s_sleep(1); \
    if ((++_sp & 255u) == 0u) { if (xb_ld(&(bar)[XB_TMO])) break; if (_sp > XB_SPIN_CAP) { atomicAdd(&(bar)[XB_TMO], 1u); break; } } } } while (0)

struct XcdBarrier {
    unsigned* bar; unsigned x;
    volatile LAS unsigned* st;
};

__device__ __forceinline__ XcdBarrier xcd_barrier_post(unsigned* bar, volatile LAS unsigned* st) {
    XcdBarrier b; b.bar = bar; b.x = xb_xcc_id(); b.st = st;
    if (threadIdx.x == 0) (void)xb_add(&bar[XB_XCNT(b.x)], 1u);
    return b;
}
__device__ __forceinline__ void xcd_barrier_complete(unsigned* bar, unsigned x, unsigned& nloc, unsigned& nx) {
    const unsigned G = gridDim.x * gridDim.y * gridDim.z;
    unsigned sum, cnt, mine, sp = 0u;
    for (;;) {
        sum = 0u; cnt = 0u; mine = 0u;
#pragma unroll
        for (unsigned j = 0; j < 16; ++j) { const unsigned c = xb_ld(&bar[XB_XCNT(j)]); sum += c; cnt += (c > 0u) ? 1u : 0u; mine = (j == x) ? c : mine; }
        if (sum == G) break;
        __builtin_amdgcn_s_sleep(1);
        if ((++sp & 255u) == 0u) { if (xb_ld(&bar[XB_TMO])) break; if (sp > XB_SPIN_CAP) { atomicAdd(&bar[XB_TMO], 1u); break; } }
    }
    nloc = mine > 0u ? mine : 1u; nx = cnt > 0u ? cnt : 1u;
}

__device__ __forceinline__ void xcd_barrier(const XcdBarrier& b) {
    asm volatile("s_waitcnt vmcnt(0)" ::: "memory");
    __syncthreads();
    if (threadIdx.x == 0) {
        unsigned* bar = b.bar;
        __builtin_amdgcn_s_waitcnt(0);
        unsigned nloc = b.st[0], nx = b.st[1];
        if (nloc == 0u) { xcd_barrier_complete(bar, b.x, nloc, nx); b.st[0] = nloc; b.st[1] = nx; }
        const unsigned old = xb_add(&bar[XB_XSUB(b.x)], 1u);
        const unsigned gen = old / nloc;
        if (old + 1u == (gen + 1u) * nloc) {
            __builtin_amdgcn_fence(__ATOMIC_RELEASE, "agent");
            asm volatile("s_waitcnt vmcnt(0)" ::: "memory");
            const unsigned og = xb_add(&bar[XB_TOP], 1u);
            const unsigned tg = og / nx;
            if (og + 1u == (tg + 1u) * nx) xb_add(&bar[XB_TOPGEN], 1u);
            else XB_SPIN(xb_ld(&bar[XB_TOPGEN]) == tg, bar);
            __builtin_amdgcn_fence(__ATOMIC_ACQUIRE, "agent");
            xb_add(&bar[XB_XGEN(b.x)], 1u);
            asm volatile("s_waitcnt vmcnt(0)" ::: "memory");
        } else {
            XB_SPIN(xb_ld(&bar[XB_XGEN(b.x)]) == gen, bar);
            __builtin_amdgcn_fence(__ATOMIC_ACQUIRE, "agent");
            asm volatile("s_waitcnt vmcnt(0)" ::: "memory");
        }
    }

    __syncthreads();
}
constexpr int N_PHASES = 12;
template <int PH> __device__ __forceinline__ void run_phase(const Params& p, LAS unsigned char* lds) {
    unsigned char* ws = p.ws; const int G = gridDim.x, bid = blockIdx.x;
    float* mod = (float*)(ws + WS_MOD);
    if constexpr (PH == 0) phase_prep<0>(p, lds, G, bid);
    else if constexpr (PH == 1) {
        const int NA = NMODC / 256;
        if (G > 2 * NA) {
            if (bid < NA) { pg8::Gemm g{(const bf16_t*)(ws + WS_CACT), (const bf16_t*)(ws + WS_WADA), 256, NMODC, DM}; pg8::StaticOrder S; S.init(256, NMODC, NA, bid); EpiAda E{mod, p.in[7]}; pg8::gemm_phase(lds, g, S, E); }
            else phase_prep<1>(p, lds, G - NA, bid - NA);
        } else { phase_prep<1>(p, lds, G, bid); pg8::Gemm g{(const bf16_t*)(ws + WS_CACT), (const bf16_t*)(ws + WS_WADA), 256, NMODC, DM}; pg8::StaticOrder S; S.init(256, NMODC, G, bid); EpiAda E{mod, p.in[7]}; pg8::gemm_phase(lds, g, S, E); }
    }
    else if constexpr (PH == 2) phase_u(p);
    else if constexpr (PH == 3) { pg8::Gemm g{(const bf16_t*)(p.out + O_HS), (const bf16_t*)(ws + WS_WIN), NTOK, DIN, DM}; pg8::StaticOrder S; S.init(NTOK, DIN, G, bid);
        EpiZ E{p.out, (bf16_t*)(ws + WS_QS), (bf16_t*)(ws + WS_ZF), (bf16_t*)(ws + WS_VV), (bf16_t*)(ws + WS_OG), (bf16_t*)((unsigned char*)p.out + S35), (bf16_t*)(ws + WS_GB), p.in[12]};
        pg8::gemm_phase(lds, g, S, E); }
    else if constexpr (PH == 4) { phase_pool(p);
        for (int it = bid; it < NBP * NH * (NSEG - 1); it += G) hgrn_item<false>(p, lds, it / (NH * (NSEG - 1)), (it / (NSEG - 1)) % NH, it % (NSEG - 1)); }
    else if constexpr (PH == 5) {
        for (int it = bid; it < NBP * NH * NSEG + NBS * NH; it += G) {
            if (it < NBP * NH * NSEG) hgrn_item<true>(p, lds, it / (NH * NSEG), (it / NSEG) % NH, it % NSEG);
            else { const int s = it - NBP * NH * NSEG; hgrn_sample_item(p, lds, s >> 3, s & 7); } } }
    else if constexpr (PH == 6) { pg8::StaticOrder S; S.init(NPTOK, DM, G, bid);
        const EpiP EP{(float*)(ws + WS_QS), (const bf16_t*)((unsigned char*)p.out + S35)}; const EpiM EM{(const float*)(ws + WS_QS), (const bf16_t*)(ws + WS_GB), (bf16_t*)(ws + WS_VV)};
        { pg8::Gemm g{(const bf16_t*)(ws + WS_DMB), (const bf16_t*)(ws + WS_WEFF), NPTOK, DM, DPOOL}; pg8::gemm_phase(lds, g, S, EP); }
        { pg8::Gemm g{(const bf16_t*)p.out, (const bf16_t*)(ws + WS_WB), NPTOK, DM, DM}; pg8::gemm_phase(lds, g, S, EM); }
        for (int it = bid; it < 256; it += G) { small_gemm(lds, (const bf16_t*)(ws + WS_DMB), (const bf16_t*)(ws + WS_WEFF), DPOOL, it >> 4, it & 15, EP);
            small_gemm(lds, (const bf16_t*)p.out, (const bf16_t*)(ws + WS_WB), DM, it >> 4, it & 15, EM); } }
    else if constexpr (PH == 7) { pg8::Gemm g{(const bf16_t*)(ws + WS_VV), (const bf16_t*)(ws + WS_WOUT), NPTOK, DM, DM}; pg8::StaticOrder S; S.init(NPTOK, DM, G, bid);
        const EpiRes E{p.in[0], p.in[1], mod, 2 * DM, p.out}; pg8::gemm_phase(lds, g, S, E);
        for (int it = bid; it < 256; it += G) small_gemm(lds, (const bf16_t*)(ws + WS_VV), (const bf16_t*)(ws + WS_WOUT), DM, it >> 4, it & 15, E); }
    else if constexpr (PH == 8) phase_ln<true>(p);
    else if constexpr (PH == 9) { pg8::Gemm g{(const bf16_t*)(ws + WS_OG), (const bf16_t*)(ws + WS_WGU), NTOK, 2 * DFF, DM}; pg8::StaticOrder S; S.init(NTOK, 2 * DFF, G, bid);
        EpiGU E{(bf16_t*)(ws + WS_VV)}; pg8::gemm_phase(lds, g, S, E); }
    else if constexpr (PH == 10) { pg8::Gemm g{(const bf16_t*)(ws + WS_VV), (const bf16_t*)(ws + WS_WDN), NPTOK, DM, DFF}; pg8::StaticOrder S; S.init(NPTOK, DM, G, bid);
        const float* x1 = (const float*)(ws + WS_QS); const EpiRes E{x1, x1 + (size_t)NPTOK * DM, mod, 5 * DM, p.out}; pg8::gemm_phase(lds, g, S, E);
        for (int it = bid; it < 256; it += G) small_gemm(lds, (const bf16_t*)(ws + WS_VV), (const bf16_t*)(ws + WS_WDN), DFF, it >> 4, it & 15, E); }
    else phase_ln<false>(p);
}
#if N_LAUNCH_MODE == 0
#define RUN_PHASE(PH) { const __attribute__((address_space(4))) Params* q_ = kp; asm volatile("" : "+s"(q_)); const Params lp_ = *(const Params*)q_; run_phase<PH>(lp_, lds); }
#define PHASE_SYNC(PH) RUN_PHASE(PH) xcd_barrier(xb);
__global__ __launch_bounds__(512, 2) void mega(Params p) {
    extern __shared__ __attribute__((aligned(16))) unsigned char shm[];
    LAS unsigned char* lds = (LAS unsigned char*)shm;
#if defined(__HIP_DEVICE_COMPILE__)
    cg::grid_group grid = cg::this_grid();
    const __attribute__((address_space(4))) Params* kp = (const __attribute__((address_space(4))) Params*)__builtin_amdgcn_kernarg_segment_ptr();
    LAS unsigned* stw = (LAS unsigned*)(lds + 131072);
    if (threadIdx.x == 0) { stw[0] = 0u; stw[1] = 0u; stw[2] = 0u; stw[3] = 0u; }
    __syncthreads();
    const XcdBarrier xb = xcd_barrier_post((unsigned*)(p.ws + WS_BAR), (volatile LAS unsigned*)stw);
    if (kp->ws == nullptr) grid.sync();
    PHASE_SYNC(0)
    PHASE_SYNC(1) PHASE_SYNC(2) PHASE_SYNC(3) PHASE_SYNC(4) PHASE_SYNC(5) PHASE_SYNC(6) PHASE_SYNC(7) PHASE_SYNC(8) PHASE_SYNC(9) PHASE_SYNC(10)
    RUN_PHASE(11)
#endif
}
#else
template <int PH> __global__ __launch_bounds__(512, 2) void mega(Params p) {
    extern __shared__ __attribute__((aligned(16))) unsigned char shm[];
    run_phase<PH>(p, (LAS unsigned char*)shm);
}
template <int PH> static void launch_phase(const Params& p, int grid, hipStream_t stream) {
    static bool attr = false;
    if (!attr) { (void)hipFuncSetAttribute((const void*)mega<PH>, hipFuncAttributeMaxDynamicSharedMemorySize, LDS_BYTES); attr = true; }
    hipLaunchKernelGGL(mega<PH>, dim3(grid), dim3(512), LDS_BYTES, stream, p);
}
#endif

extern "C" void kernel_launch(void* const* d_in, const int* in_sizes, int n_in, void* d_out, int out_size, void* d_ws, size_t ws_size, hipStream_t stream) {
    static int grid_blocks = 0;
    if (!grid_blocks) {
        int dev = 0, cus = 0, per_cu = 0;
        (void)hipGetDevice(&dev); (void)hipDeviceGetAttribute(&cus, hipDeviceAttributeMultiprocessorCount, dev);
#if N_LAUNCH_MODE == 0
        if (hipFuncSetAttribute((const void*)mega, hipFuncAttributeMaxDynamicSharedMemorySize, LDS_BYTES) != hipSuccess) fprintf(stderr, "hipFuncSetAttribute failed\n");
        if (hipOccupancyMaxActiveBlocksPerMultiprocessor(&per_cu, (const void*)mega, 512, LDS_BYTES) != hipSuccess || per_cu < 1) { fprintf(stderr, "occupancy query: %d\n", per_cu); per_cu = 1; }
        (void)hipGetLastError();
#else
        per_cu = 1;
#endif
        grid_blocks = cus * per_cu;
        if (ws_size < WS_BAR + 16384 || n_in != 23) fprintf(stderr, "kernel_launch: ws_size %zu < %zu or n_in %d != 23\n", ws_size, (size_t)WS_NEED, n_in);
    }
    Params p{};
    for (int i = 0; i < 23; ++i) p.in[i] = (const float*)d_in[i];
    p.out = (float*)d_out; p.ws = (unsigned char*)d_ws;
#if N_LAUNCH_MODE == 0
    (void)hipMemsetAsync((unsigned char*)d_ws + WS_BAR, 0, XCD_BAR_WORDS * sizeof(unsigned), stream);
    void* args[] = {&p};
    hipError_t e = hipLaunchCooperativeKernel((const void*)mega, dim3(grid_blocks), dim3(512), args, LDS_BYTES, stream);
    if (e != hipSuccess) fprintf(stderr, "cooperative launch failed: %s (grid %d)\n", hipGetErrorString(e), grid_blocks);
#else
    launch_phase<0>(p, grid_blocks, stream); launch_phase<1>(p, grid_blocks, stream); launch_phase<2>(p, grid_blocks, stream); launch_phase<3>(p, grid_blocks, stream);
    launch_phase<4>(p, grid_blocks, stream); launch_phase<5>(p, grid_blocks, stream); launch_phase<6>(p, grid_blocks, stream); launch_phase<7>(p, grid_blocks, stream);
    launch_phase<8>(p, grid_blocks, stream); launch_phase<9>(p, grid_blocks, stream); launch_phase<10>(p, grid_blocks, stream); launch_phase<11>(p, grid_blocks, stream);
#endif
}
```

```cpp
#include <hip/hip_runtime.h>
#include <hip/hip_cooperative_groups.h>
#include <cstdio>
namespace cg = cooperative_groups;

#ifndef N_LAUNCH_MODE
#define N_LAUNCH_MODE 0
#endif

constexpr int DM = 1024, NTOK = 17408, NPTOK = 16384, SEQ = 2048, NBP = 8, NBS = 128, DSEQ = 8;
constexpr int DIN = 6656, DFF = 2816, DPOOL = 512, NH = 8, HD = 128, PBUF = 15, NMODC = 6144;
constexpr float ALPHA = 1.1892071150027210f;
constexpr float LN_EPS = 1e-5f, RMS_EPS = 1e-6f;
constexpr int NSEG = 4, SEGLEN = SEQ / NSEG, CH = 64, NCHSEG = SEGLEN / CH;
constexpr size_t O_YP = 0, O_YS = 16777216, O_PP = 17825792, O_HP = 17887232, O_PS = 18935808, O_HS = 19918848;
constexpr size_t S35 = 35651584;
constexpr size_t WS_WIN = 0, WS_WADA = 13631488, WS_WEFF = 26214400, WS_WB = 27262976, WS_WOUT = 29360128, WS_WGU = 31457280,
                 WS_WDN = 42991616, WS_CACT = 48758784, WS_MOD = 49283072, WS_QS = 55574528, WS_ZF = WS_QS + S35, WS_OG = WS_ZF + S35,
                 WS_VV = WS_OG + S35, WS_GB = WS_VV + S35, WS_DMB = WS_GB + S35, WS_NEED = WS_VV + 98041856;
constexpr size_t WS_SLOC = 0, WS_SDEC = 16777216;
constexpr int LDS_BYTES = 131072 + 16;
constexpr size_t WS_BAR = 260571136;
#define DIAG 0
#if DIAG
#define DG(x) (x)
#else
#define DG(x) 1.0f
#endif

struct Params {
    const float* in[23];
    float* out;
    unsigned char* ws;
};
namespace pg8 {
#define PG8_LAS __attribute__((address_space(3)))
typedef unsigned short bf16_t;
typedef short bf16x8 __attribute__((ext_vector_type(8)));
typedef float f32x4 __attribute__((ext_vector_type(4)));
typedef unsigned u32x4 __attribute__((ext_vector_type(4)));
typedef unsigned u32x2 __attribute__((ext_vector_type(2)));
constexpr int BM = 256, BK = 64, HALF = 128, HTB = HALF * BK * 2, STAGE_BYTES = 8 * HTB, NXCD = 8, WGM = 8;
__host__ __device__ __forceinline__ int lds_byte(int r, int c) { const int st = (r >> 4) * 2 + (c >> 5), rr = r & 15, cc = c & 31, ob = rr * 64 + cc * 2; return st * 1024 + (ob ^ (((ob >> 9) & 1) << 5)); }
__host__ __device__ __forceinline__ void stage_rc(int b, int& R, int& C) { const int st = b / 1024, sb = b % 1024, swz = sb ^ (((sb >> 9) & 1) << 5); R = (st >> 1) * 16 + swz / 64; C = (st & 1) * 32 + (swz % 64) / 2; }
__host__ __device__ __forceinline__ int perm32(int rho) { const int n = rho >> 4, i = rho & 15; return 8 * (i >> 2) + 4 * n + (i & 3); }
struct Unit { int pm, pn; };
struct Gemm { const bf16_t* A; const bf16_t* Bt; int M, N, K; };
struct StaticOrder {
    int nM, nN, nwg, G, c;
    __host__ __device__ void init(int M, int N, int G_, int c_) { nM = M / BM; nN = N / BM; nwg = nM * nN; G = G_; c = c_; }
    __host__ __device__ bool next(int i, Unit& u) const {
        const long L = (long)i * G + c; if (L >= nwg) return false;
        int wgid = (int)L; { const int q = nwg / NXCD, r = nwg % NXCD, xcd = wgid % NXCD, off = wgid / NXCD; wgid = (xcd < r ? xcd * (q + 1) : r * (q + 1) + (xcd - r) * q) + off; }
        const int nig = WGM * nN, gid = wgid / nig, fm = gid * WGM, gsz = (nM - fm) < WGM ? (nM - fm) : WGM;
        u.pm = fm + ((wgid % nig) % gsz); u.pn = (wgid % nig) / gsz; return true;
    }
    __device__ __forceinline__ void a_ready(const Unit&) const {}
    __device__ __forceinline__ void done(const Unit&) const {}
};
__device__ __forceinline__ unsigned cvt_pk_bf16(float lo, float hi) { unsigned r; asm volatile("v_cvt_pk_bf16_f32 %0, %1, %2" : "=v"(r) : "v"(lo), "v"(hi)); return r; }
template <class Epi, class Sched>
__device__ __forceinline__ void gemm_phase(PG8_LAS unsigned char* lds, const Gemm g, const Sched& S, const Epi& E) {
    const int tid = threadIdx.x, wid = __builtin_amdgcn_readfirstlane(tid >> 6), lane = tid & 63, wr = wid >> 2, wc = wid & 3, fr = lane & 15, fq = lane >> 4;
    const int K = g.K, nt = K / BK;
    unsigned voffA[2], voffB[2];
#pragma unroll
    for (int i = 0; i < 2; ++i) { int R, C; stage_rc(tid * 16 + i * 8192, R, C); const int Rb = Epi::PERM ? ((R & ~31) + perm32(R & 31)) : R;
        voffA[i] = (unsigned)(R * K + C) * 2u; voffB[i] = (unsigned)(Rb * K + C) * 2u; }
    const size_t kstep = (size_t)(BK * 2);
    const size_t hstep = (size_t)HALF * K * 2;
    const size_t tstep = 2 * hstep;
    const unsigned ldsw = (unsigned)wid * 1024u;
    const int aoff = lds_byte(wr * 64 + fr, fq * 8), boff = lds_byte(wc * 32 + fr, fq * 8);
#define PG8_SA(b, h) (((b) * 2 + (h)) * HTB)
#define PG8_SB(b, h) ((4 + (b) * 2 + (h)) * HTB)
#define PG8_STAGE(bufoff, gbase, voff) do { _Pragma("unroll") for (int _i = 0; _i < 2; ++_i) \
        __builtin_amdgcn_global_load_lds((const unsigned*)((const char*)(gbase) + (voff)[_i]), (PG8_LAS unsigned*)(lds + (bufoff) + ldsw + _i * 8192), 16, 0, 0); } while (0)
#define PG8_LDA(dst, b, h) do { _Pragma("unroll") for (int m = 0; m < 4; ++m) _Pragma("unroll") for (int k = 0; k < 2; ++k) dst[m][k] = *(const PG8_LAS bf16x8*)(lds + PG8_SA(b, h) + aoff + m * 2048 + k * 1024); } while (0)
#define PG8_LDB(dst, b, h) do { _Pragma("unroll") for (int n = 0; n < 2; ++n) _Pragma("unroll") for (int k = 0; k < 2; ++k) dst[n][k] = *(const PG8_LAS bf16x8*)(lds + PG8_SB(b, h) + boff + n * 2048 + k * 1024); } while (0)
#define PG8_MMA(ai, bj, At, Bt) do { __builtin_amdgcn_s_setprio(1); _Pragma("unroll") for (int m = 0; m < 4; ++m) _Pragma("unroll") for (int n = 0; n < 2; ++n) _Pragma("unroll") for (int k = 0; k < 2; ++k) \
        acc[ai][bj][m][n] = __builtin_amdgcn_mfma_f32_16x16x32_bf16(Bt[n][k], At[m][k], acc[ai][bj][m][n], 0, 0, 0); __builtin_amdgcn_s_setprio(0); } while (0)
#define PG8_WAIT_V(n) asm volatile("s_waitcnt vmcnt(" #n ")" ::: "memory")
#define PG8_WAIT_L(n) asm volatile("s_waitcnt lgkmcnt(" #n ")" ::: "memory")
#define PG8_BAR __builtin_amdgcn_s_barrier()
#define PG8_SCHED __builtin_amdgcn_sched_barrier(0)
    Unit cur, nxt; int ui = 0;
    if (!S.next(0, cur)) return;
    f32x4 acc[2][2][4][2];
#pragma unroll
    for (int a = 0; a < 2; ++a)
#pragma unroll
        for (int b = 0; b < 2; ++b)
#pragma unroll
            for (int m = 0; m < 4; ++m)
#pragma unroll
                for (int n = 0; n < 2; ++n) acc[a][b][m][n] = (f32x4){0.f, 0.f, 0.f, 0.f};
    bf16x8 At[4][2], B0[2][2], B1[2][2];
    const char* cA = (const char*)g.A + (size_t)cur.pm * tstep; const char* cB = (const char*)g.Bt + (size_t)cur.pn * tstep;
    S.a_ready(cur);
    PG8_STAGE(PG8_SB(0, 0), cB, voffB); PG8_STAGE(PG8_SA(0, 0), cA, voffA); PG8_STAGE(PG8_SB(0, 1), cB + hstep, voffB); PG8_STAGE(PG8_SA(0, 1), cA + hstep, voffA);
    if (wr == 1) PG8_BAR;
    PG8_WAIT_V(4); PG8_BAR;
    PG8_STAGE(PG8_SB(1, 0), cB + kstep, voffB); PG8_STAGE(PG8_SA(1, 0), cA + kstep, voffA); PG8_STAGE(PG8_SB(1, 1), cB + hstep + kstep, voffB);
    PG8_WAIT_V(6); PG8_BAR;
    for (;;) {
        const bool has_next = S.next(ui + 1, nxt);
        const char* nA = has_next ? (const char*)g.A + (size_t)nxt.pm * tstep : cA; const char* nB = has_next ? (const char*)g.Bt + (size_t)nxt.pn * tstep : cB;
        for (int t = 0; t < nt; t += 2) {
            const bool last = (t == nt - 2);
            const char* a1 = cA + (size_t)(t + 1) * kstep;
            const char* a2 = last ? nA : cA + (size_t)(t + 2) * kstep; const char* b2 = last ? nB : cB + (size_t)(t + 2) * kstep;
            const char* a3 = a2 + kstep; const char* b3 = b2 + kstep;
            if (last && has_next) S.a_ready(nxt);
            PG8_LDB(B0, 0, 0); PG8_SCHED; PG8_LDA(At, 0, 0); PG8_STAGE(PG8_SA(1, 1), a1 + hstep, voffA);
            PG8_WAIT_L(8); PG8_BAR; PG8_WAIT_L(0); PG8_MMA(0, 0, At, B0); PG8_BAR; PG8_SCHED;
            PG8_LDB(B1, 0, 1); PG8_STAGE(PG8_SB(0, 0), b2, voffB);
            PG8_BAR; PG8_WAIT_L(0); PG8_MMA(0, 1, At, B1); PG8_BAR;
            PG8_LDA(At, 0, 1); PG8_STAGE(PG8_SA(0, 0), a2, voffA);
            PG8_BAR; PG8_WAIT_L(0); PG8_MMA(1, 0, At, B0); PG8_BAR; PG8_SCHED;
            PG8_STAGE(PG8_SB(0, 1), b2 + hstep, voffB);
            PG8_WAIT_V(6); PG8_BAR; PG8_MMA(1, 1, At, B1); PG8_BAR;
            PG8_LDB(B0, 1, 0); PG8_SCHED; PG8_LDA(At, 1, 0); PG8_STAGE(PG8_SA(0, 1), a2 + hstep, voffA);
            PG8_WAIT_L(8); PG8_BAR; PG8_WAIT_L(0); PG8_MMA(0, 0, At, B0); PG8_BAR; PG8_SCHED;
            PG8_LDB(B1, 1, 1); PG8_STAGE(PG8_SB(1, 0), b3, voffB);
            PG8_BAR; PG8_WAIT_L(0); PG8_MMA(0, 1, At, B1); PG8_BAR;
            PG8_LDA(At, 1, 1); PG8_STAGE(PG8_SA(1, 0), a3, voffA);
            PG8_BAR; PG8_WAIT_L(0); PG8_MMA(1, 0, At, B0); PG8_BAR; PG8_SCHED;
            PG8_STAGE(PG8_SB(1, 1), b3 + hstep, voffB);
            PG8_WAIT_V(6); PG8_BAR; PG8_MMA(1, 1, At, B1); PG8_BAR;
        }
        if constexpr (!Epi::AFTER_DRAIN) { E(acc, cur, wr, wc, fr, fq); S.done(cur); }
        if (!has_next) break;
#pragma unroll
        for (int a = 0; a < 2; ++a)
#pragma unroll
            for (int b = 0; b < 2; ++b)
#pragma unroll
                for (int m = 0; m < 4; ++m)
#pragma unroll
                    for (int n = 0; n < 2; ++n) acc[a][b][m][n] = (f32x4){0.f, 0.f, 0.f, 0.f};
        cur = nxt; cA = nA; cB = nB; ++ui;
    }
    PG8_WAIT_V(0);
    if (wr == 0) PG8_BAR;
    PG8_BAR;
    if constexpr (Epi::AFTER_DRAIN) { E.fused(acc, cur, wr, wc, fr, fq, lds, wid, lane); S.done(cur); }
#undef PG8_SA
#undef PG8_SB
#undef PG8_STAGE
#undef PG8_LDA
#undef PG8_LDB
#undef PG8_MMA
#undef PG8_WAIT_V
#undef PG8_WAIT_L
#undef PG8_BAR
#undef PG8_SCHED
}
}

using pg8::bf16_t; using pg8::bf16x8; using pg8::f32x4; using pg8::u32x4; using pg8::u32x2; using pg8::cvt_pk_bf16;
#define LAS __attribute__((address_space(3)))

__device__ __forceinline__ float sigm(float x) { return __builtin_amdgcn_rcpf(1.f + __expf(-x)); }
__device__ __forceinline__ float silu_(float x) { return x * sigm(x); }
__device__ __forceinline__ float bf2f(unsigned b) { return __uint_as_float(b << 16); }
__device__ __forceinline__ bf16_t f2bf(float f) { unsigned u = __float_as_uint(f); u += 0x7FFFu + ((u >> 16) & 1u); return (bf16_t)(u >> 16); }
__device__ __forceinline__ int mrow_of(int tok) { return tok < NPTOK ? (tok >> 11) : 8 + ((tok - NPTOK) >> 3); }
__device__ __forceinline__ u32x4 pack8(const f32x4 a, const f32x4 b) { u32x4 r; r[0] = cvt_pk_bf16(a[0], a[1]); r[1] = cvt_pk_bf16(a[2], a[3]); r[2] = cvt_pk_bf16(b[0], b[1]); r[3] = cvt_pk_bf16(b[2], b[3]); return r; }
__device__ __forceinline__ void unpack8(const u32x4 r, f32x4& a, f32x4& b) {
    a[0] = bf2f(r[0] & 0xffffu); a[1] = __uint_as_float(r[0] & 0xffff0000u); a[2] = bf2f(r[1] & 0xffffu); a[3] = __uint_as_float(r[1] & 0xffff0000u);
    b[0] = bf2f(r[2] & 0xffffu); b[1] = __uint_as_float(r[2] & 0xffff0000u); b[2] = bf2f(r[3] & 0xffffu); b[3] = __uint_as_float(r[3] & 0xffff0000u); }

__device__ __forceinline__ f32x4 unpack4(const u32x2 g) { f32x4 r; r[0] = bf2f(g[0] & 0xffffu); r[1] = __uint_as_float(g[0] & 0xffff0000u); r[2] = bf2f(g[1] & 0xffffu); r[3] = __uint_as_float(g[1] & 0xffff0000u); return r; }
__device__ __forceinline__ u32x2 pack4(const f32x4 t) { u32x2 o; o[0] = cvt_pk_bf16(t[0], t[1]); o[1] = cvt_pk_bf16(t[2], t[3]); return o; }
#define EPI_LOOP_ROWS _Pragma("unroll") for (int ai = 0; ai < 2; ++ai) _Pragma("unroll") for (int m = 0; m < 4; ++m)
struct EpiAda {
    static constexpr bool PERM = false, AFTER_DRAIN = false;
    float* C; const float* bias;
    __device__ __forceinline__ void operator()(const f32x4 (&acc)[2][2][4][2], const pg8::Unit& u, int wr, int wc, int fr, int fq) const {
        const int row0 = u.pm * 256 + wr * 64 + fr, col0 = u.pn * 256 + wc * 32 + 4 * fq;
        EPI_LOOP_ROWS { float* rowp = C + (size_t)(row0 + ai * 128 + m * 16) * NMODC + col0;
#pragma unroll
            for (int bj = 0; bj < 2; ++bj)
#pragma unroll
                for (int n = 0; n < 2; ++n) *(f32x4*)(rowp + bj * 128 + n * 16) = acc[ai][bj][m][n] + *(const f32x4*)(bias + col0 + bj * 128 + n * 16); }
    }
};
struct EpiZ {
    static constexpr bool PERM = true, AFTER_DRAIN = false;
    float* zp; bf16_t *qs, *zf, *vv, *og, *ga, *gb; const float* nw;
    __device__ __forceinline__ void operator()(const f32x4 (&acc)[2][2][4][2], const pg8::Unit& u, int wr, int wc, int fr, int fq) const {
        const int row0 = u.pm * 256 + wr * 64 + fr;
        if (u.pn < 2) {
            const int col0 = u.pn * 256 + wc * 32 + 8 * fq;
            EPI_LOOP_ROWS { float* rowp = zp + (size_t)(row0 + ai * 128 + m * 16) * DPOOL + col0;
#pragma unroll
                for (int bj = 0; bj < 2; ++bj) { *(f32x4*)(rowp + bj * 128) = acc[ai][bj][m][0]; *(f32x4*)(rowp + bj * 128 + 4) = acc[ai][bj][m][1]; } }
            return;
        }
        const int seg = (u.pn - 2) >> 2, col0 = ((u.pn - 2) & 3) * 256 + wc * 32 + 8 * fq;
        bf16_t* dst = seg == 0 ? qs : seg == 1 ? zf : seg == 2 ? vv : seg == 3 ? og : seg == 4 ? ga : gb;
        f32x4 w0[2], w1[2];
#pragma unroll
        for (int bj = 0; bj < 2; ++bj) { w0[bj] = (f32x4){1.f, 1.f, 1.f, 1.f}; w1[bj] = w0[bj]; if (seg == 3) { w0[bj] = *(const f32x4*)(nw + col0 + bj * 128); w1[bj] = *(const f32x4*)(nw + col0 + bj * 128 + 4); } }
        EPI_LOOP_ROWS { bf16_t* rowp = dst + (size_t)(row0 + ai * 128 + m * 16) * DM + col0;
#pragma unroll
            for (int bj = 0; bj < 2; ++bj) { f32x4 v0 = acc[ai][bj][m][0], v1 = acc[ai][bj][m][1];
                if (seg == 0 || seg == 3) {
#pragma unroll
                    for (int i = 0; i < 4; ++i) { v0[i] = silu_(v0[i]) * w0[bj][i]; v1[i] = silu_(v1[i]) * w1[bj][i]; }
                } else if (seg >= 4) {
#pragma unroll
                    for (int i = 0; i < 4; ++i) { v0[i] = sigm(v0[i]); v1[i] = sigm(v1[i]); }
                }
                *(u32x4*)(rowp + bj * 128) = pack8(v0, v1); } }
    }
};
struct EpiP {
    static constexpr bool PERM = true, AFTER_DRAIN = false;
    bf16_t* tmp; const bf16_t* ga;
    __device__ __forceinline__ void small4(int row, int col, const f32x4 v) const { const size_t ro = (size_t)row * DM + col; *(u32x2*)(tmp + ro) = pack4(v * unpack4(*(const u32x2*)(ga + ro))); }
    __device__ __forceinline__ void operator()(const f32x4 (&acc)[2][2][4][2], const pg8::Unit& u, int wr, int wc, int fr, int fq) const {
        const int row0 = u.pm * 256 + wr * 64 + fr, col0 = u.pn * 256 + wc * 32 + 8 * fq;
        EPI_LOOP_ROWS { const size_t ro = (size_t)(row0 + ai * 128 + m * 16) * DM + col0;
#pragma unroll
            for (int bj = 0; bj < 2; ++bj) { f32x4 g0, g1; unpack8(*(const u32x4*)(ga + ro + bj * 128), g0, g1);
                *(u32x4*)(tmp + ro + bj * 128) = pack8(acc[ai][bj][m][0] * g0, acc[ai][bj][m][1] * g1); } }
    }
};
struct EpiM {
    static constexpr bool PERM = true, AFTER_DRAIN = false;
    const bf16_t* tmp; const bf16_t* gb; bf16_t* mrg;
    __device__ __forceinline__ void small4(int row, int col, const f32x4 v) const { const size_t ro = (size_t)row * DM + col;
        *(u32x2*)(mrg + ro) = pack4(unpack4(*(const u32x2*)(tmp + ro)) + v * unpack4(*(const u32x2*)(gb + ro))); }
    __device__ __forceinline__ void operator()(const f32x4 (&acc)[2][2][4][2], const pg8::Unit& u, int wr, int wc, int fr, int fq) const {
        const int row0 = u.pm * 256 + wr * 64 + fr, col0 = u.pn * 256 + wc * 32 + 8 * fq;
        EPI_LOOP_ROWS { const size_t ro = (size_t)(row0 + ai * 128 + m * 16) * DM + col0;
#pragma unroll
            for (int bj = 0; bj < 2; ++bj) { f32x4 g0, g1, t0, t1; unpack8(*(const u32x4*)(gb + ro + bj * 128), g0, g1); unpack8(*(const u32x4*)(tmp + ro + bj * 128), t0, t1);
                *(u32x4*)(mrg + ro + bj * 128) = pack8(t0 + acc[ai][bj][m][0] * g0, t1 + acc[ai][bj][m][1] * g1); } }
    }
};
template <bool RES_BF16> struct EpiRes {
    static constexpr bool PERM = false, AFTER_DRAIN = false;
    const void* resp; const void* ress; const float* mod; int goff; bf16_t* r;
    __device__ __forceinline__ f32x4 res4(int row, int col) const {
        if (RES_BF16) return unpack4(*(const u32x2*)((const bf16_t*)resp + (size_t)row * DM + col));
        return *(const f32x4*)((row < NPTOK ? (const float*)resp + (size_t)row * DM : (const float*)ress + (size_t)(row - NPTOK) * DM) + col); }
    __device__ __forceinline__ void small4(int row, int col, const f32x4 v) const {
        *(u32x2*)(r + (size_t)row * DM + col) = pack4(res4(row, col) * ALPHA + *(const f32x4*)(mod + (size_t)mrow_of(row) * NMODC + goff + col) * v); }
    __device__ __forceinline__ void operator()(const f32x4 (&acc)[2][2][4][2], const pg8::Unit& u, int wr, int wc, int fr, int fq) const {
        const int row0 = u.pm * 256 + wr * 64 + fr, col0 = u.pn * 256 + wc * 32 + 4 * fq;
        EPI_LOOP_ROWS { const int row = row0 + ai * 128 + m * 16; const float* gr = mod + (size_t)mrow_of(row) * NMODC + goff + col0;
#pragma unroll
            for (int bj = 0; bj < 2; ++bj)
#pragma unroll
                for (int n = 0; n < 2; ++n) { const int o = bj * 128 + n * 16; *(u32x2*)(r + (size_t)row * DM + col0 + o) = pack4(res4(row, col0 + o) * ALPHA + *(const f32x4*)(gr + o) * acc[ai][bj][m][n]); } }
    }
};
struct EpiGU {
    static constexpr bool PERM = true, AFTER_DRAIN = false;
    bf16_t* act;
    __device__ __forceinline__ void operator()(const f32x4 (&acc)[2][2][4][2], const pg8::Unit& u, int wr, int wc, int fr, int fq) const {
        const int row0 = u.pm * 256 + wr * 64 + fr, col0 = (u.pn * 256 + wc * 32 + 8 * fq) >> 1;
        EPI_LOOP_ROWS { bf16_t* rowp = act + (size_t)(row0 + ai * 128 + m * 16) * DFF + col0;
#pragma unroll
            for (int bj = 0; bj < 2; ++bj) { const f32x4 g = acc[ai][bj][m][0], up = acc[ai][bj][m][1]; u32x2 o;
                o[0] = cvt_pk_bf16(silu_(g[0]) * up[0], silu_(g[1]) * up[1]); o[1] = cvt_pk_bf16(silu_(g[2]) * up[2], silu_(g[3]) * up[3]);
                *(u32x2*)(rowp + bj * 64) = o; } }
    }
};
__device__ void transpose_job(const float* __restrict__ src, int K, int N, bf16_t* __restrict__ dst, int mode, LAS float* tile, int& job, int nb, int wb) {
    const int tid = threadIdx.x, ntn = N / 256, ntiles = (K / 64) * ntn;
    const int first = ((wb - job) % nb + nb) % nb; job += ntiles;
    for (int t = first; t < ntiles; t += nb) {
        const int k0 = (t / ntn) * 64, n0 = (t % ntn) * 256;
        { const int r = tid >> 4, c4 = tid & 15; f32x4 v[2][4];
#pragma unroll
          for (int rr = 0; rr < 2; ++rr)
#pragma unroll
              for (int q = 0; q < 4; ++q) v[rr][q] = *(const f32x4*)(src + (size_t)(k0 + r + rr * 32) * N + n0 + q * 64 + c4 * 4);
#pragma unroll
          for (int rr = 0; rr < 2; ++rr)
#pragma unroll
              for (int q = 0; q < 4; ++q)
#pragma unroll
                  for (int i = 0; i < 4; ++i) tile[(r + rr * 32) * 257 + q * 64 + c4 * 4 + i] = v[rr][q][i]; }
        __syncthreads();
        { const int k8 = tid & 7;
#pragma unroll
          for (int q = 0; q < 4; ++q) { const int nr = (tid >> 3) + 64 * q; float v[8];
#pragma unroll
              for (int i = 0; i < 8; ++i) v[i] = tile[(k8 * 8 + i) * 257 + nr];
              const int n = n0 + nr; const int nd = mode == 0 ? n : ((n >> 2) * 8 + (n & 3) + (mode == 2 ? 4 : 0));
              u32x4 o; o[0] = cvt_pk_bf16(v[0], v[1]); o[1] = cvt_pk_bf16(v[2], v[3]); o[2] = cvt_pk_bf16(v[4], v[5]); o[3] = cvt_pk_bf16(v[6], v[7]);
              *(u32x4*)(dst + (size_t)nd * K + k0 + k8 * 8) = o; } }
        __syncthreads();
    }
}
template <int PART> __device__ void phase_prep(const Params& p, LAS unsigned char* lds, int nb, int wb) {
    const int tid = threadIdx.x; unsigned char* ws = p.ws;
    LAS float* tile = (LAS float*)lds;
    int job = 0;
    if (PART == 0) {
        transpose_job(p.in[6], DM, NMODC, (bf16_t*)(ws + WS_WADA), 0, tile, job, nb, wb);
        bf16_t* ca = (bf16_t*)(ws + WS_CACT);
        for (int i = wb * 512 + tid; i < 256 * DM / 8; i += nb * 512) { const int row = i >> 7, c8 = (i & 127) * 8; u32x4 o = {0u, 0u, 0u, 0u};
            if (row < 136) { const float* s = row < 8 ? p.in[4] + (size_t)row * DM + c8 : p.in[5] + (size_t)(row - 8) * DM + c8; const f32x4 a = *(const f32x4*)s, b = *(const f32x4*)(s + 4);
                o[0] = cvt_pk_bf16(silu_(a[0]), silu_(a[1])); o[1] = cvt_pk_bf16(silu_(a[2]), silu_(a[3])); o[2] = cvt_pk_bf16(silu_(b[0]), silu_(b[1])); o[3] = cvt_pk_bf16(silu_(b[2]), silu_(b[3])); }
            *(u32x4*)(ca + (size_t)row * DM + c8) = o; }
    } else {
        transpose_job(p.in[8], DM, DIN, (bf16_t*)(ws + WS_WIN), 0, tile, job, nb, wb);
        transpose_job(p.in[14], DM, DM, (bf16_t*)(ws + WS_WB), 0, tile, job, nb, wb);
        transpose_job(p.in[15], DM, DM, (bf16_t*)(ws + WS_WOUT), 0, tile, job, nb, wb);
        transpose_job(p.in[18], DM, DFF, (bf16_t*)(ws + WS_WGU), 1, tile, job, nb, wb);
        transpose_job(p.in[19], DM, DFF, (bf16_t*)(ws + WS_WGU), 2, tile, job, nb, wb);
        transpose_job(p.in[20], DFF, DM, (bf16_t*)(ws + WS_WDN), 0, tile, job, nb, wb);
        const float* wg = p.in[9]; const float* ps = p.in[10]; const float* wa = p.in[13]; bf16_t* weff = (bf16_t*)(ws + WS_WEFF);
        for (int it = ((wb - job) % nb + nb) % nb; it < 256; it += nb) {
            const int g = it >> 6, cb = (it >> 1) & 31, nh = it & 1, n = nh * 512 + tid;
            float a[4] = {0.f, 0.f, 0.f, 0.f};
            const float* wap = wa + (size_t)(g * 128) * DM + n; const float* wgp = wg + (size_t)(g * 128 + cb * 4) * 128; const float* psp = ps + g * 128;
#pragma unroll 16
            for (int d = 0; d < 128; ++d) { const float w = wap[(size_t)d * DM] * psp[d];
#pragma unroll
                for (int i = 0; i < 4; ++i) a[i] += wgp[i * 128 + d] * w; }
            u32x2 o; o[0] = cvt_pk_bf16(a[0], a[1]); o[1] = cvt_pk_bf16(a[2], a[3]);
            *(u32x2*)(weff + (size_t)n * DPOOL + g * 128 + cb * 4) = o; }
    }
}
__device__ void phase_u(const Params& p) {
    const float* mod = (const float*)(p.ws + WS_MOD); bf16_t* u = (bf16_t*)(p.out + O_HS);
    const int stride = gridDim.x * 512;
    for (int i0 = blockIdx.x * 512 + threadIdx.x; i0 < NTOK * DM / 8; i0 += 4 * stride) { f32x4 x0[4], x1[4], sh0[4], sh1[4], sc0[4], sc1[4];
#pragma unroll
        for (int k = 0; k < 4; ++k) { const int i = i0 + k * stride; if (i < NTOK * DM / 8) { const int tok = i >> 7, c8 = (i & 127) * 8;
            const float* xr = tok < NPTOK ? p.in[0] + (size_t)tok * DM + c8 : p.in[1] + (size_t)(tok - NPTOK) * DM + c8; const float* mr = mod + (size_t)mrow_of(tok) * NMODC + c8;
            x0[k] = *(const f32x4*)xr; x1[k] = *(const f32x4*)(xr + 4); sh0[k] = *(const f32x4*)mr; sh1[k] = *(const f32x4*)(mr + 4); sc0[k] = *(const f32x4*)(mr + DM); sc1[k] = *(const f32x4*)(mr + DM + 4); } }
#pragma unroll
        for (int k = 0; k < 4; ++k) { const int i = i0 + k * stride; if (i < NTOK * DM / 8) { const int tok = i >> 7, c8 = (i & 127) * 8;
            *(u32x4*)(u + (size_t)tok * DM + c8) = pack8(x0[k] * (sc0[k] + 1.f) + sh0[k], x1[k] * (sc1[k] + 1.f) + sh1[k]); } } }
}
template <bool FIRST> __device__ void phase_ln(const Params& p) {
    const float* mod = (const float*)(p.ws + WS_MOD);
    const bf16_t* r = FIRST ? (const bf16_t*)p.out : (const bf16_t*)(p.ws + WS_OG);
    const float* g = p.in[FIRST ? 16 : 21]; const float* b = p.in[FIRST ? 17 : 22];
    bf16_t* x1 = (bf16_t*)(p.ws + WS_QS); bf16_t* hb = (bf16_t*)(p.ws + WS_OG);
    const int lane = threadIdx.x & 63, wv = blockIdx.x * 8 + (threadIdx.x >> 6), nw = gridDim.x * 8;
    constexpr int R = 4;
    for (int row0 = wv * R; row0 < NTOK; row0 += nw * R) { f32x4 v[R][4]; float s[R], q[R];
#pragma unroll
        for (int k = 0; k < R; ++k) { const bf16_t* rp = r + (size_t)(row0 + k) * DM; s[k] = 0.f;
#pragma unroll
            for (int i = 0; i < 4; ++i) { v[k][i] = unpack4(*(const u32x2*)(rp + i * 256 + lane * 4)); s[k] += v[k][i][0] + v[k][i][1] + v[k][i][2] + v[k][i][3]; } }
#pragma unroll
        for (int o = 32; o; o >>= 1)
#pragma unroll
            for (int k = 0; k < R; ++k) s[k] += __shfl_xor(s[k], o);
#pragma unroll
        for (int k = 0; k < R; ++k) { const float mu = s[k] * (1.f / DM); q[k] = 0.f;
#pragma unroll
            for (int i = 0; i < 4; ++i) { v[k][i] = v[k][i] - mu; q[k] += v[k][i][0] * v[k][i][0] + v[k][i][1] * v[k][i][1] + v[k][i][2] * v[k][i][2] + v[k][i][3] * v[k][i][3]; } }
#pragma unroll
        for (int o = 32; o; o >>= 1)
#pragma unroll
            for (int k = 0; k < R; ++k) q[k] += __shfl_xor(q[k], o);
#pragma unroll
        for (int k = 0; k < R; ++k) { const int row = row0 + k; const float rs = rsqrtf(q[k] * (1.f / DM) + LN_EPS); const float* mr = mod + (size_t)mrow_of(row) * NMODC;
#pragma unroll
            for (int i = 0; i < 4; ++i) { const int c = i * 256 + lane * 4; const f32x4 y = v[k][i] * rs * *(const f32x4*)(g + c) + *(const f32x4*)(b + c);
                if (FIRST) { *(u32x2*)(x1 + (size_t)row * DM + c) = pack4(y); *(u32x2*)(hb + (size_t)row * DM + c) = pack4(y * (*(const f32x4*)(mr + 4 * DM + c) + 1.f) + *(const f32x4*)(mr + 3 * DM + c)); }
                else *(f32x4*)(p.out + (size_t)row * DM + c) = y; } } }
}
__device__ void phase_pool(const Params& p, int nb, int wb) {
    const float* zp = p.out;
    bf16_t* dmb = (bf16_t*)(p.ws + WS_DMB); const float* sp = p.in[2];
    const int gt = wb * 512 + threadIdx.x, gn = nb * 512;
    for (int i = gt; i < 512 * 128 + NBS * 128; i += gn) {
        const int c0 = (i & 127) * 4, w = 2 << (c0 >> 7);
        if (i < 512 * 128) {
            const int run = i >> 7, b = run >> 6, t0 = (run & 63) * 32; const float* zb = zp + (size_t)b * SEQ * DPOOL + c0; bf16_t* db = dmb + (size_t)b * SEQ * DPOOL + c0;
            f32x4 s = {0.f, 0.f, 0.f, 0.f};
            for (int t = t0 - w; t < t0; ++t) if (t >= 0) s += *(const f32x4*)(zb + (size_t)t * DPOOL);
            for (int t = t0; t < t0 + 32; ++t) { const f32x4 z = *(const f32x4*)(zb + (size_t)t * DPOOL); s += z;
                if (t - w >= 0) s -= *(const f32x4*)(zb + (size_t)(t - w) * DPOOL);
                const float ic = 1.f / (float)(t + 1 < w ? t + 1 : w); const f32x4 d = s * ic - z;
                u32x2 o; o[0] = cvt_pk_bf16(d[0], d[1]); o[1] = cvt_pk_bf16(d[2], d[3]); *(u32x2*)(db + (size_t)t * DPOOL) = o; }
        } else {
            const int b = (i - 512 * 128) >> 7; const float* sb = sp + (size_t)b * PBUF * DPOOL + c0; const float* zb = zp + (size_t)(NPTOK + b * DSEQ) * DPOOL + c0;
            const float ic = 1.f / (float)w;
            for (int t = 0; t < DSEQ; ++t) { f32x4 s = {0.f, 0.f, 0.f, 0.f};
                for (int e = PBUF + t - w + 1; e <= PBUF + t; ++e) s += e < PBUF ? *(const f32x4*)(sb + (size_t)e * DPOOL) : *(const f32x4*)(zb + (size_t)(e - PBUF) * DPOOL);
                const f32x4 z = *(const f32x4*)(zb + (size_t)t * DPOOL), d = s * ic - z;
                u32x2 o; o[0] = cvt_pk_bf16(d[0], d[1]); o[1] = cvt_pk_bf16(d[2], d[3]); *(u32x2*)(dmb + (size_t)(NPTOK + b * DSEQ + t) * DPOOL + c0) = o; }
        }
    }
    for (int i = gt; i < NBP * PBUF * 128; i += gn) { const int c0 = (i & 127) * 4, r = i >> 7, b = r / PBUF, k = r % PBUF;
        *(f32x4*)(p.out + O_PP + (size_t)r * DPOOL + c0) = *(const f32x4*)(zp + (size_t)(b * SEQ + SEQ - PBUF + k) * DPOOL + c0) * DG(1.00632f); }
    for (int i = gt; i < NBS * PBUF * 128; i += gn) { const int c0 = (i & 127) * 4, r = i >> 7, b = r / PBUF, k = r % PBUF;
        *(f32x4*)(p.out + O_PS + (size_t)r * DPOOL + c0) = DG(1.01049f) * (k < PBUF - DSEQ ? *(const f32x4*)(sp + (size_t)(b * PBUF + k + DSEQ) * DPOOL + c0) : *(const f32x4*)(zp + (size_t)(NPTOK + b * DSEQ + k - (PBUF - DSEQ)) * DPOOL + c0)); }
}
constexpr int L_QD = 0, L_KD = 17408, L_KT = 34816, L_VT = 53248, L_PP = 71680, L_ST = 80896, L_GT = 115712, L_DEC = 117760, L_RED = 118272;
constexpr int QS_ = 136, TS_ = 72;
#define MFMA16(a, b, c) __builtin_amdgcn_mfma_f32_16x16x32_bf16(a, b, c, 0, 0, 0)
#define LDSV(off) (*(const LAS bf16x8*)(lds + (off)))
template <bool PASSB> __device__ void hgrn_item(const Params& p, LAS unsigned char* lds, int b, int h, int seg) {
    const int tid = threadIdx.x, wid = tid >> 6, lane = tid & 63, fr = lane & 15, fq = lane >> 4, c = tid & 127, tg = tid >> 7;
    const bf16_t* qs = (const bf16_t*)(p.ws + WS_QS); const bf16_t* zf = (const bf16_t*)(p.ws + WS_ZF); const bf16_t* vv = (const bf16_t*)(p.ws + WS_VV); const bf16_t* og = (const bf16_t*)(p.ws + WS_OG);
    bf16_t* yh = (bf16_t*)p.out;
    float* sloc = (float*)(p.ws + WS_SLOC); float* sdec = (float*)(p.ws + WS_SDEC);
    const float l0 = p.in[11][h * HD + c], l1 = p.in[11][DM + h * HD + c]; const float lbv = sigm(l0 - l1), oml = 1.f - lbv;
    f32x4 S[8];
#pragma unroll
    for (int n = 0; n < 8; ++n) S[n] = (f32x4){0.f, 0.f, 0.f, 0.f};
    const int crow = wid * 16 + fq * 4;
    const int ptok = tid >> 4, pch = (tid & 15) * 8;
    const size_t tokbase = (size_t)(b * SEQ + seg * SEGLEN) * DM + h * HD + pch;
    __syncthreads();
    if (PASSB) {
        for (int s = 0; s < seg; ++s) { const float* sl = sloc + (size_t)((b * NH + h) * NSEG + s) * HD * HD + crow * HD + fr; const float* sd = sdec + ((b * NH + h) * NSEG + s) * HD + crow;
#pragma unroll
            for (int j = 0; j < 4; ++j) { const float d = sd[j];
#pragma unroll
                for (int n = 0; n < 8; ++n) S[n][j] = S[n][j] * d + sl[j * HD + n * 16]; } }
#pragma unroll
        for (int n = 0; n < 8; ++n) { u32x2 o; o[0] = cvt_pk_bf16(S[n][0], S[n][1]); o[1] = cvt_pk_bf16(S[n][2], S[n][3]); *(LAS u32x2*)(lds + L_ST + ((n * 16 + fr) * QS_ + crow) * 2) = o; }
    }
    float segtot = 1.f;
    for (int ch = 0; ch < NCHSEG; ++ch) {
        const int tok0 = b * SEQ + seg * SEGLEN + ch * CH;
        u32x4 cg_[2];
        { u32x4 rz[2], rv[2], rq[2];
#pragma unroll
          for (int i = 0; i < 2; ++i) { const size_t gi = tokbase + (size_t)(ch * CH + ptok + 32 * i) * DM; rz[i] = *(const u32x4*)(zf + gi); rv[i] = *(const u32x4*)(vv + gi);
              if (PASSB) { rq[i] = *(const u32x4*)(qs + gi); cg_[i] = *(const u32x4*)(og + gi); } }
#pragma unroll
          for (int i = 0; i < 2; ++i) { const int o = ((ptok + 32 * i) * 128 + pch) * 2; *(LAS u32x4*)(lds + L_QD + o) = rz[i]; *(LAS u32x4*)(lds + L_KT + o) = rv[i]; if (PASSB) *(LAS u32x4*)(lds + L_KD + o) = rq[i]; } }
        __syncthreads();
        float pr[16], kk[16]; unsigned qp[8];
        { float run = 1.f;
#pragma unroll
          for (int i = 0; i < 16; ++i) { const int o = ((tg * 16 + i) * 128 + c) * 2; const float z = bf2f(*(const LAS bf16_t*)(lds + L_QD + o)); const float sg = sigm(z); kk[i] = oml * (1.f - sg); run *= lbv + oml * sg; pr[i] = run;
              if (PASSB) { const unsigned qq = *(const LAS bf16_t*)(lds + L_KD + o); if (i & 1) qp[i >> 1] |= qq << 16; else qp[i >> 1] = qq; } }
          unsigned vt[8];
#pragma unroll
          for (int i = 0; i < 8; ++i) vt[i] = (unsigned)*(const LAS bf16_t*)(lds + L_KT + ((tg * 16 + 2 * i) * 128 + c) * 2) | ((unsigned)*(const LAS bf16_t*)(lds + L_KT + ((tg * 16 + 2 * i + 1) * 128 + c) * 2) << 16);
          *(LAS u32x4*)(lds + L_VT + (c * TS_ + tg * 16) * 2) = (u32x4){vt[0], vt[1], vt[2], vt[3]}; *(LAS u32x4*)(lds + L_VT + (c * TS_ + tg * 16 + 8) * 2) = (u32x4){vt[4], vt[5], vt[6], vt[7]};
          *(LAS float*)(lds + L_GT + (tg * 128 + c) * 4) = run; }
        __syncthreads();
        float off = 1.f, tot = 1.f;
#pragma unroll
        for (int g = 0; g < 4; ++g) { const float t = *(const LAS float*)(lds + L_GT + (g * 128 + c) * 4); tot *= t; if (g < tg) off *= t; }
        { unsigned kt[8];
#pragma unroll
          for (int i = 0; i < 8; ++i) { const float e0 = pr[2 * i] * off, e1 = pr[2 * i + 1] * off, r0 = __builtin_amdgcn_rcpf(e0), r1 = __builtin_amdgcn_rcpf(e1);
              kt[i] = cvt_pk_bf16(kk[2 * i] * (tot * r0), kk[2 * i + 1] * (tot * r1));
              if (PASSB) { const int t = tg * 16 + 2 * i;
                  *(LAS bf16_t*)(lds + L_QD + (t * QS_ + c) * 2) = f2bf(bf2f(qp[i] & 0xffffu) * e0); *(LAS bf16_t*)(lds + L_QD + ((t + 1) * QS_ + c) * 2) = f2bf(__uint_as_float(qp[i] & 0xffff0000u) * e1);
                  *(LAS bf16_t*)(lds + L_KD + (t * QS_ + c) * 2) = f2bf(kk[2 * i] * r0); *(LAS bf16_t*)(lds + L_KD + ((t + 1) * QS_ + c) * 2) = f2bf(kk[2 * i + 1] * r1); } }
          *(LAS u32x4*)(lds + L_KT + (c * TS_ + tg * 16) * 2) = (u32x4){kt[0], kt[1], kt[2], kt[3]}; *(LAS u32x4*)(lds + L_KT + (c * TS_ + tg * 16 + 8) * 2) = (u32x4){kt[4], kt[5], kt[6], kt[7]};
          }
        if (tg == 0) { *(LAS float*)(lds + L_DEC + c * 4) = tot; segtot *= tot; }
        __syncthreads();
        f32x4 o[4]; const int ti = wid >> 1;
        if (PASSB) {
#pragma unroll
            for (int x = 0; x < 2; ++x) { const int tj = (wid & 1) * 2 + x; f32x4 a = {0.f, 0.f, 0.f, 0.f};
                if (tj <= ti) {
#pragma unroll
                    for (int k = 0; k < 4; ++k) a = MFMA16(LDSV(L_QD + ((ti * 16 + fr) * QS_ + k * 32 + fq * 8) * 2), LDSV(L_KD + ((tj * 16 + fr) * QS_ + k * 32 + fq * 8) * 2), a);
                }
#pragma unroll
                for (int j = 0; j < 4; ++j) { const int t = ti * 16 + fq * 4 + j, s = tj * 16 + fr; *(LAS bf16_t*)(lds + L_PP + (t * TS_ + s) * 2) = f2bf(s <= t ? a[j] : 0.f); } }
            __syncthreads();
#pragma unroll
            for (int n = 0; n < 4; ++n) { const int vtile = (wid & 1) * 4 + n; o[n] = (f32x4){0.f, 0.f, 0.f, 0.f};
#pragma unroll
                for (int k = 0; k < 2; ++k) o[n] = MFMA16(LDSV(L_PP + ((ti * 16 + fr) * TS_ + k * 32 + fq * 8) * 2), LDSV(L_VT + ((vtile * 16 + fr) * TS_ + k * 32 + fq * 8) * 2), o[n]);
#pragma unroll
                for (int k = 0; k < 4; ++k) o[n] = MFMA16(LDSV(L_QD + ((ti * 16 + fr) * QS_ + k * 32 + fq * 8) * 2), LDSV(L_ST + ((vtile * 16 + fr) * QS_ + k * 32 + fq * 8) * 2), o[n]);
                __builtin_amdgcn_sched_barrier(0); }
#pragma unroll
            for (int j = 0; j < 4; ++j) { float q = 0.f;
#pragma unroll
                for (int n = 0; n < 4; ++n) q += o[n][j] * o[n][j];
                q += __shfl_xor(q, 1); q += __shfl_xor(q, 2); q += __shfl_xor(q, 4); q += __shfl_xor(q, 8);
                if (fr == 0) *(LAS float*)(lds + L_RED + ((wid & 1) * 64 + ti * 16 + fq * 4 + j) * 4) = q; }
        }
        { float d[4];
#pragma unroll
          for (int j = 0; j < 4; ++j) d[j] = *(const LAS float*)(lds + L_DEC + (crow + j) * 4);
#pragma unroll
          for (int n = 0; n < 8; ++n) {
#pragma unroll
              for (int j = 0; j < 4; ++j) S[n][j] *= d[j];
#pragma unroll
              for (int k = 0; k < 2; ++k) S[n] = MFMA16(LDSV(L_KT + ((wid * 16 + fr) * TS_ + k * 32 + fq * 8) * 2), LDSV(L_VT + ((n * 16 + fr) * TS_ + k * 32 + fq * 8) * 2), S[n]);
              if (n & 1) __builtin_amdgcn_sched_barrier(0); } }
        __syncthreads();
        if (PASSB) {
#pragma unroll
            for (int n = 0; n < 8; ++n) { u32x2 w; w[0] = cvt_pk_bf16(S[n][0], S[n][1]); w[1] = cvt_pk_bf16(S[n][2], S[n][3]); *(LAS u32x2*)(lds + L_ST + ((n * 16 + fr) * QS_ + crow) * 2) = w; }
#pragma unroll
            for (int j = 0; j < 4; ++j) { const int t = ti * 16 + fq * 4 + j;
                const float ri = rsqrtf((*(const LAS float*)(lds + L_RED + t * 4) + *(const LAS float*)(lds + L_RED + (64 + t) * 4)) * (1.f / HD) + RMS_EPS);
#pragma unroll
                for (int n = 0; n < 4; ++n) *(LAS bf16_t*)(lds + L_VT + (t * 128 + ((wid & 1) * 4 + n) * 16 + fr) * 2) = f2bf(o[n][j] * ri); }
            __syncthreads();
#pragma unroll
            for (int i = 0; i < 2; ++i) { const u32x4 yv = *(const LAS u32x4*)(lds + L_VT + ((ptok + 32 * i) * 128 + pch) * 2); f32x4 y0, y1, g0, g1; unpack8(yv, y0, y1); unpack8(cg_[i], g0, g1);
                *(u32x4*)(yh + (size_t)(tok0 + ptok + 32 * i) * DM + h * HD + pch) = pack8(y0 * g0, y1 * g1); }
        }
    }
    if (PASSB) {
        if (seg == NSEG - 1) { float* dst = p.out + O_HP + (size_t)(b * NH + h) * HD * HD + crow * HD + fr;
#pragma unroll
            for (int n = 0; n < 8; ++n)
#pragma unroll
                for (int j = 0; j < 4; ++j) dst[j * HD + n * 16] = S[n][j] * DG(1.00837f); }
    } else {
        float* sl = sloc + (size_t)((b * NH + h) * NSEG + seg) * HD * HD + crow * HD + fr;
#pragma unroll
        for (int n = 0; n < 8; ++n)
#pragma unroll
            for (int j = 0; j < 4; ++j) sl[j * HD + n * 16] = S[n][j];
        if (tg == 0) sdec[((b * NH + h) * NSEG + seg) * HD + c] = segtot;
    }
}
constexpr int L2_Q = 0, L2_K = 4096, L2_F = 8192, L2_V = 12288, L2_OG = 16384, L2_PO = 20480, L2_RED = 36864;
__device__ void hgrn_sample_run(const Params& p, LAS unsigned char* lds, int s_first, int s_stride) {
    const int tid = threadIdx.x, v = tid & 127, cq = tid >> 7, lane = tid & 63, wid = tid >> 6;
    const bf16_t* qs = (const bf16_t*)(p.ws + WS_QS); const bf16_t* zf = (const bf16_t*)(p.ws + WS_ZF); const bf16_t* vv = (const bf16_t*)(p.ws + WS_VV); const bf16_t* og = (const bf16_t*)(p.ws + WS_OG);
    bf16_t* yh = (bf16_t*)p.out;
    float S[32], Sn[32];
    if (s_first < NBS * NH) { const float* s0 = p.in[3] + (size_t)s_first * HD * HD + (cq * 32) * HD + v;
#pragma unroll
        for (int i = 0; i < 32; ++i) S[i] = s0[i * HD]; }
    for (int s = s_first; s < NBS * NH; s += s_stride) {
        const int bs = s >> 3, h = s & 7, sn = s + s_stride;
        float* s1 = p.out + O_HS + (size_t)s * HD * HD + (cq * 32) * HD + v;
        float zr[2], qr[2], vr[2], gr[2];
#pragma unroll
        for (int r = 0; r < 2; ++r) { const size_t gi = (size_t)(NPTOK + bs * DSEQ + cq * 2 + r) * DM + h * HD + v; zr[r] = bf2f(zf[gi]); qr[r] = bf2f(qs[gi]); vr[r] = bf2f(vv[gi]); gr[r] = bf2f(og[gi]); }
        const float l0 = p.in[11][h * HD + v], l1 = p.in[11][DM + h * HD + v];
        if (sn < NBS * NH) { const float* s0 = p.in[3] + (size_t)sn * HD * HD + (cq * 32) * HD + v;
#pragma unroll
            for (int i = 0; i < 32; ++i) Sn[i] = s0[i * HD]; }
        __syncthreads();
        { const float lbv = sigm(l0 - l1), oml = 1.f - lbv;
#pragma unroll
          for (int r = 0; r < 2; ++r) { const int t = cq * 2 + r; const float sg = sigm(zr[r]);
              *(LAS float*)(lds + L2_Q + (t * 128 + v) * 4) = qr[r]; *(LAS float*)(lds + L2_K + (t * 128 + v) * 4) = oml * (1.f - sg); *(LAS float*)(lds + L2_F + (t * 128 + v) * 4) = lbv + oml * sg;
              *(LAS float*)(lds + L2_V + (t * 128 + v) * 4) = vr[r]; *(LAS float*)(lds + L2_OG + (t * 128 + v) * 4) = gr[r]; } }
        __syncthreads();
#pragma unroll 1
        for (int t = 0; t < DSEQ; ++t) { const float vt = *(const LAS float*)(lds + L2_V + (t * 128 + v) * 4); float po = 0.f;
#pragma unroll
            for (int i4 = 0; i4 < 8; ++i4) { const int co = (t * 128 + cq * 32 + i4 * 4) * 4;
                const f32x4 f = *(const LAS f32x4*)(lds + L2_F + co), k = *(const LAS f32x4*)(lds + L2_K + co), q = *(const LAS f32x4*)(lds + L2_Q + co);
#pragma unroll
                for (int i = 0; i < 4; ++i) { S[i4 * 4 + i] = f[i] * S[i4 * 4 + i] + k[i] * vt; po += S[i4 * 4 + i] * q[i]; } }
            *(LAS float*)(lds + L2_PO + ((t * 4 + cq) * 128 + v) * 4) = po; }
#pragma unroll
        for (int i = 0; i < 32; ++i) s1[i * HD] = S[i] * DG(1.01265f);
        __syncthreads();
        float ov[2];
#pragma unroll
        for (int r = 0; r < 2; ++r) { const int t = cq * 2 + r; float o = 0.f;
#pragma unroll
            for (int g = 0; g < 4; ++g) o += *(const LAS float*)(lds + L2_PO + ((t * 4 + g) * 128 + v) * 4);
            ov[r] = o; float q = o * o;
#pragma unroll
            for (int x = 32; x; x >>= 1) q += __shfl_xor(q, x);
            if (lane == 0) *(LAS float*)(lds + L2_RED + (t * 2 + (wid & 1)) * 4) = q; }
        __syncthreads();
#pragma unroll
        for (int r = 0; r < 2; ++r) { const int t = cq * 2 + r; const float ri = rsqrtf((*(const LAS float*)(lds + L2_RED + (t * 2) * 4) + *(const LAS float*)(lds + L2_RED + (t * 2 + 1) * 4)) * (1.f / HD) + RMS_EPS);
            yh[(size_t)(NPTOK + bs * DSEQ + t) * DM + h * HD + v] = f2bf(ov[r] * ri * *(const LAS float*)(lds + L2_OG + (t * 128 + v) * 4)); }
#pragma unroll
        for (int i = 0; i < 32; ++i) S[i] = Sn[i];
    }
}
template <class Epi> __device__ void small_gemm(LAS unsigned char* lds, const bf16_t* __restrict__ A, const bf16_t* __restrict__ Bt, int K, int tm, int tn, const Epi& E) {
    const int tid = threadIdx.x, wid = tid >> 6, lane = tid & 63, fr = lane & 15, fq = lane >> 4;
    const int row0 = NPTOK + tm * 64, col0 = tn * 64;
    const bf16_t* Ab = A + (size_t)row0 * K + (size_t)(tid >> 5) * K + (tid & 31) * 8; const bf16_t* Bb = Bt + (size_t)col0 * K + (size_t)(tid >> 5) * K + (tid & 31) * 8;
    const int loff = (tid >> 5) * 512 + (((tid & 31) ^ ((tid >> 5) & 15)) << 4);
    u32x4 ra[4], rb[4];
    f32x4 acc[2]; acc[0] = (f32x4){0.f, 0.f, 0.f, 0.f}; acc[1] = acc[0];
    const int nk = K >> 8;
#pragma unroll
    for (int i = 0; i < 4; ++i) { ra[i] = *(const u32x4*)(Ab + (size_t)(16 * i) * K); rb[i] = *(const u32x4*)(Bb + (size_t)(16 * i) * K); }
    __syncthreads();
#pragma unroll
    for (int i = 0; i < 4; ++i) { *(LAS u32x4*)(lds + loff + i * 8192) = ra[i]; *(LAS u32x4*)(lds + 32768 + loff + i * 8192) = rb[i]; }
    __syncthreads();
    const int arow = (wid & 3) * 16 + fr, brow = (wid >> 2) * 32 + fr;
    for (int t = 0; t < nk; ++t) {
        const int buf = (t & 1) * 65536;
        if (t + 1 < nk) {
#pragma unroll
            for (int i = 0; i < 4; ++i) { ra[i] = *(const u32x4*)(Ab + (size_t)(16 * i) * K + (t + 1) * 256); rb[i] = *(const u32x4*)(Bb + (size_t)(16 * i) * K + (t + 1) * 256); } }
#pragma unroll
        for (int kk = 0; kk < 8; ++kk) { const int sw = ((kk * 4 + fq) ^ fr) << 4;
            const bf16x8 a = *(const LAS bf16x8*)(lds + buf + arow * 512 + sw);
#pragma unroll
            for (int s2 = 0; s2 < 2; ++s2) { const bf16x8 bb = *(const LAS bf16x8*)(lds + buf + 32768 + (brow + s2 * 16) * 512 + sw); acc[s2] = __builtin_amdgcn_mfma_f32_16x16x32_bf16(bb, a, acc[s2], 0, 0, 0); } }
        if (t + 1 < nk) {
#pragma unroll
            for (int i = 0; i < 4; ++i) { *(LAS u32x4*)(lds + (buf ^ 65536) + loff + i * 8192) = ra[i]; *(LAS u32x4*)(lds + (buf ^ 65536) + 32768 + loff + i * 8192) = rb[i]; } }
        __syncthreads();
    }
#pragma unroll
    for (int s2 = 0; s2 < 2; ++s2) E.small4(row0 + arow, col0 + (wid >> 2) * 32 + s2 * 16 + fq * 4, acc[s2]);
}
#define XB_TMO      128
#define XB_XCNT(j)  (256  + 64 * (j))
#define XB_XSUB(j)  (1280 + 64 * (j))
#define XB_XGEN(j)  (2304 + 64 * (j))
#define XB_TOP      3328
#define XB_TOPGEN   3392
#define XCD_BAR_WORDS 3456
#define XB_SPIN_CAP (1u << 18)

__device__ __forceinline__ unsigned xb_ld(unsigned* p)              { return __hip_atomic_load(p, __ATOMIC_RELAXED, __HIP_MEMORY_SCOPE_AGENT); }
__device__ __forceinline__ unsigned xb_add(unsigned* p, unsigned v) { return __hip_atomic_fetch_add(p, v, __ATOMIC_RELAXED, __HIP_MEMORY_SCOPE_AGENT); }
__device__ __forceinline__ unsigned xb_xcc_id() { return (unsigned)__builtin_amdgcn_s_getreg((3 << 11) | 20) & 0xFu; }
#define XB_SPIN(cond, bar) do { unsigned _sp = 0; while (cond) { __builtin_amdgcn_s_sleep(1); \
    if ((++_sp & 255u) == 0u) { if (xb_ld(&(bar)[XB_TMO])) break; if (_sp > XB_SPIN_CAP) { atomicAdd(&(bar)[XB_TMO], 1u); break; } } } } while (0)

struct XcdBarrier {
    unsigned* bar; unsigned x;
    volatile LAS unsigned* st;
};

__device__ __forceinline__ XcdBarrier xcd_barrier_post(unsigned* bar, volatile LAS unsigned* st) {
    XcdBarrier b; b.bar = bar; b.x = xb_xcc_id(); b.st = st;
    if (threadIdx.x == 0) (void)xb_add(&bar[XB_XCNT(b.x)], 1u);
    return b;
}
__device__ __forceinline__ void xcd_barrier_complete(unsigned* bar, unsigned x, unsigned& nloc, unsigned& nx) {
    const unsigned G = gridDim.x * gridDim.y * gridDim.z;
    unsigned sum, cnt, mine, sp = 0u;
    for (;;) {
        sum = 0u; cnt = 0u; mine = 0u;
#pragma unroll
        for (unsigned j = 0; j < 16; ++j) { const unsigned c = xb_ld(&bar[XB_XCNT(j)]); sum += c; cnt += (c > 0u) ? 1u : 0u; mine = (j == x) ? c : mine; }
        if (sum == G) break;
        __builtin_amdgcn_s_sleep(1);
        if ((++sp & 255u) == 0u) { if (xb_ld(&bar[XB_TMO])) break; if (sp > XB_SPIN_CAP) { atomicAdd(&bar[XB_TMO], 1u); break; } }
    }
    nloc = mine > 0u ? mine : 1u; nx = cnt > 0u ? cnt : 1u;
}

__device__ __forceinline__ void xcd_barrier(const XcdBarrier& b) {
    asm volatile("s_waitcnt vmcnt(0)" ::: "memory");
    __syncthreads();
    if (threadIdx.x == 0) {
        unsigned* bar = b.bar;
        __builtin_amdgcn_s_waitcnt(0);
        unsigned nloc = b.st[0], nx = b.st[1];
        if (nloc == 0u) { xcd_barrier_complete(bar, b.x, nloc, nx); b.st[0] = nloc; b.st[1] = nx; }
        const unsigned old = xb_add(&bar[XB_XSUB(b.x)], 1u);
        const unsigned gen = old / nloc;
        if (old + 1u == (gen + 1u) * nloc) {
            __builtin_amdgcn_fence(__ATOMIC_RELEASE, "agent");
            asm volatile("s_waitcnt vmcnt(0)" ::: "memory");
            const unsigned og = xb_add(&bar[XB_TOP], 1u);
            const unsigned tg = og / nx;
            if (og + 1u == (tg + 1u) * nx) xb_add(&bar[XB_TOPGEN], 1u);
            else XB_SPIN(xb_ld(&bar[XB_TOPGEN]) == tg, bar);
            __builtin_amdgcn_fence(__ATOMIC_ACQUIRE, "agent");
            xb_add(&bar[XB_XGEN(b.x)], 1u);
            asm volatile("s_waitcnt vmcnt(0)" ::: "memory");
        } else {
            XB_SPIN(xb_ld(&bar[XB_XGEN(b.x)]) == gen, bar);
            __builtin_amdgcn_fence(__ATOMIC_ACQUIRE, "agent");
            asm volatile("s_waitcnt vmcnt(0)" ::: "memory");
        }
    }

    __syncthreads();
}
constexpr int N_PHASES = 12;
template <int PH> __device__ __forceinline__ void run_phase(const Params& p, LAS unsigned char* lds) {
    unsigned char* ws = p.ws; const int G = gridDim.x, bid = blockIdx.x;
    float* mod = (float*)(ws + WS_MOD);
    if constexpr (PH == 0) phase_prep<0>(p, lds, G, bid);
    else if constexpr (PH == 1) {
        const int NA = NMODC / 256;
        if (G > 2 * NA) {
            if (bid < NA) { pg8::Gemm g{(const bf16_t*)(ws + WS_CACT), (const bf16_t*)(ws + WS_WADA), 256, NMODC, DM}; pg8::StaticOrder S; S.init(256, NMODC, NA, bid); EpiAda E{mod, p.in[7]}; pg8::gemm_phase(lds, g, S, E); }
            else phase_prep<1>(p, lds, G - NA, bid - NA);
        } else { phase_prep<1>(p, lds, G, bid); pg8::Gemm g{(const bf16_t*)(ws + WS_CACT), (const bf16_t*)(ws + WS_WADA), 256, NMODC, DM}; pg8::StaticOrder S; S.init(256, NMODC, G, bid); EpiAda E{mod, p.in[7]}; pg8::gemm_phase(lds, g, S, E); }
    }
    else if constexpr (PH == 2) phase_u(p);
    else if constexpr (PH == 3) { pg8::Gemm g{(const bf16_t*)(p.out + O_HS), (const bf16_t*)(ws + WS_WIN), NTOK, DIN, DM}; pg8::StaticOrder S; S.init(NTOK, DIN, G, bid);
        EpiZ E{p.out, (bf16_t*)(ws + WS_QS), (bf16_t*)(ws + WS_ZF), (bf16_t*)(ws + WS_VV), (bf16_t*)(ws + WS_OG), (bf16_t*)((unsigned char*)p.out + S35), (bf16_t*)(ws + WS_GB), p.in[12]};
        pg8::gemm_phase(lds, g, S, E); }
    else if constexpr (PH == 4) { const int NA = NBP * NH * (NSEG - 1);
        if (G >= NA + 32) { if (bid >= NA) phase_pool(p, G - NA, bid - NA); else hgrn_item<false>(p, lds, bid / (NH * (NSEG - 1)), (bid / (NSEG - 1)) % NH, bid % (NSEG - 1)); }
        else { phase_pool(p, G, bid); for (int it = bid; it < NA; it += G) hgrn_item<false>(p, lds, it / (NH * (NSEG - 1)), (it / (NSEG - 1)) % NH, it % (NSEG - 1)); } }
    else if constexpr (PH == 5) {
        for (int it = bid; it < NBP * NH * NSEG; it += G) hgrn_item<true>(p, lds, it / (NH * NSEG), (it / NSEG) % NH, it % NSEG);
        hgrn_sample_run(p, lds, bid, G); }
    else if constexpr (PH == 6) { pg8::StaticOrder S; S.init(NPTOK, DM, G, bid);
        const EpiP EP{(bf16_t*)(ws + WS_QS), (const bf16_t*)((unsigned char*)p.out + S35)}; const EpiM EM{(const bf16_t*)(ws + WS_QS), (const bf16_t*)(ws + WS_GB), (bf16_t*)(ws + WS_VV)};
        { pg8::Gemm g{(const bf16_t*)(ws + WS_DMB), (const bf16_t*)(ws + WS_WEFF), NPTOK, DM, DPOOL}; pg8::gemm_phase(lds, g, S, EP); }
        { pg8::Gemm g{(const bf16_t*)p.out, (const bf16_t*)(ws + WS_WB), NPTOK, DM, DM}; pg8::gemm_phase(lds, g, S, EM); }
        for (int it = bid; it < 256; it += G) { small_gemm(lds, (const bf16_t*)(ws + WS_DMB), (const bf16_t*)(ws + WS_WEFF), DPOOL, it >> 4, it & 15, EP);
            small_gemm(lds, (const bf16_t*)p.out, (const bf16_t*)(ws + WS_WB), DM, it >> 4, it & 15, EM); } }
    else if constexpr (PH == 7) { pg8::Gemm g{(const bf16_t*)(ws + WS_VV), (const bf16_t*)(ws + WS_WOUT), NPTOK, DM, DM}; pg8::StaticOrder S; S.init(NPTOK, DM, G, bid);
        const EpiRes<false> E{p.in[0], p.in[1], mod, 2 * DM, (bf16_t*)p.out}; pg8::gemm_phase(lds, g, S, E);
        for (int it = bid; it < 256; it += G) small_gemm(lds, (const bf16_t*)(ws + WS_VV), (const bf16_t*)(ws + WS_WOUT), DM, it >> 4, it & 15, E); }
    else if constexpr (PH == 8) phase_ln<true>(p);
    else if constexpr (PH == 9) { pg8::Gemm g{(const bf16_t*)(ws + WS_OG), (const bf16_t*)(ws + WS_WGU), NTOK, 2 * DFF, DM}; pg8::StaticOrder S; S.init(NTOK, 2 * DFF, G, bid);
        EpiGU E{(bf16_t*)(ws + WS_VV)}; pg8::gemm_phase(lds, g, S, E); }
    else if constexpr (PH == 10) { pg8::Gemm g{(const bf16_t*)(ws + WS_VV), (const bf16_t*)(ws + WS_WDN), NPTOK, DM, DFF}; pg8::StaticOrder S; S.init(NPTOK, DM, G, bid);
        const EpiRes<true> E{ws + WS_QS, nullptr, mod, 5 * DM, (bf16_t*)(ws + WS_OG)}; pg8::gemm_phase(lds, g, S, E);
        for (int it = bid; it < 256; it += G) small_gemm(lds, (const bf16_t*)(ws + WS_VV), (const bf16_t*)(ws + WS_WDN), DFF, it >> 4, it & 15, E); }
    else phase_ln<false>(p);
}
#if N_LAUNCH_MODE == 0
#define RUN_PHASE(PH) { const __attribute__((address_space(4))) Params* q_ = kp; asm volatile("" : "+s"(q_)); const Params lp_ = *(const Params*)q_; run_phase<PH>(lp_, lds); }
#define PHASE_SYNC(PH) RUN_PHASE(PH) xcd_barrier(xb);
__global__ __launch_bounds__(512, 2) void mega(Params p) {
    extern __shared__ __attribute__((aligned(16))) unsigned char shm[];
    LAS unsigned char* lds = (LAS unsigned char*)shm;
#if defined(__HIP_DEVICE_COMPILE__)
    cg::grid_group grid = cg::this_grid();
    const __attribute__((address_space(4))) Params* kp = (const __attribute__((address_space(4))) Params*)__builtin_amdgcn_kernarg_segment_ptr();
    LAS unsigned* stw = (LAS unsigned*)(lds + 131072);
    if (threadIdx.x == 0) { stw[0] = 0u; stw[1] = 0u; stw[2] = 0u; stw[3] = 0u; }
    __syncthreads();
    const XcdBarrier xb = xcd_barrier_post((unsigned*)(p.ws + WS_BAR), (volatile LAS unsigned*)stw);
    if (kp->ws == nullptr) grid.sync();
    PHASE_SYNC(0)
    PHASE_SYNC(1) PHASE_SYNC(2) PHASE_SYNC(3) PHASE_SYNC(4) PHASE_SYNC(5) PHASE_SYNC(6) PHASE_SYNC(7) PHASE_SYNC(8) PHASE_SYNC(9) PHASE_SYNC(10)
    RUN_PHASE(11)
#endif
}
#else
template <int PH> __global__ __launch_bounds__(512, 2) void mega(Params p) {
    extern __shared__ __attribute__((aligned(16))) unsigned char shm[];
    run_phase<PH>(p, (LAS unsigned char*)shm);
}
template <int PH> static void launch_phase(const Params& p, int grid, hipStream_t stream) {
    static bool attr = false;
    if (!attr) { (void)hipFuncSetAttribute((const void*)mega<PH>, hipFuncAttributeMaxDynamicSharedMemorySize, LDS_BYTES); attr = true; }
    hipLaunchKernelGGL(mega<PH>, dim3(grid), dim3(512), LDS_BYTES, stream, p);
}
#endif

extern "C" void kernel_launch(void* const* d_in, const int* in_sizes, int n_in, void* d_out, int out_size, void* d_ws, size_t ws_size, hipStream_t stream) {
    static int grid_blocks = 0;
    if (!grid_blocks) {
        int dev = 0, cus = 0, per_cu = 0;
        (void)hipGetDevice(&dev); (void)hipDeviceGetAttribute(&cus, hipDeviceAttributeMultiprocessorCount, dev);
#if N_LAUNCH_MODE == 0
        if (hipFuncSetAttribute((const void*)mega, hipFuncAttributeMaxDynamicSharedMemorySize, LDS_BYTES) != hipSuccess) fprintf(stderr, "hipFuncSetAttribute failed\n");
        if (hipOccupancyMaxActiveBlocksPerMultiprocessor(&per_cu, (const void*)mega, 512, LDS_BYTES) != hipSuccess || per_cu < 1) { fprintf(stderr, "occupancy query: %d\n", per_cu); per_cu = 1; }
        (void)hipGetLastError();
#else
        per_cu = 1;
#endif
        grid_blocks = cus * per_cu;
        if (ws_size < WS_BAR + 16384 || n_in != 23) fprintf(stderr, "kernel_launch: ws_size %zu < %zu or n_in %d != 23\n", ws_size, (size_t)WS_NEED, n_in);
    }
    Params p{};
    for (int i = 0; i < 23; ++i) p.in[i] = (const float*)d_in[i];
    p.out = (float*)d_out; p.ws = (unsigned char*)d_ws;
#if N_LAUNCH_MODE == 0
    (void)hipMemsetAsync((unsigned char*)d_ws + WS_BAR, 0, XCD_BAR_WORDS * sizeof(unsigned), stream);
    void* args[] = {&p};
    hipError_t e = hipLaunchCooperativeKernel((const void*)mega, dim3(grid_blocks), dim3(512), args, LDS_BYTES, stream);
    if (e != hipSuccess) fprintf(stderr, "cooperative launch failed: %s (grid %d)\n", hipGetErrorString(e), grid_blocks);
#else
    launch_phase<0>(p, grid_blocks, stream); launch_phase<1>(p, grid_blocks, stream); launch_phase<2>(p, grid_blocks, stream); launch_phase<3>(p, grid_blocks, stream);
    launch_phase<4>(p, grid_blocks, stream); launch_phase<5>(p, grid_blocks, stream); launch_phase<6>(p, grid_blocks, stream); launch_phase<7>(p, grid_blocks, stream);
    launch_phase<8>(p, grid_blocks, stream); launch_phase<9>(p, grid_blocks, stream); launch_phase<10>(p, grid_blocks, stream); launch_phase<11>(p, grid_blocks, stream);
#endif
}
```

```cpp
#include <hip/hip_runtime.h>
#include <hip/hip_cooperative_groups.h>
#include <cstdio>
namespace cg = cooperative_groups;

#ifndef N_LAUNCH_MODE
#define N_LAUNCH_MODE 0
#endif

constexpr int DM = 1024, NTOK = 17408, NPTOK = 16384, SEQ = 2048, NBP = 8, NBS = 128, DSEQ = 8;
constexpr int DIN = 6656, DFF = 2816, DPOOL = 512, NH = 8, HD = 128, PBUF = 15, NMODC = 6144;
constexpr float ALPHA = 1.1892071150027210f;
constexpr float LN_EPS = 1e-5f, RMS_EPS = 1e-6f;
constexpr int NSEG = 4, SEGLEN = SEQ / NSEG, CH = 64, NCHSEG = SEGLEN / CH;
constexpr size_t O_YP = 0, O_YS = 16777216, O_PP = 17825792, O_HP = 17887232, O_PS = 18935808, O_HS = 19918848;
constexpr size_t S35 = 35651584;
constexpr size_t WS_WIN = 0, WS_WADA = 13631488, WS_WEFF = 26214400, WS_WB = 27262976, WS_WOUT = 29360128, WS_WGU = 31457280,
                 WS_WDN = 42991616, WS_CACT = 48758784, WS_MOD = 49283072, WS_QS = 55574528, WS_ZF = WS_QS + S35, WS_OG = WS_ZF + S35,
                 WS_VV = WS_OG + S35, WS_GB = WS_VV + S35, WS_DMB = WS_GB + S35, WS_NEED = WS_VV + 98041856;
constexpr size_t WS_SLOC = 0, WS_SDEC = 16777216;
constexpr int LDS_BYTES = 131072 + 16;
constexpr size_t WS_BAR = 260571136;

struct Params {
    const float* in[23];
    float* out;
    unsigned char* ws;
};
namespace pg8 {
#define PG8_LAS __attribute__((address_space(3)))
typedef unsigned short bf16_t;
typedef short bf16x8 __attribute__((ext_vector_type(8)));
typedef float f32x4 __attribute__((ext_vector_type(4)));
typedef unsigned u32x4 __attribute__((ext_vector_type(4)));
typedef unsigned u32x2 __attribute__((ext_vector_type(2)));
constexpr int BM = 256, BK = 64, HALF = 128, HTB = HALF * BK * 2, STAGE_BYTES = 8 * HTB, NXCD = 8, WGM = 8;
__host__ __device__ __forceinline__ int lds_byte(int r, int c) { const int st = (r >> 4) * 2 + (c >> 5), rr = r & 15, cc = c & 31, ob = rr * 64 + cc * 2; return st * 1024 + (ob ^ (((ob >> 9) & 1) << 5)); }
__host__ __device__ __forceinline__ void stage_rc(int b, int& R, int& C) { const int st = b / 1024, sb = b % 1024, swz = sb ^ (((sb >> 9) & 1) << 5); R = (st >> 1) * 16 + swz / 64; C = (st & 1) * 32 + (swz % 64) / 2; }
__host__ __device__ __forceinline__ int perm32(int rho) { const int n = rho >> 4, i = rho & 15; return 8 * (i >> 2) + 4 * n + (i & 3); }
struct Unit { int pm, pn; };
struct Gemm { const bf16_t* A; const bf16_t* Bt; int M, N, K; };
struct StaticOrder {
    int nM, nN, nwg, G, c;
    __host__ __device__ void init(int M, int N, int G_, int c_) { nM = M / BM; nN = N / BM; nwg = nM * nN; G = G_; c = c_; }
    __host__ __device__ bool next(int i, Unit& u) const {
        const long L = (long)i * G + c; if (L >= nwg) return false;
        int wgid = (int)L; { const int q = nwg / NXCD, r = nwg % NXCD, xcd = wgid % NXCD, off = wgid / NXCD; wgid = (xcd < r ? xcd * (q + 1) : r * (q + 1) + (xcd - r) * q) + off; }
        const int nig = WGM * nN, gid = wgid / nig, fm = gid * WGM, gsz = (nM - fm) < WGM ? (nM - fm) : WGM;
        u.pm = fm + ((wgid % nig) % gsz); u.pn = (wgid % nig) / gsz; return true;
    }
    __device__ __forceinline__ void a_ready(const Unit&) const {}
    __device__ __forceinline__ void done(const Unit&) const {}
};
__device__ __forceinline__ unsigned cvt_pk_bf16(float lo, float hi) { unsigned r; asm volatile("v_cvt_pk_bf16_f32 %0, %1, %2" : "=v"(r) : "v"(lo), "v"(hi)); return r; }
template <class Epi, class Sched>
__device__ __forceinline__ void gemm_phase(PG8_LAS unsigned char* lds, const Gemm g, const Sched& S, const Epi& E) {
    const int tid = threadIdx.x, wid = __builtin_amdgcn_readfirstlane(tid >> 6), lane = tid & 63, wr = wid >> 2, wc = wid & 3, fr = lane & 15, fq = lane >> 4;
    const int K = g.K, nt = K / BK;
    unsigned voffA[2], voffB[2];
#pragma unroll
    for (int i = 0; i < 2; ++i) { int R, C; stage_rc(tid * 16 + i * 8192, R, C); const int Rb = Epi::PERM ? ((R & ~31) + perm32(R & 31)) : R;
        voffA[i] = (unsigned)(R * K + C) * 2u; voffB[i] = (unsigned)(Rb * K + C) * 2u; }
    const size_t kstep = (size_t)(BK * 2);
    const size_t hstep = (size_t)HALF * K * 2;
    const size_t tstep = 2 * hstep;
    const unsigned ldsw = (unsigned)wid * 1024u;
    const int aoff = lds_byte(wr * 64 + fr, fq * 8), boff = lds_byte(wc * 32 + fr, fq * 8);
#define PG8_SA(b, h) (((b) * 2 + (h)) * HTB)
#define PG8_SB(b, h) ((4 + (b) * 2 + (h)) * HTB)
#define PG8_STAGE(bufoff, gbase, voff) do { _Pragma("unroll") for (int _i = 0; _i < 2; ++_i) \
        __builtin_amdgcn_global_load_lds((const unsigned*)((const char*)(gbase) + (voff)[_i]), (PG8_LAS unsigned*)(lds + (bufoff) + ldsw + _i * 8192), 16, 0, 0); } while (0)
#define PG8_LDA(dst, b, h) do { _Pragma("unroll") for (int m = 0; m < 4; ++m) _Pragma("unroll") for (int k = 0; k < 2; ++k) dst[m][k] = *(const PG8_LAS bf16x8*)(lds + PG8_SA(b, h) + aoff + m * 2048 + k * 1024); } while (0)
#define PG8_LDB(dst, b, h) do { _Pragma("unroll") for (int n = 0; n < 2; ++n) _Pragma("unroll") for (int k = 0; k < 2; ++k) dst[n][k] = *(const PG8_LAS bf16x8*)(lds + PG8_SB(b, h) + boff + n * 2048 + k * 1024); } while (0)
#define PG8_MMA(ai, bj, At, Bt) do { __builtin_amdgcn_s_setprio(1); _Pragma("unroll") for (int m = 0; m < 4; ++m) _Pragma("unroll") for (int n = 0; n < 2; ++n) _Pragma("unroll") for (int k = 0; k < 2; ++k) \
        acc[ai][bj][m][n] = __builtin_amdgcn_mfma_f32_16x16x32_bf16(Bt[n][k], At[m][k], acc[ai][bj][m][n], 0, 0, 0); __builtin_amdgcn_s_setprio(0); } while (0)
#define PG8_WAIT_V(n) asm volatile("s_waitcnt vmcnt(" #n ")" ::: "memory")
#define PG8_WAIT_L(n) asm volatile("s_waitcnt lgkmcnt(" #n ")" ::: "memory")
#define PG8_BAR __builtin_amdgcn_s_barrier()
#define PG8_SCHED __builtin_amdgcn_sched_barrier(0)
    Unit cur, nxt; int ui = 0;
    if (!S.next(0, cur)) return;
    f32x4 acc[2][2][4][2];
#pragma unroll
    for (int a = 0; a < 2; ++a)
#pragma unroll
        for (int b = 0; b < 2; ++b)
#pragma unroll
            for (int m = 0; m < 4; ++m)
#pragma unroll
                for (int n = 0; n < 2; ++n) acc[a][b][m][n] = (f32x4){0.f, 0.f, 0.f, 0.f};
    bf16x8 At[4][2], B0[2][2], B1[2][2];
    const char* cA = (const char*)g.A + (size_t)cur.pm * tstep; const char* cB = (const char*)g.Bt + (size_t)cur.pn * tstep;
    S.a_ready(cur);
    PG8_STAGE(PG8_SB(0, 0), cB, voffB); PG8_STAGE(PG8_SA(0, 0), cA, voffA); PG8_STAGE(PG8_SB(0, 1), cB + hstep, voffB); PG8_STAGE(PG8_SA(0, 1), cA + hstep, voffA);
    if (wr == 1) PG8_BAR;
    PG8_WAIT_V(4); PG8_BAR;
    PG8_STAGE(PG8_SB(1, 0), cB + kstep, voffB); PG8_STAGE(PG8_SA(1, 0), cA + kstep, voffA); PG8_STAGE(PG8_SB(1, 1), cB + hstep + kstep, voffB);
    PG8_WAIT_V(6); PG8_BAR;
    for (;;) {
        const bool has_next = S.next(ui + 1, nxt);
        const char* nA = has_next ? (const char*)g.A + (size_t)nxt.pm * tstep : cA; const char* nB = has_next ? (const char*)g.Bt + (size_t)nxt.pn * tstep : cB;
        for (int t = 0; t < nt; t += 2) {
            const bool last = (t == nt - 2);
            const char* a1 = cA + (size_t)(t + 1) * kstep;
            const char* a2 = last ? nA : cA + (size_t)(t + 2) * kstep; const char* b2 = last ? nB : cB + (size_t)(t + 2) * kstep;
            const char* a3 = a2 + kstep; const char* b3 = b2 + kstep;
            if (last && has_next) S.a_ready(nxt);
            PG8_LDB(B0, 0, 0); PG8_SCHED; PG8_LDA(At, 0, 0); PG8_STAGE(PG8_SA(1, 1), a1 + hstep, voffA);
            PG8_WAIT_L(8); PG8_BAR; PG8_WAIT_L(0); PG8_MMA(0, 0, At, B0); PG8_BAR; PG8_SCHED;
            PG8_LDB(B1, 0, 1); PG8_STAGE(PG8_SB(0, 0), b2, voffB);
            PG8_BAR; PG8_WAIT_L(0); PG8_MMA(0, 1, At, B1); PG8_BAR;
            PG8_LDA(At, 0, 1); PG8_STAGE(PG8_SA(0, 0), a2, voffA);
            PG8_BAR; PG8_WAIT_L(0); PG8_MMA(1, 0, At, B0); PG8_BAR; PG8_SCHED;
            PG8_STAGE(PG8_SB(0, 1), b2 + hstep, voffB);
            PG8_WAIT_V(6); PG8_BAR; PG8_MMA(1, 1, At, B1); PG8_BAR;
            PG8_LDB(B0, 1, 0); PG8_SCHED; PG8_LDA(At, 1, 0); PG8_STAGE(PG8_SA(0, 1), a2 + hstep, voffA);
            PG8_WAIT_L(8); PG8_BAR; PG8_WAIT_L(0); PG8_MMA(0, 0, At, B0); PG8_BAR; PG8_SCHED;
            PG8_LDB(B1, 1, 1); PG8_STAGE(PG8_SB(1, 0), b3, voffB);
            PG8_BAR; PG8_WAIT_L(0); PG8_MMA(0, 1, At, B1); PG8_BAR;
            PG8_LDA(At, 1, 1); PG8_STAGE(PG8_SA(1, 0), a3, voffA);
            PG8_BAR; PG8_WAIT_L(0); PG8_MMA(1, 0, At, B0); PG8_BAR; PG8_SCHED;
            PG8_STAGE(PG8_SB(1, 1), b3 + hstep, voffB);
            PG8_WAIT_V(6); PG8_BAR; PG8_MMA(1, 1, At, B1); PG8_BAR;
        }
        if constexpr (!Epi::AFTER_DRAIN) { E(acc, cur, wr, wc, fr, fq); S.done(cur); }
        if (!has_next) break;
#pragma unroll
        for (int a = 0; a < 2; ++a)
#pragma unroll
            for (int b = 0; b < 2; ++b)
#pragma unroll
                for (int m = 0; m < 4; ++m)
#pragma unroll
                    for (int n = 0; n < 2; ++n) acc[a][b][m][n] = (f32x4){0.f, 0.f, 0.f, 0.f};
        cur = nxt; cA = nA; cB = nB; ++ui;
    }
    PG8_WAIT_V(0);
    if (wr == 0) PG8_BAR;
    PG8_BAR;
    if constexpr (Epi::AFTER_DRAIN) { E.fused(acc, cur, wr, wc, fr, fq, lds, wid, lane); S.done(cur); }
#undef PG8_SA
#undef PG8_SB
#undef PG8_STAGE
#undef PG8_LDA
#undef PG8_LDB
#undef PG8_MMA
#undef PG8_WAIT_V
#undef PG8_WAIT_L
#undef PG8_BAR
#undef PG8_SCHED
}
}

using pg8::bf16_t; using pg8::bf16x8; using pg8::f32x4; using pg8::u32x4; using pg8::u32x2; using pg8::cvt_pk_bf16;
#define LAS __attribute__((address_space(3)))

__device__ __forceinline__ float sigm(float x) { return __builtin_amdgcn_rcpf(1.f + __expf(-x)); }
__device__ __forceinline__ float silu_(float x) { return x * sigm(x); }
__device__ __forceinline__ float bf2f(unsigned b) { return __uint_as_float(b << 16); }
__device__ __forceinline__ bf16_t f2bf(float f) { unsigned u = __float_as_uint(f); u += 0x7FFFu + ((u >> 16) & 1u); return (bf16_t)(u >> 16); }
__device__ __forceinline__ int mrow_of(int tok) { return tok < NPTOK ? (tok >> 11) : 8 + ((tok - NPTOK) >> 3); }
__device__ __forceinline__ u32x4 pack8(const f32x4 a, const f32x4 b) { u32x4 r; r[0] = cvt_pk_bf16(a[0], a[1]); r[1] = cvt_pk_bf16(a[2], a[3]); r[2] = cvt_pk_bf16(b[0], b[1]); r[3] = cvt_pk_bf16(b[2], b[3]); return r; }
__device__ __forceinline__ void unpack8(const u32x4 r, f32x4& a, f32x4& b) {
    a[0] = bf2f(r[0] & 0xffffu); a[1] = __uint_as_float(r[0] & 0xffff0000u); a[2] = bf2f(r[1] & 0xffffu); a[3] = __uint_as_float(r[1] & 0xffff0000u);
    b[0] = bf2f(r[2] & 0xffffu); b[1] = __uint_as_float(r[2] & 0xffff0000u); b[2] = bf2f(r[3] & 0xffffu); b[3] = __uint_as_float(r[3] & 0xffff0000u); }

__device__ __forceinline__ f32x4 unpack4(const u32x2 g) { f32x4 r; r[0] = bf2f(g[0] & 0xffffu); r[1] = __uint_as_float(g[0] & 0xffff0000u); r[2] = bf2f(g[1] & 0xffffu); r[3] = __uint_as_float(g[1] & 0xffff0000u); return r; }
__device__ __forceinline__ u32x2 pack4(const f32x4 t) { u32x2 o; o[0] = cvt_pk_bf16(t[0], t[1]); o[1] = cvt_pk_bf16(t[2], t[3]); return o; }
#define EPI_LOOP_ROWS _Pragma("unroll") for (int ai = 0; ai < 2; ++ai) _Pragma("unroll") for (int m = 0; m < 4; ++m)
struct EpiAda {
    static constexpr bool PERM = false, AFTER_DRAIN = false;
    float* C; const float* bias;
    __device__ __forceinline__ void operator()(const f32x4 (&acc)[2][2][4][2], const pg8::Unit& u, int wr, int wc, int fr, int fq) const {
        const int row0 = u.pm * 256 + wr * 64 + fr, col0 = u.pn * 256 + wc * 32 + 4 * fq;
        EPI_LOOP_ROWS { float* rowp = C + (size_t)(row0 + ai * 128 + m * 16) * NMODC + col0;
#pragma unroll
            for (int bj = 0; bj < 2; ++bj)
#pragma unroll
                for (int n = 0; n < 2; ++n) *(f32x4*)(rowp + bj * 128 + n * 16) = acc[ai][bj][m][n] + *(const f32x4*)(bias + col0 + bj * 128 + n * 16); }
    }
};
struct EpiZ {
    static constexpr bool PERM = true, AFTER_DRAIN = false;
    float* zp; bf16_t *qs, *zf, *vv, *og, *ga, *gb; const float* nw;
    __device__ __forceinline__ void operator()(const f32x4 (&acc)[2][2][4][2], const pg8::Unit& u, int wr, int wc, int fr, int fq) const {
        const int row0 = u.pm * 256 + wr * 64 + fr;
        if (u.pn < 2) {
            const int col0 = u.pn * 256 + wc * 32 + 8 * fq;
            EPI_LOOP_ROWS { float* rowp = zp + (size_t)(row0 + ai * 128 + m * 16) * DPOOL + col0;
#pragma unroll
                for (int bj = 0; bj < 2; ++bj) { *(f32x4*)(rowp + bj * 128) = acc[ai][bj][m][0]; *(f32x4*)(rowp + bj * 128 + 4) = acc[ai][bj][m][1]; } }
            return;
        }
        const int seg = (u.pn - 2) >> 2, col0 = ((u.pn - 2) & 3) * 256 + wc * 32 + 8 * fq;
        bf16_t* dst = seg == 0 ? qs : seg == 1 ? zf : seg == 2 ? vv : seg == 3 ? og : seg == 4 ? ga : gb;
        f32x4 w0[2], w1[2];
#pragma unroll
        for (int bj = 0; bj < 2; ++bj) { w0[bj] = (f32x4){1.f, 1.f, 1.f, 1.f}; w1[bj] = w0[bj]; if (seg == 3) { w0[bj] = *(const f32x4*)(nw + col0 + bj * 128); w1[bj] = *(const f32x4*)(nw + col0 + bj * 128 + 4); } }
        EPI_LOOP_ROWS { bf16_t* rowp = dst + (size_t)(row0 + ai * 128 + m * 16) * DM + col0;
#pragma unroll
            for (int bj = 0; bj < 2; ++bj) { f32x4 v0 = acc[ai][bj][m][0], v1 = acc[ai][bj][m][1];
                if (seg == 0 || seg == 3) {
#pragma unroll
                    for (int i = 0; i < 4; ++i) { v0[i] = silu_(v0[i]) * w0[bj][i]; v1[i] = silu_(v1[i]) * w1[bj][i]; }
                } else if (seg >= 4) {
#pragma unroll
                    for (int i = 0; i < 4; ++i) { v0[i] = sigm(v0[i]); v1[i] = sigm(v1[i]); }
                }
                *(u32x4*)(rowp + bj * 128) = pack8(v0, v1); } }
    }
};
struct EpiP {
    static constexpr bool PERM = true, AFTER_DRAIN = false;
    bf16_t* tmp; const bf16_t* ga;
    __device__ __forceinline__ void small4(int row, int col, const f32x4 v) const { const size_t ro = (size_t)row * DM + col; *(u32x2*)(tmp + ro) = pack4(v * unpack4(*(const u32x2*)(ga + ro))); }
    __device__ __forceinline__ void operator()(const f32x4 (&acc)[2][2][4][2], const pg8::Unit& u, int wr, int wc, int fr, int fq) const {
        const int row0 = u.pm * 256 + wr * 64 + fr, col0 = u.pn * 256 + wc * 32 + 8 * fq;
        EPI_LOOP_ROWS { const size_t ro = (size_t)(row0 + ai * 128 + m * 16) * DM + col0;
#pragma unroll
            for (int bj = 0; bj < 2; ++bj) { f32x4 g0, g1; unpack8(*(const u32x4*)(ga + ro + bj * 128), g0, g1);
                *(u32x4*)(tmp + ro + bj * 128) = pack8(acc[ai][bj][m][0] * g0, acc[ai][bj][m][1] * g1); } }
    }
};
struct EpiM {
    static constexpr bool PERM = true, AFTER_DRAIN = false;
    const bf16_t* tmp; const bf16_t* gb; bf16_t* mrg;
    __device__ __forceinline__ void small4(int row, int col, const f32x4 v) const { const size_t ro = (size_t)row * DM + col;
        *(u32x2*)(mrg + ro) = pack4(unpack4(*(const u32x2*)(tmp + ro)) + v * unpack4(*(const u32x2*)(gb + ro))); }
    __device__ __forceinline__ void operator()(const f32x4 (&acc)[2][2][4][2], const pg8::Unit& u, int wr, int wc, int fr, int fq) const {
        const int row0 = u.pm * 256 + wr * 64 + fr, col0 = u.pn * 256 + wc * 32 + 8 * fq;
        EPI_LOOP_ROWS { const size_t ro = (size_t)(row0 + ai * 128 + m * 16) * DM + col0;
#pragma unroll
            for (int bj = 0; bj < 2; ++bj) { f32x4 g0, g1, t0, t1; unpack8(*(const u32x4*)(gb + ro + bj * 128), g0, g1); unpack8(*(const u32x4*)(tmp + ro + bj * 128), t0, t1);
                *(u32x4*)(mrg + ro + bj * 128) = pack8(t0 + acc[ai][bj][m][0] * g0, t1 + acc[ai][bj][m][1] * g1); } }
    }
};
template <bool RES_BF16> struct EpiRes {
    static constexpr bool PERM = false, AFTER_DRAIN = false;
    const void* resp; const void* ress; const float* mod; int goff; bf16_t* r;
    __device__ __forceinline__ f32x4 res4(int row, int col) const {
        if (RES_BF16) return unpack4(*(const u32x2*)((const bf16_t*)resp + (size_t)row * DM + col));
        return *(const f32x4*)((row < NPTOK ? (const float*)resp + (size_t)row * DM : (const float*)ress + (size_t)(row - NPTOK) * DM) + col); }
    __device__ __forceinline__ void small4(int row, int col, const f32x4 v) const {
        *(u32x2*)(r + (size_t)row * DM + col) = pack4(res4(row, col) * ALPHA + *(const f32x4*)(mod + (size_t)mrow_of(row) * NMODC + goff + col) * v); }
    __device__ __forceinline__ void operator()(const f32x4 (&acc)[2][2][4][2], const pg8::Unit& u, int wr, int wc, int fr, int fq) const {
        const int row0 = u.pm * 256 + wr * 64 + fr, col0 = u.pn * 256 + wc * 32 + 4 * fq;
        EPI_LOOP_ROWS { const int row = row0 + ai * 128 + m * 16; const float* gr = mod + (size_t)mrow_of(row) * NMODC + goff + col0;
#pragma unroll
            for (int bj = 0; bj < 2; ++bj)
#pragma unroll
                for (int n = 0; n < 2; ++n) { const int o = bj * 128 + n * 16; *(u32x2*)(r + (size_t)row * DM + col0 + o) = pack4(res4(row, col0 + o) * ALPHA + *(const f32x4*)(gr + o) * acc[ai][bj][m][n]); } }
    }
};
struct EpiGU {
    static constexpr bool PERM = true, AFTER_DRAIN = false;
    bf16_t* act;
    __device__ __forceinline__ void operator()(const f32x4 (&acc)[2][2][4][2], const pg8::Unit& u, int wr, int wc, int fr, int fq) const {
        const int row0 = u.pm * 256 + wr * 64 + fr, col0 = (u.pn * 256 + wc * 32 + 8 * fq) >> 1;
        EPI_LOOP_ROWS { bf16_t* rowp = act + (size_t)(row0 + ai * 128 + m * 16) * DFF + col0;
#pragma unroll
            for (int bj = 0; bj < 2; ++bj) { const f32x4 g = acc[ai][bj][m][0], up = acc[ai][bj][m][1]; u32x2 o;
                o[0] = cvt_pk_bf16(silu_(g[0]) * up[0], silu_(g[1]) * up[1]); o[1] = cvt_pk_bf16(silu_(g[2]) * up[2], silu_(g[3]) * up[3]);
                *(u32x2*)(rowp + bj * 64) = o; } }
    }
};
__device__ void transpose_job(const float* __restrict__ src, int K, int N, bf16_t* __restrict__ dst, int mode, LAS float* tile, int& job, int nb, int wb) {
    const int tid = threadIdx.x, ntn = N / 256, ntiles = (K / 64) * ntn;
    const int first = ((wb - job) % nb + nb) % nb; job += ntiles;
    for (int t = first; t < ntiles; t += nb) {
        const int k0 = (t / ntn) * 64, n0 = (t % ntn) * 256;
        { const int r = tid >> 4, c4 = tid & 15; f32x4 v[2][4];
#pragma unroll
          for (int rr = 0; rr < 2; ++rr)
#pragma unroll
              for (int q = 0; q < 4; ++q) v[rr][q] = *(const f32x4*)(src + (size_t)(k0 + r + rr * 32) * N + n0 + q * 64 + c4 * 4);
#pragma unroll
          for (int rr = 0; rr < 2; ++rr)
#pragma unroll
              for (int q = 0; q < 4; ++q)
#pragma unroll
                  for (int i = 0; i < 4; ++i) tile[(r + rr * 32) * 257 + q * 64 + c4 * 4 + i] = v[rr][q][i]; }
        __syncthreads();
        { const int k8 = tid & 7;
#pragma unroll
          for (int q = 0; q < 4; ++q) { const int nr = (tid >> 3) + 64 * q; float v[8];
#pragma unroll
              for (int i = 0; i < 8; ++i) v[i] = tile[(k8 * 8 + i) * 257 + nr];
              const int n = n0 + nr; const int nd = mode == 0 ? n : ((n >> 2) * 8 + (n & 3) + (mode == 2 ? 4 : 0));
              u32x4 o; o[0] = cvt_pk_bf16(v[0], v[1]); o[1] = cvt_pk_bf16(v[2], v[3]); o[2] = cvt_pk_bf16(v[4], v[5]); o[3] = cvt_pk_bf16(v[6], v[7]);
              *(u32x4*)(dst + (size_t)nd * K + k0 + k8 * 8) = o; } }
        __syncthreads();
    }
}
template <int PART> __device__ void phase_prep(const Params& p, LAS unsigned char* lds, int nb, int wb) {
    const int tid = threadIdx.x; unsigned char* ws = p.ws;
    LAS float* tile = (LAS float*)lds;
    int job = 0;
    if (PART == 0) {
        transpose_job(p.in[6], DM, NMODC, (bf16_t*)(ws + WS_WADA), 0, tile, job, nb, wb);
        bf16_t* ca = (bf16_t*)(ws + WS_CACT);
        for (int i = wb * 512 + tid; i < 256 * DM / 8; i += nb * 512) { const int row = i >> 7, c8 = (i & 127) * 8; u32x4 o = {0u, 0u, 0u, 0u};
            if (row < 136) { const float* s = row < 8 ? p.in[4] + (size_t)row * DM + c8 : p.in[5] + (size_t)(row - 8) * DM + c8; const f32x4 a = *(const f32x4*)s, b = *(const f32x4*)(s + 4);
                o[0] = cvt_pk_bf16(silu_(a[0]), silu_(a[1])); o[1] = cvt_pk_bf16(silu_(a[2]), silu_(a[3])); o[2] = cvt_pk_bf16(silu_(b[0]), silu_(b[1])); o[3] = cvt_pk_bf16(silu_(b[2]), silu_(b[3])); }
            *(u32x4*)(ca + (size_t)row * DM + c8) = o; }
    } else {
        transpose_job(p.in[8], DM, DIN, (bf16_t*)(ws + WS_WIN), 0, tile, job, nb, wb);
        transpose_job(p.in[14], DM, DM, (bf16_t*)(ws + WS_WB), 0, tile, job, nb, wb);
        transpose_job(p.in[15], DM, DM, (bf16_t*)(ws + WS_WOUT), 0, tile, job, nb, wb);
        transpose_job(p.in[18], DM, DFF, (bf16_t*)(ws + WS_WGU), 1, tile, job, nb, wb);
        transpose_job(p.in[19], DM, DFF, (bf16_t*)(ws + WS_WGU), 2, tile, job, nb, wb);
        transpose_job(p.in[20], DFF, DM, (bf16_t*)(ws + WS_WDN), 0, tile, job, nb, wb);
        const float* wg = p.in[9]; const float* ps = p.in[10]; const float* wa = p.in[13]; bf16_t* weff = (bf16_t*)(ws + WS_WEFF);
        for (int it = ((wb - job) % nb + nb) % nb; it < 256; it += nb) {
            const int g = it >> 6, cb = (it >> 1) & 31, nh = it & 1, n = nh * 512 + tid;
            float a[4] = {0.f, 0.f, 0.f, 0.f};
            const float* wap = wa + (size_t)(g * 128) * DM + n; const float* wgp = wg + (size_t)(g * 128 + cb * 4) * 128; const float* psp = ps + g * 128;
#pragma unroll 16
            for (int d = 0; d < 128; ++d) { const float w = wap[(size_t)d * DM] * psp[d];
#pragma unroll
                for (int i = 0; i < 4; ++i) a[i] += wgp[i * 128 + d] * w; }
            u32x2 o; o[0] = cvt_pk_bf16(a[0], a[1]); o[1] = cvt_pk_bf16(a[2], a[3]);
            *(u32x2*)(weff + (size_t)n * DPOOL + g * 128 + cb * 4) = o; }
    }
}
__device__ void phase_u(const Params& p) {
    const float* mod = (const float*)(p.ws + WS_MOD); bf16_t* u = (bf16_t*)(p.out + O_HS);
    const int stride = gridDim.x * 512;
    for (int i0 = blockIdx.x * 512 + threadIdx.x; i0 < NTOK * DM / 8; i0 += 4 * stride) { f32x4 x0[4], x1[4], sh0[4], sh1[4], sc0[4], sc1[4];
#pragma unroll
        for (int k = 0; k < 4; ++k) { const int i = i0 + k * stride; if (i < NTOK * DM / 8) { const int tok = i >> 7, c8 = (i & 127) * 8;
            const float* xr = tok < NPTOK ? p.in[0] + (size_t)tok * DM + c8 : p.in[1] + (size_t)(tok - NPTOK) * DM + c8; const float* mr = mod + (size_t)mrow_of(tok) * NMODC + c8;
            x0[k] = *(const f32x4*)xr; x1[k] = *(const f32x4*)(xr + 4); sh0[k] = *(const f32x4*)mr; sh1[k] = *(const f32x4*)(mr + 4); sc0[k] = *(const f32x4*)(mr + DM); sc1[k] = *(const f32x4*)(mr + DM + 4); } }
#pragma unroll
        for (int k = 0; k < 4; ++k) { const int i = i0 + k * stride; if (i < NTOK * DM / 8) { const int tok = i >> 7, c8 = (i & 127) * 8;
            *(u32x4*)(u + (size_t)tok * DM + c8) = pack8(x0[k] * (sc0[k] + 1.f) + sh0[k], x1[k] * (sc1[k] + 1.f) + sh1[k]); } } }
}
template <bool FIRST> __device__ void phase_ln(const Params& p) {
    const float* mod = (const float*)(p.ws + WS_MOD);
    const bf16_t* r = FIRST ? (const bf16_t*)p.out : (const bf16_t*)(p.ws + WS_OG);
    const float* g = p.in[FIRST ? 16 : 21]; const float* b = p.in[FIRST ? 17 : 22];
    bf16_t* x1 = (bf16_t*)(p.ws + WS_QS); bf16_t* hb = (bf16_t*)(p.ws + WS_OG);
    const int lane = threadIdx.x & 63, wv = blockIdx.x * 8 + (threadIdx.x >> 6), nw = gridDim.x * 8;
    constexpr int R = 4;
    for (int row0 = wv * R; row0 < NTOK; row0 += nw * R) { f32x4 v[R][4]; float s[R], q[R];
#pragma unroll
        for (int k = 0; k < R; ++k) { const bf16_t* rp = r + (size_t)(row0 + k) * DM; s[k] = 0.f;
#pragma unroll
            for (int i = 0; i < 4; ++i) { v[k][i] = unpack4(*(const u32x2*)(rp + i * 256 + lane * 4)); s[k] += v[k][i][0] + v[k][i][1] + v[k][i][2] + v[k][i][3]; } }
#pragma unroll
        for (int o = 32; o; o >>= 1)
#pragma unroll
            for (int k = 0; k < R; ++k) s[k] += __shfl_xor(s[k], o);
#pragma unroll
        for (int k = 0; k < R; ++k) { const float mu = s[k] * (1.f / DM); q[k] = 0.f;
#pragma unroll
            for (int i = 0; i < 4; ++i) { v[k][i] = v[k][i] - mu; q[k] += v[k][i][0] * v[k][i][0] + v[k][i][1] * v[k][i][1] + v[k][i][2] * v[k][i][2] + v[k][i][3] * v[k][i][3]; } }
#pragma unroll
        for (int o = 32; o; o >>= 1)
#pragma unroll
            for (int k = 0; k < R; ++k) q[k] += __shfl_xor(q[k], o);
#pragma unroll
        for (int k = 0; k < R; ++k) { const int row = row0 + k; const float rs = rsqrtf(q[k] * (1.f / DM) + LN_EPS); const float* mr = mod + (size_t)mrow_of(row) * NMODC;
#pragma unroll
            for (int i = 0; i < 4; ++i) { const int c = i * 256 + lane * 4; const f32x4 y = v[k][i] * rs * *(const f32x4*)(g + c) + *(const f32x4*)(b + c);
                if (FIRST) { *(u32x2*)(x1 + (size_t)row * DM + c) = pack4(y); *(u32x2*)(hb + (size_t)row * DM + c) = pack4(y * (*(const f32x4*)(mr + 4 * DM + c) + 1.f) + *(const f32x4*)(mr + 3 * DM + c)); }
                else *(f32x4*)(p.out + (size_t)row * DM + c) = y; } } }
}
__device__ void phase_pool(const Params& p, int nb, int wb) {
    const float* zp = p.out;
    bf16_t* dmb = (bf16_t*)(p.ws + WS_DMB); const float* sp = p.in[2];
    const int gt = wb * 512 + threadIdx.x, gn = nb * 512;
    for (int i = gt; i < 512 * 128 + NBS * 128; i += gn) {
        const int c0 = (i & 127) * 4, w = 2 << (c0 >> 7);
        if (i < 512 * 128) {
            const int run = i >> 7, b = run >> 6, t0 = (run & 63) * 32; const float* zb = zp + (size_t)b * SEQ * DPOOL + c0; bf16_t* db = dmb + (size_t)b * SEQ * DPOOL + c0;
            f32x4 s = {0.f, 0.f, 0.f, 0.f};
            for (int t = t0 - w; t < t0; ++t) if (t >= 0) s += *(const f32x4*)(zb + (size_t)t * DPOOL);
            for (int t = t0; t < t0 + 32; ++t) { const f32x4 z = *(const f32x4*)(zb + (size_t)t * DPOOL); s += z;
                if (t - w >= 0) s -= *(const f32x4*)(zb + (size_t)(t - w) * DPOOL);
                const float ic = 1.f / (float)(t + 1 < w ? t + 1 : w); const f32x4 d = s * ic - z;
                u32x2 o; o[0] = cvt_pk_bf16(d[0], d[1]); o[1] = cvt_pk_bf16(d[2], d[3]); *(u32x2*)(db + (size_t)t * DPOOL) = o; }
        } else {
            const int b = (i - 512 * 128) >> 7; const float* sb = sp + (size_t)b * PBUF * DPOOL + c0; const float* zb = zp + (size_t)(NPTOK + b * DSEQ) * DPOOL + c0;
            const float ic = 1.f / (float)w;
            for (int t = 0; t < DSEQ; ++t) { f32x4 s = {0.f, 0.f, 0.f, 0.f};
                for (int e = PBUF + t - w + 1; e <= PBUF + t; ++e) s += e < PBUF ? *(const f32x4*)(sb + (size_t)e * DPOOL) : *(const f32x4*)(zb + (size_t)(e - PBUF) * DPOOL);
                const f32x4 z = *(const f32x4*)(zb + (size_t)t * DPOOL), d = s * ic - z;
                u32x2 o; o[0] = cvt_pk_bf16(d[0], d[1]); o[1] = cvt_pk_bf16(d[2], d[3]); *(u32x2*)(dmb + (size_t)(NPTOK + b * DSEQ + t) * DPOOL + c0) = o; }
        }
    }
    for (int i = gt; i < NBP * PBUF * 128; i += gn) { const int c0 = (i & 127) * 4, r = i >> 7, b = r / PBUF, k = r % PBUF;
        *(f32x4*)(p.out + O_PP + (size_t)r * DPOOL + c0) = *(const f32x4*)(zp + (size_t)(b * SEQ + SEQ - PBUF + k) * DPOOL + c0); }
    for (int i = gt; i < NBS * PBUF * 128; i += gn) { const int c0 = (i & 127) * 4, r = i >> 7, b = r / PBUF, k = r % PBUF;
        *(f32x4*)(p.out + O_PS + (size_t)r * DPOOL + c0) = (k < PBUF - DSEQ ? *(const f32x4*)(sp + (size_t)(b * PBUF + k + DSEQ) * DPOOL + c0) : *(const f32x4*)(zp + (size_t)(NPTOK + b * DSEQ + k - (PBUF - DSEQ)) * DPOOL + c0)); }
}
constexpr int L_QD = 0, L_KD = 17408, L_KT = 34816, L_VT = 53248, L_PP = 71680, L_ST = 80896, L_GT = 115712, L_DEC = 117760, L_RED = 118272;
constexpr int QS_ = 136, TS_ = 72;
#define MFMA16(a, b, c) __builtin_amdgcn_mfma_f32_16x16x32_bf16(a, b, c, 0, 0, 0)
#define LDSV(off) (*(const LAS bf16x8*)(lds + (off)))
template <bool PASSB> __device__ void hgrn_item(const Params& p, LAS unsigned char* lds, int b, int h, int seg) {
    const int tid = threadIdx.x, wid = tid >> 6, lane = tid & 63, fr = lane & 15, fq = lane >> 4, c = tid & 127, tg = tid >> 7;
    const bf16_t* qs = (const bf16_t*)(p.ws + WS_QS); const bf16_t* zf = (const bf16_t*)(p.ws + WS_ZF); const bf16_t* vv = (const bf16_t*)(p.ws + WS_VV); const bf16_t* og = (const bf16_t*)(p.ws + WS_OG);
    bf16_t* yh = (bf16_t*)p.out;
    float* sloc = (float*)(p.ws + WS_SLOC); float* sdec = (float*)(p.ws + WS_SDEC);
    const float l0 = p.in[11][h * HD + c], l1 = p.in[11][DM + h * HD + c]; const float lbv = sigm(l0 - l1), oml = 1.f - lbv;
    f32x4 S[8];
#pragma unroll
    for (int n = 0; n < 8; ++n) S[n] = (f32x4){0.f, 0.f, 0.f, 0.f};
    const int crow = wid * 16 + fq * 4;
    const int ptok = tid >> 4, pch = (tid & 15) * 8;
    const size_t tokbase = (size_t)(b * SEQ + seg * SEGLEN) * DM + h * HD + pch;
    __syncthreads();
    if (PASSB) {
        for (int s = 0; s < seg; ++s) { const float* sl = sloc + (size_t)((b * NH + h) * NSEG + s) * HD * HD + crow * HD + fr; const float* sd = sdec + ((b * NH + h) * NSEG + s) * HD + crow;
#pragma unroll
            for (int j = 0; j < 4; ++j) { const float d = sd[j];
#pragma unroll
                for (int n = 0; n < 8; ++n) S[n][j] = S[n][j] * d + sl[j * HD + n * 16]; } }
#pragma unroll
        for (int n = 0; n < 8; ++n) { u32x2 o; o[0] = cvt_pk_bf16(S[n][0], S[n][1]); o[1] = cvt_pk_bf16(S[n][2], S[n][3]); *(LAS u32x2*)(lds + L_ST + ((n * 16 + fr) * QS_ + crow) * 2) = o; }
    }
    float segtot = 1.f;
    for (int ch = 0; ch < NCHSEG; ++ch) {
        const int tok0 = b * SEQ + seg * SEGLEN + ch * CH;
        u32x4 cg_[2];
        { u32x4 rz[2], rv[2], rq[2];
#pragma unroll
          for (int i = 0; i < 2; ++i) { const size_t gi = tokbase + (size_t)(ch * CH + ptok + 32 * i) * DM; rz[i] = *(const u32x4*)(zf + gi); rv[i] = *(const u32x4*)(vv + gi);
              if (PASSB) { rq[i] = *(const u32x4*)(qs + gi); cg_[i] = *(const u32x4*)(og + gi); } }
#pragma unroll
          for (int i = 0; i < 2; ++i) { const int o = ((ptok + 32 * i) * 128 + pch) * 2; *(LAS u32x4*)(lds + L_QD + o) = rz[i]; *(LAS u32x4*)(lds + L_KT + o) = rv[i]; if (PASSB) *(LAS u32x4*)(lds + L_KD + o) = rq[i]; } }
        __syncthreads();
        float pr[16], kk[16]; unsigned qp[8];
        { float run = 1.f;
#pragma unroll
          for (int i = 0; i < 16; ++i) { const int o = ((tg * 16 + i) * 128 + c) * 2; const float z = bf2f(*(const LAS bf16_t*)(lds + L_QD + o)); const float sg = sigm(z); kk[i] = oml * (1.f - sg); run *= lbv + oml * sg; pr[i] = run;
              if (PASSB) { const unsigned qq = *(const LAS bf16_t*)(lds + L_KD + o); if (i & 1) qp[i >> 1] |= qq << 16; else qp[i >> 1] = qq; } }
          unsigned vt[8];
#pragma unroll
          for (int i = 0; i < 8; ++i) vt[i] = (unsigned)*(const LAS bf16_t*)(lds + L_KT + ((tg * 16 + 2 * i) * 128 + c) * 2) | ((unsigned)*(const LAS bf16_t*)(lds + L_KT + ((tg * 16 + 2 * i + 1) * 128 + c) * 2) << 16);
          *(LAS u32x4*)(lds + L_VT + (c * TS_ + tg * 16) * 2) = (u32x4){vt[0], vt[1], vt[2], vt[3]}; *(LAS u32x4*)(lds + L_VT + (c * TS_ + tg * 16 + 8) * 2) = (u32x4){vt[4], vt[5], vt[6], vt[7]};
          *(LAS float*)(lds + L_GT + (tg * 128 + c) * 4) = run; }
        __syncthreads();
        float off = 1.f, tot = 1.f;
#pragma unroll
        for (int g = 0; g < 4; ++g) { const float t = *(const LAS float*)(lds + L_GT + (g * 128 + c) * 4); tot *= t; if (g < tg) off *= t; }
        { unsigned kt[8];
#pragma unroll
          for (int i = 0; i < 8; ++i) { const float e0 = pr[2 * i] * off, e1 = pr[2 * i + 1] * off, r0 = __builtin_amdgcn_rcpf(e0), r1 = __builtin_amdgcn_rcpf(e1);
              kt[i] = cvt_pk_bf16(kk[2 * i] * (tot * r0), kk[2 * i + 1] * (tot * r1));
              if (PASSB) { const int t = tg * 16 + 2 * i;
                  *(LAS bf16_t*)(lds + L_QD + (t * QS_ + c) * 2) = f2bf(bf2f(qp[i] & 0xffffu) * e0); *(LAS bf16_t*)(lds + L_QD + ((t + 1) * QS_ + c) * 2) = f2bf(__uint_as_float(qp[i] & 0xffff0000u) * e1);
                  *(LAS bf16_t*)(lds + L_KD + (t * QS_ + c) * 2) = f2bf(kk[2 * i] * r0); *(LAS bf16_t*)(lds + L_KD + ((t + 1) * QS_ + c) * 2) = f2bf(kk[2 * i + 1] * r1); } }
          *(LAS u32x4*)(lds + L_KT + (c * TS_ + tg * 16) * 2) = (u32x4){kt[0], kt[1], kt[2], kt[3]}; *(LAS u32x4*)(lds + L_KT + (c * TS_ + tg * 16 + 8) * 2) = (u32x4){kt[4], kt[5], kt[6], kt[7]};
          }
        if (tg == 0) { *(LAS float*)(lds + L_DEC + c * 4) = tot; segtot *= tot; }
        __syncthreads();
        f32x4 o[4]; const int ti = wid >> 1;
        if (PASSB) {
#pragma unroll
            for (int x = 0; x < 2; ++x) { const int tj = (wid & 1) * 2 + x; f32x4 a = {0.f, 0.f, 0.f, 0.f};
                if (tj <= ti) {
#pragma unroll
                    for (int k = 0; k < 4; ++k) a = MFMA16(LDSV(L_QD + ((ti * 16 + fr) * QS_ + k * 32 + fq * 8) * 2), LDSV(L_KD + ((tj * 16 + fr) * QS_ + k * 32 + fq * 8) * 2), a);
                }
#pragma unroll
                for (int j = 0; j < 4; ++j) { const int t = ti * 16 + fq * 4 + j, s = tj * 16 + fr; *(LAS bf16_t*)(lds + L_PP + (t * TS_ + s) * 2) = f2bf(s <= t ? a[j] : 0.f); } }
            __syncthreads();
#pragma unroll
            for (int n = 0; n < 4; ++n) { const int vtile = (wid & 1) * 4 + n; o[n] = (f32x4){0.f, 0.f, 0.f, 0.f};
#pragma unroll
                for (int k = 0; k < 2; ++k) o[n] = MFMA16(LDSV(L_PP + ((ti * 16 + fr) * TS_ + k * 32 + fq * 8) * 2), LDSV(L_VT + ((vtile * 16 + fr) * TS_ + k * 32 + fq * 8) * 2), o[n]);
#pragma unroll
                for (int k = 0; k < 4; ++k) o[n] = MFMA16(LDSV(L_QD + ((ti * 16 + fr) * QS_ + k * 32 + fq * 8) * 2), LDSV(L_ST + ((vtile * 16 + fr) * QS_ + k * 32 + fq * 8) * 2), o[n]);
                __builtin_amdgcn_sched_barrier(0); }
#pragma unroll
            for (int j = 0; j < 4; ++j) { float q = 0.f;
#pragma unroll
                for (int n = 0; n < 4; ++n) q += o[n][j] * o[n][j];
                q += __shfl_xor(q, 1); q += __shfl_xor(q, 2); q += __shfl_xor(q, 4); q += __shfl_xor(q, 8);
                if (fr == 0) *(LAS float*)(lds + L_RED + ((wid & 1) * 64 + ti * 16 + fq * 4 + j) * 4) = q; }
        }
        { float d[4];
#pragma unroll
          for (int j = 0; j < 4; ++j) d[j] = *(const LAS float*)(lds + L_DEC + (crow + j) * 4);
#pragma unroll
          for (int n = 0; n < 8; ++n) {
#pragma unroll
              for (int j = 0; j < 4; ++j) S[n][j] *= d[j];
#pragma unroll
              for (int k = 0; k < 2; ++k) S[n] = MFMA16(LDSV(L_KT + ((wid * 16 + fr) * TS_ + k * 32 + fq * 8) * 2), LDSV(L_VT + ((n * 16 + fr) * TS_ + k * 32 + fq * 8) * 2), S[n]);
              if (n & 1) __builtin_amdgcn_sched_barrier(0); } }
        __syncthreads();
        if (PASSB) {
#pragma unroll
            for (int n = 0; n < 8; ++n) { u32x2 w; w[0] = cvt_pk_bf16(S[n][0], S[n][1]); w[1] = cvt_pk_bf16(S[n][2], S[n][3]); *(LAS u32x2*)(lds + L_ST + ((n * 16 + fr) * QS_ + crow) * 2) = w; }
#pragma unroll
            for (int j = 0; j < 4; ++j) { const int t = ti * 16 + fq * 4 + j;
                const float ri = rsqrtf((*(const LAS float*)(lds + L_RED + t * 4) + *(const LAS float*)(lds + L_RED + (64 + t) * 4)) * (1.f / HD) + RMS_EPS);
#pragma unroll
                for (int n = 0; n < 4; ++n) *(LAS bf16_t*)(lds + L_VT + (t * 128 + ((wid & 1) * 4 + n) * 16 + fr) * 2) = f2bf(o[n][j] * ri); }
            __syncthreads();
#pragma unroll
            for (int i = 0; i < 2; ++i) { const u32x4 yv = *(const LAS u32x4*)(lds + L_VT + ((ptok + 32 * i) * 128 + pch) * 2); f32x4 y0, y1, g0, g1; unpack8(yv, y0, y1); unpack8(cg_[i], g0, g1);
                *(u32x4*)(yh + (size_t)(tok0 + ptok + 32 * i) * DM + h * HD + pch) = pack8(y0 * g0, y1 * g1); }
        }
    }
    if (PASSB) {
        if (seg == NSEG - 1) { float* dst = p.out + O_HP + (size_t)(b * NH + h) * HD * HD + crow * HD + fr;
#pragma unroll
            for (int n = 0; n < 8; ++n)
#pragma unroll
                for (int j = 0; j < 4; ++j) dst[j * HD + n * 16] = S[n][j]; }
    } else {
        float* sl = sloc + (size_t)((b * NH + h) * NSEG + seg) * HD * HD + crow * HD + fr;
#pragma unroll
        for (int n = 0; n < 8; ++n)
#pragma unroll
            for (int j = 0; j < 4; ++j) sl[j * HD + n * 16] = S[n][j];
        if (tg == 0) sdec[((b * NH + h) * NSEG + seg) * HD + c] = segtot;
    }
}
constexpr int L2_Q = 0, L2_K = 4096, L2_F = 8192, L2_V = 12288, L2_OG = 16384, L2_PO = 20480, L2_RED = 36864;
__device__ void hgrn_sample_run(const Params& p, LAS unsigned char* lds, int s_first, int s_stride) {
    const int tid = threadIdx.x, v = tid & 127, cq = tid >> 7, lane = tid & 63, wid = tid >> 6;
    const bf16_t* qs = (const bf16_t*)(p.ws + WS_QS); const bf16_t* zf = (const bf16_t*)(p.ws + WS_ZF); const bf16_t* vv = (const bf16_t*)(p.ws + WS_VV); const bf16_t* og = (const bf16_t*)(p.ws + WS_OG);
    bf16_t* yh = (bf16_t*)p.out;
    float S[32], Sn[32];
    if (s_first < NBS * NH) { const float* s0 = p.in[3] + (size_t)s_first * HD * HD + (cq * 32) * HD + v;
#pragma unroll
        for (int i = 0; i < 32; ++i) S[i] = s0[i * HD]; }
    for (int s = s_first; s < NBS * NH; s += s_stride) {
        const int bs = s >> 3, h = s & 7, sn = s + s_stride;
        float* s1 = p.out + O_HS + (size_t)s * HD * HD + (cq * 32) * HD + v;
        float zr[2], qr[2], vr[2], gr[2];
#pragma unroll
        for (int r = 0; r < 2; ++r) { const size_t gi = (size_t)(NPTOK + bs * DSEQ + cq * 2 + r) * DM + h * HD + v; zr[r] = bf2f(zf[gi]); qr[r] = bf2f(qs[gi]); vr[r] = bf2f(vv[gi]); gr[r] = bf2f(og[gi]); }
        const float l0 = p.in[11][h * HD + v], l1 = p.in[11][DM + h * HD + v];
        if (sn < NBS * NH) { const float* s0 = p.in[3] + (size_t)sn * HD * HD + (cq * 32) * HD + v;
#pragma unroll
            for (int i = 0; i < 32; ++i) Sn[i] = s0[i * HD]; }
        __syncthreads();
        { const float lbv = sigm(l0 - l1), oml = 1.f - lbv;
#pragma unroll
          for (int r = 0; r < 2; ++r) { const int t = cq * 2 + r; const float sg = sigm(zr[r]);
              *(LAS float*)(lds + L2_Q + (t * 128 + v) * 4) = qr[r]; *(LAS float*)(lds + L2_K + (t * 128 + v) * 4) = oml * (1.f - sg); *(LAS float*)(lds + L2_F + (t * 128 + v) * 4) = lbv + oml * sg;
              *(LAS float*)(lds + L2_V + (t * 128 + v) * 4) = vr[r]; *(LAS float*)(lds + L2_OG + (t * 128 + v) * 4) = gr[r]; } }
        __syncthreads();
#pragma unroll 1
        for (int t = 0; t < DSEQ; ++t) { const float vt = *(const LAS float*)(lds + L2_V + (t * 128 + v) * 4); float po = 0.f;
#pragma unroll
            for (int i4 = 0; i4 < 8; ++i4) { const int co = (t * 128 + cq * 32 + i4 * 4) * 4;
                const f32x4 f = *(const LAS f32x4*)(lds + L2_F + co), k = *(const LAS f32x4*)(lds + L2_K + co), q = *(const LAS f32x4*)(lds + L2_Q + co);
#pragma unroll
                for (int i = 0; i < 4; ++i) { S[i4 * 4 + i] = f[i] * S[i4 * 4 + i] + k[i] * vt; po += S[i4 * 4 + i] * q[i]; } }
            *(LAS float*)(lds + L2_PO + ((t * 4 + cq) * 128 + v) * 4) = po; }
#pragma unroll
        for (int i = 0; i < 32; ++i) s1[i * HD] = S[i];
        __syncthreads();
        float ov[2];
#pragma unroll
        for (int r = 0; r < 2; ++r) { const int t = cq * 2 + r; float o = 0.f;
#pragma unroll
            for (int g = 0; g < 4; ++g) o += *(const LAS float*)(lds + L2_PO + ((t * 4 + g) * 128 + v) * 4);
            ov[r] = o; float q = o * o;
#pragma unroll
            for (int x = 32; x; x >>= 1) q += __shfl_xor(q, x);
            if (lane == 0) *(LAS float*)(lds + L2_RED + (t * 2 + (wid & 1)) * 4) = q; }
        __syncthreads();
#pragma unroll
        for (int r = 0; r < 2; ++r) { const int t = cq * 2 + r; const float ri = rsqrtf((*(const LAS float*)(lds + L2_RED + (t * 2) * 4) + *(const LAS float*)(lds + L2_RED + (t * 2 + 1) * 4)) * (1.f / HD) + RMS_EPS);
            yh[(size_t)(NPTOK + bs * DSEQ + t) * DM + h * HD + v] = f2bf(ov[r] * ri * *(const LAS float*)(lds + L2_OG + (t * 128 + v) * 4)); }
#pragma unroll
        for (int i = 0; i < 32; ++i) S[i] = Sn[i];
    }
}
template <class Epi> __device__ void small_gemm(LAS unsigned char* lds, const bf16_t* __restrict__ A, const bf16_t* __restrict__ Bt, int K, int tm, int tn, const Epi& E) {
    const int tid = threadIdx.x, wid = tid >> 6, lane = tid & 63, fr = lane & 15, fq = lane >> 4;
    const int row0 = NPTOK + tm * 64, col0 = tn * 64;
    const bf16_t* Ab = A + (size_t)row0 * K + (size_t)(tid >> 5) * K + (tid & 31) * 8; const bf16_t* Bb = Bt + (size_t)col0 * K + (size_t)(tid >> 5) * K + (tid & 31) * 8;
    const int loff = (tid >> 5) * 512 + (((tid & 31) ^ ((tid >> 5) & 15)) << 4);
    u32x4 ra0[4], rb0[4], ra1[4], rb1[4];
    f32x4 acc[2]; acc[0] = (f32x4){0.f, 0.f, 0.f, 0.f}; acc[1] = acc[0];
    const int nk = K >> 8;
    const int arow = (wid & 3) * 16 + fr, brow = (wid >> 2) * 32 + fr;
#define SG_LOAD(RA, RB, tt) _Pragma("unroll") for (int i = 0; i < 4; ++i) { RA[i] = *(const u32x4*)(Ab + (size_t)(16 * i) * K + (tt) * 256); RB[i] = *(const u32x4*)(Bb + (size_t)(16 * i) * K + (tt) * 256); }
#define SG_STORE(RA, RB, buf) _Pragma("unroll") for (int i = 0; i < 4; ++i) { *(LAS u32x4*)(lds + (buf) + loff + i * 8192) = RA[i]; *(LAS u32x4*)(lds + (buf) + 32768 + loff + i * 8192) = RB[i]; }
#define SG_COMPUTE(buf) _Pragma("unroll") for (int kk = 0; kk < 8; ++kk) { const int sw = ((kk * 4 + fq) ^ fr) << 4; const bf16x8 a = *(const LAS bf16x8*)(lds + (buf) + arow * 512 + sw); \
        _Pragma("unroll") for (int s2 = 0; s2 < 2; ++s2) { const bf16x8 bb = *(const LAS bf16x8*)(lds + (buf) + 32768 + (brow + s2 * 16) * 512 + sw); acc[s2] = __builtin_amdgcn_mfma_f32_16x16x32_bf16(bb, a, acc[s2], 0, 0, 0); } }
    SG_LOAD(ra0, rb0, 0)
    if (nk > 1) { SG_LOAD(ra1, rb1, 1) }
    __syncthreads();
    SG_STORE(ra0, rb0, 0)
    __syncthreads();
    for (int t = 0; t < nk; t += 2) {
        if (t + 2 < nk) { SG_LOAD(ra0, rb0, t + 2) }
        SG_COMPUTE(0)
        if (t + 1 < nk) { SG_STORE(ra1, rb1, 65536) }
        __syncthreads();
        if (t + 1 >= nk) break;
        if (t + 3 < nk) { SG_LOAD(ra1, rb1, t + 3) }
        SG_COMPUTE(65536)
        if (t + 2 < nk) { SG_STORE(ra0, rb0, 0) }
        __syncthreads();
    }
#undef SG_LOAD
#undef SG_STORE
#undef SG_COMPUTE
#pragma unroll
    for (int s2 = 0; s2 < 2; ++s2) E.small4(row0 + arow, col0 + (wid >> 2) * 32 + s2 * 16 + fq * 4, acc[s2]);
}
#define XB_TMO      128
#define XB_XCNT(j)  (256  + 64 * (j))
#define XB_XSUB(j)  (1280 + 64 * (j))
#define XB_XGEN(j)  (2304 + 64 * (j))
#define XB_TOP      3328
#define XB_TOPGEN   3392
#define XCD_BAR_WORDS 3456
#define XB_SPIN_CAP (1u << 18)

__device__ __forceinline__ unsigned xb_ld(unsigned* p)              { return __hip_atomic_load(p, __ATOMIC_RELAXED, __HIP_MEMORY_SCOPE_AGENT); }
__device__ __forceinline__ unsigned xb_add(unsigned* p, unsigned v) { return __hip_atomic_fetch_add(p, v, __ATOMIC_RELAXED, __HIP_MEMORY_SCOPE_AGENT); }
__device__ __forceinline__ unsigned xb_xcc_id() { return (unsigned)__builtin_amdgcn_s_getreg((3 << 11) | 20) & 0xFu; }
#define XB_SPIN(cond, bar) do { unsigned _sp = 0; while (cond) { __builtin_amdgcn_s_sleep(1); \
    if ((++_sp & 255u) == 0u) { if (xb_ld(&(bar)[XB_TMO])) break; if (_sp > XB_SPIN_CAP) { atomicAdd(&(bar)[XB_TMO], 1u); break; } } } } while (0)

struct XcdBarrier {
    unsigned* bar; unsigned x;
    volatile LAS unsigned* st;
};

__device__ __forceinline__ XcdBarrier xcd_barrier_post(unsigned* bar, volatile LAS unsigned* st) {
    XcdBarrier b; b.bar = bar; b.x = xb_xcc_id(); b.st = st;
    if (threadIdx.x == 0) (void)xb_add(&bar[XB_XCNT(b.x)], 1u);
    return b;
}
__device__ __forceinline__ void xcd_barrier_complete(unsigned* bar, unsigned x, unsigned& nloc, unsigned& nx) {
    const unsigned G = gridDim.x * gridDim.y * gridDim.z;
    unsigned sum, cnt, mine, sp = 0u;
    for (;;) {
        sum = 0u; cnt = 0u; mine = 0u;
#pragma unroll
        for (unsigned j = 0; j < 16; ++j) { const unsigned c = xb_ld(&bar[XB_XCNT(j)]); sum += c; cnt += (c > 0u) ? 1u : 0u; mine = (j == x) ? c : mine; }
        if (sum == G) break;
        __builtin_amdgcn_s_sleep(1);
        if ((++sp & 255u) == 0u) { if (xb_ld(&bar[XB_TMO])) break; if (sp > XB_SPIN_CAP) { atomicAdd(&bar[XB_TMO], 1u); break; } }
    }
    nloc = mine > 0u ? mine : 1u; nx = cnt > 0u ? cnt : 1u;
}

__device__ __forceinline__ void xcd_barrier(const XcdBarrier& b) {
    asm volatile("s_waitcnt vmcnt(0)" ::: "memory");
    __syncthreads();
    if (threadIdx.x == 0) {
        unsigned* bar = b.bar;
        __builtin_amdgcn_s_waitcnt(0);
        unsigned nloc = b.st[0], nx = b.st[1];
        if (nloc == 0u) { xcd_barrier_complete(bar, b.x, nloc, nx); b.st[0] = nloc; b.st[1] = nx; }
        const unsigned old = xb_add(&bar[XB_XSUB(b.x)], 1u);
        const unsigned gen = old / nloc;
        if (old + 1u == (gen + 1u) * nloc) {
            __builtin_amdgcn_fence(__ATOMIC_RELEASE, "agent");
            asm volatile("s_waitcnt vmcnt(0)" ::: "memory");
            const unsigned og = xb_add(&bar[XB_TOP], 1u);
            const unsigned tg = og / nx;
            if (og + 1u == (tg + 1u) * nx) xb_add(&bar[XB_TOPGEN], 1u);
            else XB_SPIN(xb_ld(&bar[XB_TOPGEN]) == tg, bar);
            __builtin_amdgcn_fence(__ATOMIC_ACQUIRE, "agent");
            xb_add(&bar[XB_XGEN(b.x)], 1u);
            asm volatile("s_waitcnt vmcnt(0)" ::: "memory");
        } else {
            XB_SPIN(xb_ld(&bar[XB_XGEN(b.x)]) == gen, bar);
            __builtin_amdgcn_fence(__ATOMIC_ACQUIRE, "agent");
            asm volatile("s_waitcnt vmcnt(0)" ::: "memory");
        }
    }

    __syncthreads();
}
constexpr int N_PHASES = 12;
template <int PH> __device__ __forceinline__ void run_phase(const Params& p, LAS unsigned char* lds) {
    unsigned char* ws = p.ws; const int G = gridDim.x, bid = blockIdx.x;
    float* mod = (float*)(ws + WS_MOD);
    if constexpr (PH == 0) phase_prep<0>(p, lds, G, bid);
    else if constexpr (PH == 1) {
        const int NA = NMODC / 256;
        if (G > 2 * NA) {
            if (bid < NA) { pg8::Gemm g{(const bf16_t*)(ws + WS_CACT), (const bf16_t*)(ws + WS_WADA), 256, NMODC, DM}; pg8::StaticOrder S; S.init(256, NMODC, NA, bid); EpiAda E{mod, p.in[7]}; pg8::gemm_phase(lds, g, S, E); }
            else phase_prep<1>(p, lds, G - NA, bid - NA);
        } else { phase_prep<1>(p, lds, G, bid); pg8::Gemm g{(const bf16_t*)(ws + WS_CACT), (const bf16_t*)(ws + WS_WADA), 256, NMODC, DM}; pg8::StaticOrder S; S.init(256, NMODC, G, bid); EpiAda E{mod, p.in[7]}; pg8::gemm_phase(lds, g, S, E); }
    }
    else if constexpr (PH == 2) phase_u(p);
    else if constexpr (PH == 3) { pg8::Gemm g{(const bf16_t*)(p.out + O_HS), (const bf16_t*)(ws + WS_WIN), NTOK, DIN, DM}; pg8::StaticOrder S; S.init(NTOK, DIN, G, bid);
        EpiZ E{p.out, (bf16_t*)(ws + WS_QS), (bf16_t*)(ws + WS_ZF), (bf16_t*)(ws + WS_VV), (bf16_t*)(ws + WS_OG), (bf16_t*)((unsigned char*)p.out + S35), (bf16_t*)(ws + WS_GB), p.in[12]};
        pg8::gemm_phase(lds, g, S, E); }
    else if constexpr (PH == 4) { const int NA = NBP * NH * (NSEG - 1);
        if (G >= NA + 32) { if (bid >= NA) phase_pool(p, G - NA, bid - NA); else hgrn_item<false>(p, lds, bid / (NH * (NSEG - 1)), (bid / (NSEG - 1)) % NH, bid % (NSEG - 1)); }
        else { phase_pool(p, G, bid); for (int it = bid; it < NA; it += G) hgrn_item<false>(p, lds, it / (NH * (NSEG - 1)), (it / (NSEG - 1)) % NH, it % (NSEG - 1)); } }
    else if constexpr (PH == 5) {
        for (int it = bid; it < NBP * NH * NSEG; it += G) hgrn_item<true>(p, lds, it / (NH * NSEG), (it / NSEG) % NH, it % NSEG);
        hgrn_sample_run(p, lds, bid, G); }
    else if constexpr (PH == 6) { pg8::StaticOrder S; S.init(NPTOK, DM, G, bid);
        const EpiP EP{(bf16_t*)(ws + WS_QS), (const bf16_t*)((unsigned char*)p.out + S35)}; const EpiM EM{(const bf16_t*)(ws + WS_QS), (const bf16_t*)(ws + WS_GB), (bf16_t*)(ws + WS_VV)};
        { pg8::Gemm g{(const bf16_t*)(ws + WS_DMB), (const bf16_t*)(ws + WS_WEFF), NPTOK, DM, DPOOL}; pg8::gemm_phase(lds, g, S, EP); }
        { pg8::Gemm g{(const bf16_t*)p.out, (const bf16_t*)(ws + WS_WB), NPTOK, DM, DM}; pg8::gemm_phase(lds, g, S, EM); }
        for (int it = bid; it < 256; it += G) { small_gemm(lds, (const bf16_t*)(ws + WS_DMB), (const bf16_t*)(ws + WS_WEFF), DPOOL, it >> 4, it & 15, EP);
            small_gemm(lds, (const bf16_t*)p.out, (const bf16_t*)(ws + WS_WB), DM, it >> 4, it & 15, EM); } }
    else if constexpr (PH == 7) { pg8::Gemm g{(const bf16_t*)(ws + WS_VV), (const bf16_t*)(ws + WS_WOUT), NPTOK, DM, DM}; pg8::StaticOrder S; S.init(NPTOK, DM, G, bid);
        const EpiRes<false> E{p.in[0], p.in[1], mod, 2 * DM, (bf16_t*)p.out}; pg8::gemm_phase(lds, g, S, E);
        for (int it = bid; it < 256; it += G) small_gemm(lds, (const bf16_t*)(ws + WS_VV), (const bf16_t*)(ws + WS_WOUT), DM, it >> 4, it & 15, E); }
    else if constexpr (PH == 8) phase_ln<true>(p);
    else if constexpr (PH == 9) { pg8::Gemm g{(const bf16_t*)(ws + WS_OG), (const bf16_t*)(ws + WS_WGU), NTOK, 2 * DFF, DM}; pg8::StaticOrder S; S.init(NTOK, 2 * DFF, G, bid);
        EpiGU E{(bf16_t*)(ws + WS_VV)}; pg8::gemm_phase(lds, g, S, E); }
    else if constexpr (PH == 10) { pg8::Gemm g{(const bf16_t*)(ws + WS_VV), (const bf16_t*)(ws + WS_WDN), NPTOK, DM, DFF}; pg8::StaticOrder S; S.init(NPTOK, DM, G, bid);
        const EpiRes<true> E{ws + WS_QS, nullptr, mod, 5 * DM, (bf16_t*)(ws + WS_OG)}; pg8::gemm_phase(lds, g, S, E);
        for (int it = bid; it < 256; it += G) small_gemm(lds, (const bf16_t*)(ws + WS_VV), (const bf16_t*)(ws + WS_WDN), DFF, it >> 4, it & 15, E); }
    else phase_ln<false>(p);
}
#if N_LAUNCH_MODE == 0
#define RUN_PHASE(PH) { const __attribute__((address_space(4))) Params* q_ = kp; asm volatile("" : "+s"(q_)); const Params lp_ = *(const Params*)q_; run_phase<PH>(lp_, lds); }
#define PHASE_SYNC(PH) RUN_PHASE(PH) xcd_barrier(xb);
__global__ __launch_bounds__(512, 2) void mega(Params p) {
    extern __shared__ __attribute__((aligned(16))) unsigned char shm[];
    LAS unsigned char* lds = (LAS unsigned char*)shm;
#if defined(__HIP_DEVICE_COMPILE__)
    cg::grid_group grid = cg::this_grid();
    const __attribute__((address_space(4))) Params* kp = (const __attribute__((address_space(4))) Params*)__builtin_amdgcn_kernarg_segment_ptr();
    LAS unsigned* stw = (LAS unsigned*)(lds + 131072);
    if (threadIdx.x == 0) { stw[0] = 0u; stw[1] = 0u; stw[2] = 0u; stw[3] = 0u; }
    __syncthreads();
    const XcdBarrier xb = xcd_barrier_post((unsigned*)(p.ws + WS_BAR), (volatile LAS unsigned*)stw);
    if (kp->ws == nullptr) grid.sync();
    PHASE_SYNC(0)
    PHASE_SYNC(1) PHASE_SYNC(2) PHASE_SYNC(3) PHASE_SYNC(4) PHASE_SYNC(5) PHASE_SYNC(6) PHASE_SYNC(7) PHASE_SYNC(8) PHASE_SYNC(9) PHASE_SYNC(10)
    RUN_PHASE(11)
#endif
}
#else
template <int PH> __global__ __launch_bounds__(512, 2) void mega(Params p) {
    extern __shared__ __attribute__((aligned(16))) unsigned char shm[];
    run_phase<PH>(p, (LAS unsigned char*)shm);
}
template <int PH> static void launch_phase(const Params& p, int grid, hipStream_t stream) {
    static bool attr = false;
    if (!attr) { (void)hipFuncSetAttribute((const void*)mega<PH>, hipFuncAttributeMaxDynamicSharedMemorySize, LDS_BYTES); attr = true; }
    hipLaunchKernelGGL(mega<PH>, dim3(grid), dim3(512), LDS_BYTES, stream, p);
}
#endif

extern "C" void kernel_launch(void* const* d_in, const int* in_sizes, int n_in, void* d_out, int out_size, void* d_ws, size_t ws_size, hipStream_t stream) {
    static int grid_blocks = 0;
    if (!grid_blocks) {
        int dev = 0, cus = 0, per_cu = 0;
        (void)hipGetDevice(&dev); (void)hipDeviceGetAttribute(&cus, hipDeviceAttributeMultiprocessorCount, dev);
#if N_LAUNCH_MODE == 0
        if (hipFuncSetAttribute((const void*)mega, hipFuncAttributeMaxDynamicSharedMemorySize, LDS_BYTES) != hipSuccess) fprintf(stderr, "hipFuncSetAttribute failed\n");
        if (hipOccupancyMaxActiveBlocksPerMultiprocessor(&per_cu, (const void*)mega, 512, LDS_BYTES) != hipSuccess || per_cu < 1) { fprintf(stderr, "occupancy query: %d\n", per_cu); per_cu = 1; }
        (void)hipGetLastError();
#else
        per_cu = 1;
#endif
        grid_blocks = cus * per_cu;
        if (ws_size < WS_BAR + 16384 || n_in != 23) fprintf(stderr, "kernel_launch: ws_size %zu < %zu or n_in %d != 23\n", ws_size, (size_t)WS_NEED, n_in);
    }
    Params p{};
    for (int i = 0; i < 23; ++i) p.in[i] = (const float*)d_in[i];
    p.out = (float*)d_out; p.ws = (unsigned char*)d_ws;
#if N_LAUNCH_MODE == 0
    (void)hipMemsetAsync((unsigned char*)d_ws + WS_BAR, 0, XCD_BAR_WORDS * sizeof(unsigned), stream);
    void* args[] = {&p};
    hipError_t e = hipLaunchCooperativeKernel((const void*)mega, dim3(grid_blocks), dim3(512), args, LDS_BYTES, stream);
    if (e != hipSuccess) fprintf(stderr, "cooperative launch failed: %s (grid %d)\n", hipGetErrorString(e), grid_blocks);
#else
    launch_phase<0>(p, grid_blocks, stream); launch_phase<1>(p, grid_blocks, stream); launch_phase<2>(p, grid_blocks, stream); launch_phase<3>(p, grid_blocks, stream);
    launch_phase<4>(p, grid_blocks, stream); launch_phase<5>(p, grid_blocks, stream); launch_phase<6>(p, grid_blocks, stream); launch_phase<7>(p, grid_blocks, stream);
    launch_phase<8>(p, grid_blocks, stream); launch_phase<9>(p, grid_blocks, stream); launch_phase<10>(p, grid_blocks, stream); launch_phase<11>(p, grid_blocks, stream);
#endif
}
```
